# Optimizing an MI355X kernel written in HIP

```python
import math
import jax, jax.numpy as jnp
from jax import lax
import numpy as np

D_MODEL = 2048
BATCH = 8
SEQ = 4096
DEPTH = 4
DEC_BATCH = 4
DEC_SEQ = 4096
PAST_LEN = 128

N_MIXERS = 2
N_A_LAYERS = (DEPTH + 1) // 2
N_B_LAYERS = DEPTH // 2
EPS = 1e-6
ROPE_THETA = 10000.0
BLOCK = 128
A_HEADS = 16
A_KV_HEADS = 4
A_GROUP = A_HEADS // A_KV_HEADS
A_HEAD_DIM = D_MODEL // A_HEADS
WINDOW = 128
B_HEADS = 16
Q_LORA = 512
KV_LORA = 512
NOPE_DIM = 128
ROPE_DIM = 64
V_DIM = 128
D_FF = 5632
CONV_W = 3

kernel_name = "hybrid_swa_sink_mla_convffn_encoder"


def rmsnorm(x, g):
    xf = x.astype(jnp.float32)
    y = xf * lax.rsqrt(jnp.mean(xf * xf, axis=-1, keepdims=True) + EPS) * g.astype(jnp.float32)
    return y.astype(x.dtype)


def rope_tables(seq, dim):
    pos = jnp.arange(seq, dtype=jnp.float32)
    inv = 1.0 / (ROPE_THETA ** (jnp.arange(0, dim, 2, dtype=jnp.float32) / dim))
    ang = pos[:, None] * inv[None, :]
    return jnp.cos(ang), jnp.sin(ang)


def apply_rope(x, cos, sin):
    shp = (cos.shape[0],) + (1,) * (x.ndim - 3) + (cos.shape[1],)
    c = cos.reshape(shp)
    s = sin.reshape(shp)
    xf = x.astype(jnp.float32)
    x1, x2 = jnp.split(xf, 2, axis=-1)
    out = jnp.concatenate([x1 * c - x2 * s, x2 * c + x1 * s], axis=-1)
    return out.astype(x.dtype)


def window_gqa_sink(x, w_qkv, w_o, sink, cos, sin):
    B, S, _ = x.shape
    nb = S // BLOCK
    qkv = x @ w_qkv
    qd = A_HEADS * A_HEAD_DIM
    kd = A_KV_HEADS * A_HEAD_DIM
    q = qkv[..., :qd].reshape(B, S, A_KV_HEADS, A_GROUP, A_HEAD_DIM)
    k = qkv[..., qd:qd + kd].reshape(B, S, A_KV_HEADS, A_HEAD_DIM)
    v = qkv[..., qd + kd:].reshape(B, S, A_KV_HEADS, A_HEAD_DIM)
    q = apply_rope(q, cos, sin)
    k = apply_rope(k, cos, sin)
    pad = ((0, 0), (WINDOW, WINDOW), (0, 0), (0, 0))
    kp = jnp.pad(k, pad)
    vp = jnp.pad(v, pad)
    qb = jnp.moveaxis(q.reshape(B, nb, BLOCK, A_KV_HEADS, A_GROUP, A_HEAD_DIM), 1, 0)
    span = BLOCK + 2 * WINDOW
    scale = A_HEAD_DIM ** -0.5
    sink_b = sink.astype(jnp.float32).reshape(A_KV_HEADS, A_GROUP)[None, :, :, None, None]
    a_idx = jnp.arange(BLOCK)[:, None]
    c_idx = jnp.arange(span)[None, :]
    rel = c_idx - a_idx

    def block_fn(args):
        n, qn = args
        start = n * BLOCK
        kn = lax.dynamic_slice_in_dim(kp, start, span, axis=1)
        vn = lax.dynamic_slice_in_dim(vp, start, span, axis=1)
        s = jnp.einsum('bqkgd,bckd->bkgqc', qn, kn).astype(jnp.float32) * scale
        j = start + c_idx - WINDOW
        valid = (rel >= 0) & (rel <= 2 * WINDOW) & (j >= 0) & (j < S)
        s = jnp.where(valid[None, None, None], s, -1e30)
        m = jnp.maximum(jnp.max(s, axis=-1, keepdims=True), sink_b)
        p = jnp.exp(s - m)
        denom = jnp.sum(p, axis=-1, keepdims=True) + jnp.exp(sink_b - m)
        return jnp.einsum('bkgqc,bckd->bqkgd', (p / denom).astype(vn.dtype), vn)

    o = lax.map(block_fn, (jnp.arange(nb), qb))
    o = jnp.moveaxis(o, 0, 1).reshape(B, S, A_HEADS * A_HEAD_DIM)
    return o @ w_o


def mla(x, w_in, q_norm, w_q_up, kv_norm, w_kv_up, w_o, cos, sin):
    B, S, _ = x.shape
    nb = S // BLOCK
    h = x @ w_in
    cq = rmsnorm(h[..., :Q_LORA], q_norm)
    ckv = rmsnorm(h[..., Q_LORA:Q_LORA + KV_LORA], kv_norm)
    k_rope = apply_rope(h[..., Q_LORA + KV_LORA:], cos, sin)
    q = (cq @ w_q_up).reshape(B, S, B_HEADS, NOPE_DIM + ROPE_DIM)
    q_nope = q[..., :NOPE_DIM]
    q_rope = apply_rope(q[..., NOPE_DIM:], cos, sin)
    kv = (ckv @ w_kv_up).reshape(B, S, B_HEADS, NOPE_DIM + V_DIM)
    k_nope = kv[..., :NOPE_DIM]
    v = kv[..., NOPE_DIM:]
    scale = (NOPE_DIM + ROPE_DIM) ** -0.5
    qn_b = jnp.moveaxis(q_nope.reshape(B, nb, BLOCK, B_HEADS, NOPE_DIM), 1, 0)
    qr_b = jnp.moveaxis(q_rope.reshape(B, nb, BLOCK, B_HEADS, ROPE_DIM), 1, 0)

    def block_fn(args):
        qn, qr = args
        s = (jnp.einsum('bqhd,bkhd->bhqk', qn, k_nope).astype(jnp.float32)
             + jnp.einsum('bqhr,bkr->bhqk', qr, k_rope).astype(jnp.float32)) * scale
        p = jax.nn.softmax(s, axis=-1)
        return jnp.einsum('bhqk,bkhd->bqhd', p.astype(v.dtype), v)

    o = lax.map(block_fn, (qn_b, qr_b))
    o = jnp.moveaxis(o, 0, 1).reshape(B, S, B_HEADS * V_DIM)
    return o @ w_o


def conv_ffn(x, w_in, conv_w, conv_b, w_out):
    h = x @ w_in
    hp = jnp.pad(h, ((0, 0), (1, 1), (0, 0)))
    h = hp[:, :-2] * conv_w[0] + hp[:, 1:-1] * conv_w[1] + hp[:, 2:] * conv_w[2] + conv_b
    g = h[..., :D_FF]
    u = h[..., D_FF:]
    return (jax.nn.silu(g) * u) @ w_out


def trunk(x, norm_mix, norm_ffn, norm_final, a_w_qkv, a_w_o, a_sink,
          b_w_in, b_q_norm, b_w_q_up, b_kv_norm, b_w_kv_up, b_w_o,
          f_w_in, f_conv_w, f_conv_b, f_w_out):
    S = x.shape[1]
    cos_a, sin_a = rope_tables(S, A_HEAD_DIM)
    cos_b, sin_b = rope_tables(S, ROPE_DIM)
    for i in range(DEPTH):
        h = rmsnorm(x, norm_mix[i])
        j = i // N_MIXERS
        if i % N_MIXERS == 0:
            x = x + window_gqa_sink(h, a_w_qkv[j], a_w_o[j], a_sink[j], cos_a, sin_a)
        else:
            x = x + mla(h, b_w_in[j], b_q_norm[j], b_w_q_up[j], b_kv_norm[j],
                        b_w_kv_up[j], b_w_o[j], cos_b, sin_b)
        x = x + conv_ffn(rmsnorm(x, norm_ffn[i]), f_w_in[i], f_conv_w[i], f_conv_b[i], f_w_out[i])
    return rmsnorm(x, norm_final)


def setup_inputs(seed: int = 0) -> dict:
    key = jax.random.key(seed)
    ks = jax.random.split(key, 20)
    f32 = jnp.float32

    def w(k, shape, fan_in):
        return jax.random.normal(k, shape, f32) * (fan_in ** -0.5)

    def gain(k, shape):
        return 1.0 + 0.05 * jax.random.normal(k, shape, f32)

    qkv_out = (A_HEADS + 2 * A_KV_HEADS) * A_HEAD_DIM
    return {
        "x_prompt": jax.random.normal(ks[0], (BATCH, SEQ, D_MODEL), f32),
        "x_sample": jax.random.normal(ks[1], (DEC_BATCH, DEC_SEQ, D_MODEL), f32),
        "norm_mix": gain(ks[2], (DEPTH, D_MODEL)),
        "norm_ffn": gain(ks[3], (DEPTH, D_MODEL)),
        "norm_final": gain(ks[4], (D_MODEL,)),
        "a_w_qkv": w(ks[5], (N_A_LAYERS, D_MODEL, qkv_out), D_MODEL),
        "a_w_o": w(ks[6], (N_A_LAYERS, A_HEADS * A_HEAD_DIM, D_MODEL), A_HEADS * A_HEAD_DIM),
        "a_sink": 0.5 * jax.random.normal(ks[7], (N_A_LAYERS, A_HEADS), f32),
        "b_w_in": w(ks[8], (N_B_LAYERS, D_MODEL, Q_LORA + KV_LORA + ROPE_DIM), D_MODEL),
        "b_q_norm": gain(ks[9], (N_B_LAYERS, Q_LORA)),
        "b_w_q_up": w(ks[10], (N_B_LAYERS, Q_LORA, B_HEADS * (NOPE_DIM + ROPE_DIM)), Q_LORA),
        "b_kv_norm": gain(ks[11], (N_B_LAYERS, KV_LORA)),
        "b_w_kv_up": w(ks[12], (N_B_LAYERS, KV_LORA, B_HEADS * (NOPE_DIM + V_DIM)), KV_LORA),
        "b_w_o": w(ks[13], (N_B_LAYERS, B_HEADS * V_DIM, D_MODEL), B_HEADS * V_DIM),
        "f_w_in": w(ks[14], (DEPTH, D_MODEL, 2 * D_FF), D_MODEL),
        "f_conv_w": w(ks[15], (DEPTH, CONV_W, 2 * D_FF), CONV_W),
        "f_conv_b": 0.01 * jax.random.normal(ks[16], (DEPTH, 2 * D_FF), f32),
        "f_w_out": w(ks[17], (DEPTH, D_FF, D_MODEL), D_FF),
    }


def reference(x_prompt, x_sample, norm_mix, norm_ffn, norm_final, a_w_qkv, a_w_o, a_sink,
              b_w_in, b_q_norm, b_w_q_up, b_kv_norm, b_w_kv_up, b_w_o,
              f_w_in, f_conv_w, f_conv_b, f_w_out):
    y_prompt = trunk(x_prompt, norm_mix, norm_ffn, norm_final, a_w_qkv, a_w_o, a_sink,
                     b_w_in, b_q_norm, b_w_q_up, b_kv_norm, b_w_kv_up, b_w_o,
                     f_w_in, f_conv_w, f_conv_b, f_w_out)
    y_sample = trunk(x_sample, norm_mix, norm_ffn, norm_final, a_w_qkv, a_w_o, a_sink,
                     b_w_in, b_q_norm, b_w_q_up, b_kv_norm, b_w_kv_up, b_w_o,
                     f_w_in, f_conv_w, f_conv_b, f_w_out)
    return (y_prompt, y_sample)
```

```cpp
#include <hip/hip_runtime.h>
#include <hip/hip_bf16.h>
#include <cstdio>
#include <cstdint>
__device__ __forceinline__ int opaque_tid() { int t = (int)threadIdx.x; asm volatile("" : "+v"(t)); return t; }
namespace pg8 {
#define PG8_LAS __attribute__((address_space(3)))
typedef unsigned short bf16_t;
typedef short bf16x8 __attribute__((ext_vector_type(8)));
typedef float f32x4 __attribute__((ext_vector_type(4)));
typedef unsigned u32x4 __attribute__((ext_vector_type(4)));
constexpr int BM = 256, BK = 64, HALF = 128, HTB = HALF * BK * 2  , STAGE_BYTES = 8 * HTB, NXCD = 8, WGM = 8;

__host__ __device__ __forceinline__ int lds_byte(int r, int c) { const int st = (r >> 4) * 2 + (c >> 5), rr = r & 15, cc = c & 31, ob = rr * 64 + cc * 2; return st * 1024 + (ob ^ (((ob >> 9) & 1) << 5)); }
__host__ __device__ __forceinline__ void stage_rc(int b, int& R, int& C) { const int st = b / 1024, sb = b % 1024, swz = sb ^ (((sb >> 9) & 1) << 5); R = (st >> 1) * 16 + swz / 64; C = (st & 1) * 32 + (swz % 64) / 2; }
__host__ __device__ __forceinline__ int perm32(int rho) { const int n = rho >> 4, i = rho & 15; return 8 * (i >> 2) + 4 * n + (i & 3); }

struct Unit { int pm, pn; };
struct Gemm { const bf16_t* A; const bf16_t* Bt; int M, N, K; };

struct StaticOrder {
    int nM, nN, nwg, G, c;
    __host__ __device__ void init(int M, int N, int G_, int c_) { nM = M / BM; nN = N / BM; nwg = nM * nN; G = G_; c = c_; }
    __host__ __device__ bool next(int i, Unit& u) const {
        const long L = (long)i * G + c; if (L >= nwg) return false;
        int wgid = (int)L; { const int q = nwg / NXCD, r = nwg % NXCD, xcd = wgid % NXCD, off = wgid / NXCD; wgid = (xcd < r ? xcd * (q + 1) : r * (q + 1) + (xcd - r) * q) + off; }
        const int nig = WGM * nN, gid = wgid / nig, fm = gid * WGM, gsz = (nM - fm) < WGM ? (nM - fm) : WGM;
        u.pm = fm + ((wgid % nig) % gsz); u.pn = (wgid % nig) / gsz; return true;
    }
    __device__ __forceinline__ void a_ready(const Unit&) const {}
    __device__ __forceinline__ void done(const Unit&) const {}
};

__device__ __forceinline__ unsigned cvt_pk_bf16(float lo, float hi) { unsigned r; asm volatile("v_cvt_pk_bf16_f32 %0, %1, %2" : "=v"(r) : "v"(lo), "v"(hi)); return r; }
typedef float f32x2 __attribute__((ext_vector_type(2)));
typedef unsigned u32x2 __attribute__((ext_vector_type(2)));

struct EpiBf16Split {
    static constexpr bool PERM = true, AFTER_DRAIN = false, APERM = false;
    bf16_t* O0; bf16_t* O1; int ldc; int split;
    __device__ __forceinline__ void operator()(const f32x4 (&acc)[2][2][4][2], const Unit& u, int wr, int wc, int fr, int fq) const {
        char* base = (char*)((u.pn < split) ? (O0 + (size_t)u.pn * BM) : (O1 + (size_t)(u.pn - split) * BM)) + (size_t)u.pm * BM * ldc * 2;
        const unsigned off0 = (unsigned)((wr * 64 + fr) * ldc + wc * 32 + 8 * fq) * 2u;
#pragma unroll
        for (int ai = 0; ai < 2; ++ai)
#pragma unroll
            for (int m = 0; m < 4; ++m) { const unsigned off = off0 + (unsigned)((ai * HALF + m * 16) * ldc) * 2u;
#pragma unroll
                for (int bj = 0; bj < 2; ++bj) { const f32x4 v0 = acc[ai][bj][m][0], v1 = acc[ai][bj][m][1];
                    u32x4 w; w.x = cvt_pk_bf16(v0[0], v0[1]); w.y = cvt_pk_bf16(v0[2], v0[3]); w.z = cvt_pk_bf16(v1[0], v1[1]); w.w = cvt_pk_bf16(v1[2], v1[3]);
                    *(u32x4*)(base + off + bj * HALF * 2) = w; } }
    }
};

struct EpiRope {
    static constexpr bool PERM = true, AFTER_DRAIN = false, APERM = false;
    bf16_t* O0; bf16_t* O1; bf16_t* O2; int ld0, ld1, ld2, t1, t2, rope_mask; const float* cs; const float* sn; int jn;
    __device__ __forceinline__ void operator()(const f32x4 (&acc)[2][2][4][2], const Unit& u, int wr, int wc, int fr, int fq) const {
        bf16_t* ob; int ldc; bool rope;
        if (u.pn < t1) { ob = O0 + (size_t)u.pn * BM; ldc = ld0; rope = (rope_mask & 1) != 0; }
        else if (u.pn < t2) { ob = O1 + (size_t)(u.pn - t1) * BM; ldc = ld1; rope = (rope_mask & 2) != 0; }
        else { ob = O2 + (size_t)(u.pn - t2) * BM; ldc = ld2; rope = (rope_mask & 4) != 0; }
        char* base = (char*)ob + (size_t)u.pm * BM * ldc * 2;
        const unsigned off0 = (unsigned)((wr * 64 + fr) * ldc + wc * 32 + 8 * fq) * 2u;
        const int pos0 = ((u.pm * BM) & 4095) + wr * 64 + fr;
        const unsigned toff0 = (unsigned)(pos0 * jn + ((wc * 16 + 4 * fq) & (jn - 1))) * 4u;
#pragma unroll
        for (int ai = 0; ai < 2; ++ai)
#pragma unroll
            for (int m = 0; m < 4; ++m) { const unsigned off = off0 + (unsigned)((ai * HALF + m * 16) * ldc) * 2u;
                f32x4 c = (f32x4){1.f, 1.f, 1.f, 1.f}, s = (f32x4){0.f, 0.f, 0.f, 0.f};
                if (rope) { const unsigned toff = toff0 + (unsigned)((ai * HALF + m * 16) * jn) * 4u; c = *(const f32x4*)((const char*)cs + toff); s = *(const f32x4*)((const char*)sn + toff); }
#pragma unroll
                for (int bj = 0; bj < 2; ++bj) { const f32x4 v0 = acc[ai][bj][m][0], v1 = acc[ai][bj][m][1];
                    const float a0 = v0[0] * c[0] - v0[1] * s[0], b0 = v0[1] * c[0] + v0[0] * s[0];
                    const float a1 = v0[2] * c[1] - v0[3] * s[1], b1 = v0[3] * c[1] + v0[2] * s[1];
                    const float a2 = v1[0] * c[2] - v1[1] * s[2], b2 = v1[1] * c[2] + v1[0] * s[2];
                    const float a3 = v1[2] * c[3] - v1[3] * s[3], b3 = v1[3] * c[3] + v1[2] * s[3];
                    u32x4 w; w.x = cvt_pk_bf16(a0, b0); w.y = cvt_pk_bf16(a1, b1); w.z = cvt_pk_bf16(a2, b2); w.w = cvt_pk_bf16(a3, b3);
                    *(u32x4*)(base + off + bj * HALF * 2) = w; }
                asm volatile("" ::: "memory"); }
    }
};

struct EpiResid {
    static constexpr bool PERM = false, AFTER_DRAIN = false, APERM = false;
    const float* base; float* out; int ldc;
    __device__ __forceinline__ void operator()(const f32x4 (&acc)[2][2][4][2], const Unit& u, int wr, int wc, int fr, int fq) const {
        const int col0 = u.pn * BM + wc * 32 + 4 * fq;
#pragma unroll
        for (int ai = 0; ai < 2; ++ai)
#pragma unroll
            for (int m = 0; m < 4; ++m) { const size_t off = (size_t)(u.pm * BM + ai * HALF + wr * 64 + m * 16 + fr) * ldc + col0;
                f32x4 bs[2][2];
#pragma unroll
                for (int bj = 0; bj < 2; ++bj)
#pragma unroll
                    for (int n = 0; n < 2; ++n) bs[bj][n] = *(const f32x4*)(base + off + bj * HALF + n * 16);
#pragma unroll
                for (int bj = 0; bj < 2; ++bj)
#pragma unroll
                    for (int n = 0; n < 2; ++n) *(f32x4*)(out + off + bj * HALF + n * 16) = bs[bj][n] + acc[ai][bj][m][n];
                if (m & 1) asm volatile("" ::: "memory"); }
    }
};

struct EpiF32 {
    static constexpr bool PERM = false, AFTER_DRAIN = false, APERM = false;
    float* out; int ldc; int ncols;
    __device__ __forceinline__ void operator()(const f32x4 (&acc)[2][2][4][2], const Unit& u, int wr, int wc, int fr, int fq) const {
        const int col0 = u.pn * BM + wc * 32 + 4 * fq;
#pragma unroll
        for (int ai = 0; ai < 2; ++ai)
#pragma unroll
            for (int m = 0; m < 4; ++m) { const size_t off = (size_t)(u.pm * BM + ai * HALF + wr * 64 + m * 16 + fr) * ldc;
#pragma unroll
                for (int bj = 0; bj < 2; ++bj)
#pragma unroll
                    for (int n = 0; n < 2; ++n) { const int c = col0 + bj * HALF + n * 16; if (c < ncols) *(f32x4*)(out + off + c) = acc[ai][bj][m][n]; } }
    }
};

struct EpiConv {
    static constexpr bool PERM = true, AFTER_DRAIN = false, APERM = true;
    bf16_t* ACT; float* HALO; const float* cw; const float* cb; PG8_LAS float* xch; int dff;
    __device__ __forceinline__ void operator()(const f32x4 (&acc)[2][2][4][2], const Unit& u, int wr, int wc, int fr, int fq) const {
        const int wid = wr * 4 + wc, dff2 = 2 * dff;
        PG8_LAS float* mine = xch + wid * 256;
        if (fr == 0) {
#pragma unroll
            for (int ai = 0; ai < 2; ++ai)
#pragma unroll
                for (int bj = 0; bj < 2; ++bj)
#pragma unroll
                    for (int n = 0; n < 2; ++n) *(PG8_LAS f32x4*)(mine + (ai * 2 + 0) * 64 + bj * 32 + 8 * fq + 4 * n) = acc[ai][bj][0][n];
            if (wr == 0) {
                float* hp = HALO + ((size_t)u.pm * 4) * dff2 + u.pn * BM + wc * 32 + 8 * fq;
#pragma unroll
                for (int bj = 0; bj < 2; ++bj)
#pragma unroll
                    for (int n = 0; n < 2; ++n) { *(f32x4*)(hp + bj * HALF + 4 * n) = acc[0][bj][0][n]; *(f32x4*)(hp + dff2 + bj * HALF + 4 * n) = acc[0][bj][1][n]; }
            }
        }
        if (fr == 15) {
#pragma unroll
            for (int ai = 0; ai < 2; ++ai)
#pragma unroll
                for (int bj = 0; bj < 2; ++bj)
#pragma unroll
                    for (int n = 0; n < 2; ++n) *(PG8_LAS f32x4*)(mine + (ai * 2 + 1) * 64 + bj * 32 + 8 * fq + 4 * n) = acc[ai][bj][3][n];
            if (wr == 1) {
                float* hp = HALO + ((size_t)u.pm * 4 + 2) * dff2 + u.pn * BM + wc * 32 + 8 * fq;
#pragma unroll
                for (int bj = 0; bj < 2; ++bj)
#pragma unroll
                    for (int n = 0; n < 2; ++n) { *(f32x4*)(hp + bj * HALF + 4 * n) = acc[1][bj][2][n]; *(f32x4*)(hp + dff2 + bj * HALF + 4 * n) = acc[1][bj][3][n]; }
            }
        }
        asm volatile("s_waitcnt lgkmcnt(0)" ::: "memory"); __builtin_amdgcn_s_barrier(); asm volatile("" ::: "memory");
        const PG8_LAS float* oth = xch + ((wr ^ 1) * 4 + wc) * 256;
        const f32x4 zero4 = (f32x4){0.f, 0.f, 0.f, 0.f};
#define PG8_DPP(x, ctrl) __builtin_bit_cast(float, __builtin_amdgcn_update_dpp(0, __builtin_bit_cast(int, (x)), (ctrl), 0xf, 0xf, true))
#pragma unroll
        for (int n = 0; n < 2; ++n) {
            const int gcol = u.pn * HALF + wc * 32 + 8 * fq + 4 * n, ucol = dff + gcol;
            const f32x4 w0g = *(const f32x4*)(cw + gcol), w1g = *(const f32x4*)(cw + dff2 + gcol), w2g = *(const f32x4*)(cw + 2 * dff2 + gcol), bg = *(const f32x4*)(cb + gcol);
            const f32x4 w0u = *(const f32x4*)(cw + ucol), w1u = *(const f32x4*)(cw + dff2 + ucol), w2u = *(const f32x4*)(cw + 2 * dff2 + ucol), bu = *(const f32x4*)(cb + ucol);
            const int xo = 8 * fq + 4 * n;
#pragma unroll
            for (int ai = 0; ai < 2; ++ai) {
                f32x4 pg = zero4, pu = zero4, ng = zero4, nu = zero4;
                if (fr == 0) {
                    if (wr == 1) { pg = *(const PG8_LAS f32x4*)(oth + (ai * 2 + 1) * 64 + xo); pu = *(const PG8_LAS f32x4*)(oth + (ai * 2 + 1) * 64 + 32 + xo); }
                    else if (ai == 1) { pg = *(const PG8_LAS f32x4*)(oth + (0 * 2 + 1) * 64 + xo); pu = *(const PG8_LAS f32x4*)(oth + (0 * 2 + 1) * 64 + 32 + xo); }
                }
                if (fr == 15) {
                    if (wr == 0) { ng = *(const PG8_LAS f32x4*)(oth + (ai * 2 + 0) * 64 + xo); nu = *(const PG8_LAS f32x4*)(oth + (ai * 2 + 0) * 64 + 32 + xo); }
                    else if (ai == 0) { ng = *(const PG8_LAS f32x4*)(oth + (1 * 2 + 0) * 64 + xo); nu = *(const PG8_LAS f32x4*)(oth + (1 * 2 + 0) * 64 + 32 + xo); }
                }
                f32x4 a[4];
#pragma unroll
                for (int e = 0; e < 4; ++e) {
                    const float g0 = acc[ai][0][0][n][e], g1 = acc[ai][0][1][n][e], g2 = acc[ai][0][2][n][e], g3 = acc[ai][0][3][n][e];
                    const float u0 = acc[ai][1][0][n][e], u1 = acc[ai][1][1][n][e], u2 = acc[ai][1][2][n][e], u3 = acc[ai][1][3][n][e];
                    const float gm = PG8_DPP(g3, 0x111) + pg[e], gp = PG8_DPP(g0, 0x101) + ng[e];
                    const float um = PG8_DPP(u3, 0x111) + pu[e], up = PG8_DPP(u0, 0x101) + nu[e];
                    const float cg0 = w0g[e] * gm + w1g[e] * g0 + w2g[e] * g1 + bg[e], cg1 = w0g[e] * g0 + w1g[e] * g1 + w2g[e] * g2 + bg[e];
                    const float cg2 = w0g[e] * g1 + w1g[e] * g2 + w2g[e] * g3 + bg[e], cg3 = w0g[e] * g2 + w1g[e] * g3 + w2g[e] * gp + bg[e];
                    const float cu0 = w0u[e] * um + w1u[e] * u0 + w2u[e] * u1 + bu[e], cu1 = w0u[e] * u0 + w1u[e] * u1 + w2u[e] * u2 + bu[e];
                    const float cu2 = w0u[e] * u1 + w1u[e] * u2 + w2u[e] * u3 + bu[e], cu3 = w0u[e] * u2 + w1u[e] * u3 + w2u[e] * up + bu[e];
                    a[0][e] = cg0 * __builtin_amdgcn_rcpf(1.0f + __builtin_amdgcn_exp2f(-1.4426950408889634f * cg0)) * cu0;
                    a[1][e] = cg1 * __builtin_amdgcn_rcpf(1.0f + __builtin_amdgcn_exp2f(-1.4426950408889634f * cg1)) * cu1;
                    a[2][e] = cg2 * __builtin_amdgcn_rcpf(1.0f + __builtin_amdgcn_exp2f(-1.4426950408889634f * cg2)) * cu2;
                    a[3][e] = cg3 * __builtin_amdgcn_rcpf(1.0f + __builtin_amdgcn_exp2f(-1.4426950408889634f * cg3)) * cu3;
                }
#pragma unroll
                for (int m = 0; m < 4; ++m) { u32x2 w; w.x = cvt_pk_bf16(a[m][0], a[m][1]); w.y = cvt_pk_bf16(a[m][2], a[m][3]);
                    const int row = u.pm * BM + ai * HALF + wr * 64 + 4 * fr + m;
                    *(u32x2*)(ACT + (size_t)row * dff + gcol) = w; }
            }
        }
#undef PG8_DPP
    }
};
template <class Epi, class Sched, bool ALIGN_EPI = false, bool SP2 = false>
__device__ __forceinline__ void gemm_phase(PG8_LAS unsigned char* lds, const Gemm g, const Sched& S, const Epi& E) {
    const int tid = opaque_tid(), wid = __builtin_amdgcn_readfirstlane(tid >> 6), lane = tid & 63, wr = wid >> 2, wc = wid & 3, fr = lane & 15, fq = lane >> 4;
    const int K = g.K, nt = K / BK;
    unsigned voffA[2], voffB[2];
#pragma unroll
    for (int i = 0; i < 2; ++i) { int R, C; stage_rc(tid * 16 + i * 8192, R, C); const int Rb = Epi::PERM ? ((R & ~31) + perm32(R & 31)) : R;
        const int Ra = Epi::APERM ? ((R & ~63) + 4 * (R & 15) + ((R >> 4) & 3)) : R;
        voffA[i] = (unsigned)(Ra * K + C) * 2u; voffB[i] = (unsigned)(Rb * K + C) * 2u; }
    const size_t kstep = (size_t)(BK * 2);
    const size_t hstep = (size_t)HALF * K * 2;
    const size_t tstep = 2 * hstep;
    const unsigned ldsw = (unsigned)wid * 1024u;
    const int aoff = lds_byte(wr * 64 + fr, fq * 8), boff = lds_byte(wc * 32 + fr, fq * 8);
#define PG8_SA(b, h) (((b) * 2 + (h)) * HTB)
#define PG8_SB(b, h) ((4 + (b) * 2 + (h)) * HTB)
#define PG8_STAGE(bufoff, gbase, voff) do { _Pragma("unroll") for (int _i = 0; _i < 2; ++_i) \
        __builtin_amdgcn_global_load_lds((const unsigned*)((const char*)(gbase) + (voff)[_i]), (PG8_LAS unsigned*)(lds + (bufoff) + ldsw + _i * 8192), 16, 0, 0); } while (0)
#define PG8_LDA(dst, b, h) do { _Pragma("unroll") for (int m = 0; m < 4; ++m) _Pragma("unroll") for (int k = 0; k < 2; ++k) dst[m][k] = *(const PG8_LAS bf16x8*)(lds + PG8_SA(b, h) + aoff + m * 2048 + k * 1024); } while (0)
#define PG8_LDB(dst, b, h) do { _Pragma("unroll") for (int n = 0; n < 2; ++n) _Pragma("unroll") for (int k = 0; k < 2; ++k) dst[n][k] = *(const PG8_LAS bf16x8*)(lds + PG8_SB(b, h) + boff + n * 2048 + k * 1024); } while (0)
#define PG8_MMA(ai, bj, At, Bt) do { __builtin_amdgcn_s_setprio(1); _Pragma("unroll") for (int m = 0; m < 4; ++m) _Pragma("unroll") for (int n = 0; n < 2; ++n) _Pragma("unroll") for (int k = 0; k < 2; ++k) \
        acc[ai][bj][m][n] = __builtin_amdgcn_mfma_f32_16x16x32_bf16(Bt[n][k], At[m][k], acc[ai][bj][m][n], 0, 0, 0); __builtin_amdgcn_s_setprio(0); } while (0)
#define PG8_WAIT_V(n) asm volatile("s_waitcnt vmcnt(" #n ")" ::: "memory")
#define PG8_WAIT_L(n) asm volatile("s_waitcnt lgkmcnt(" #n ")" ::: "memory")
#define PG8_BAR __builtin_amdgcn_s_barrier()
#define PG8_SCHED __builtin_amdgcn_sched_barrier(0)
    Unit cur, nxt; int ui = 0;
    if (!S.next(0, cur)) return;
    f32x4 acc[2][2][4][2];
#pragma unroll
    for (int a = 0; a < 2; ++a)
#pragma unroll
        for (int b = 0; b < 2; ++b)
#pragma unroll
            for (int m = 0; m < 4; ++m)
#pragma unroll
                for (int n = 0; n < 2; ++n) acc[a][b][m][n] = (f32x4){0.f, 0.f, 0.f, 0.f};
    bf16x8 At[4][2], B0[2][2], B1[2][2];
    const char* cA = (const char*)g.A + (size_t)cur.pm * tstep; const char* cB = (const char*)g.Bt + (size_t)cur.pn * tstep;
    S.a_ready(cur);
    if constexpr (SP2) {
        PG8_STAGE(PG8_SB(0, 0), cB, voffB); PG8_STAGE(PG8_SB(0, 1), cB + hstep, voffB); PG8_STAGE(PG8_SA(0, 0), cA, voffA); PG8_STAGE(PG8_SA(0, 1), cA + hstep, voffA);
        if (wr == 1) PG8_BAR;
        PG8_WAIT_V(2); PG8_BAR;
        PG8_STAGE(PG8_SB(1, 0), cB + kstep, voffB); PG8_STAGE(PG8_SA(1, 0), cA + kstep, voffA); PG8_STAGE(PG8_SB(1, 1), cB + hstep + kstep, voffB);
        PG8_WAIT_V(6); PG8_BAR;
    } else {
        PG8_STAGE(PG8_SB(0, 0), cB, voffB); PG8_STAGE(PG8_SA(0, 0), cA, voffA); PG8_STAGE(PG8_SB(0, 1), cB + hstep, voffB); PG8_STAGE(PG8_SA(0, 1), cA + hstep, voffA);
        if (wr == 1) PG8_BAR;
        PG8_WAIT_V(4); PG8_BAR;
        PG8_STAGE(PG8_SB(1, 0), cB + kstep, voffB); PG8_STAGE(PG8_SA(1, 0), cA + kstep, voffA); PG8_STAGE(PG8_SB(1, 1), cB + hstep + kstep, voffB);
        PG8_WAIT_V(6); PG8_BAR;
    }
    for (;;) {
        const bool has_next = S.next(ui + 1, nxt);
        const char* nA = has_next ? (const char*)g.A + (size_t)nxt.pm * tstep : cA; const char* nB = has_next ? (const char*)g.Bt + (size_t)nxt.pn * tstep : cB;
        for (int t = 0; t < nt; t += 2) {
            const bool last = (t == nt - 2);
            const char* a1 = cA + (size_t)(t + 1) * kstep;
            const char* a2 = last ? nA : cA + (size_t)(t + 2) * kstep; const char* b2 = last ? nB : cB + (size_t)(t + 2) * kstep;
            const char* a3 = a2 + kstep; const char* b3 = b2 + kstep;
            if (last && has_next) S.a_ready(nxt);
            if constexpr (SP2) {
            PG8_LDB(B0, 0, 0); PG8_LDB(B1, 0, 1); PG8_SCHED; PG8_LDA(At, 0, 0); PG8_STAGE(PG8_SA(1, 1), a1 + hstep, voffA);
            PG8_WAIT_V(8); PG8_WAIT_L(0); PG8_BAR; PG8_MMA(0, 0, At, B0); PG8_MMA(0, 1, At, B1); PG8_BAR; PG8_SCHED;
            PG8_LDA(At, 0, 1); PG8_STAGE(PG8_SB(0, 0), b2, voffB); PG8_STAGE(PG8_SB(0, 1), b2 + hstep, voffB); PG8_STAGE(PG8_SA(0, 0), a2, voffA);
            PG8_WAIT_V(8); PG8_WAIT_L(0); PG8_BAR; PG8_MMA(1, 0, At, B0); PG8_MMA(1, 1, At, B1); PG8_BAR; PG8_SCHED;
            PG8_LDB(B0, 1, 0); PG8_LDB(B1, 1, 1); PG8_SCHED; PG8_LDA(At, 1, 0); PG8_STAGE(PG8_SA(0, 1), a2 + hstep, voffA);
            PG8_WAIT_V(8); PG8_WAIT_L(0); PG8_BAR; PG8_MMA(0, 0, At, B0); PG8_MMA(0, 1, At, B1); PG8_BAR; PG8_SCHED;
            PG8_LDA(At, 1, 1); PG8_STAGE(PG8_SB(1, 0), b3, voffB); PG8_STAGE(PG8_SB(1, 1), b3 + hstep, voffB); PG8_STAGE(PG8_SA(1, 0), a3, voffA);
            PG8_WAIT_V(8); PG8_WAIT_L(0); PG8_BAR; PG8_MMA(1, 0, At, B0); PG8_MMA(1, 1, At, B1); PG8_BAR; PG8_SCHED;
            } else {
            PG8_LDB(B0, 0, 0); PG8_SCHED; PG8_LDA(At, 0, 0); PG8_STAGE(PG8_SA(1, 1), a1 + hstep, voffA);
            PG8_WAIT_L(8); PG8_BAR; PG8_WAIT_L(0); PG8_MMA(0, 0, At, B0); PG8_BAR; PG8_SCHED;
            PG8_LDB(B1, 0, 1); PG8_STAGE(PG8_SB(0, 0), b2, voffB);
            PG8_BAR; PG8_WAIT_L(0); PG8_MMA(0, 1, At, B1); PG8_BAR;
            PG8_LDA(At, 0, 1); PG8_STAGE(PG8_SA(0, 0), a2, voffA);
            PG8_BAR; PG8_WAIT_L(0); PG8_MMA(1, 0, At, B0); PG8_BAR; PG8_SCHED;
            PG8_STAGE(PG8_SB(0, 1), b2 + hstep, voffB);
            PG8_WAIT_V(6); PG8_BAR; PG8_MMA(1, 1, At, B1); PG8_BAR;
            PG8_LDB(B0, 1, 0); PG8_SCHED; PG8_LDA(At, 1, 0); PG8_STAGE(PG8_SA(0, 1), a2 + hstep, voffA);
            PG8_WAIT_L(8); PG8_BAR; PG8_WAIT_L(0); PG8_MMA(0, 0, At, B0); PG8_BAR; PG8_SCHED;
            PG8_LDB(B1, 1, 1); PG8_STAGE(PG8_SB(1, 0), b3, voffB);
            PG8_BAR; PG8_WAIT_L(0); PG8_MMA(0, 1, At, B1); PG8_BAR;
            PG8_LDA(At, 1, 1); PG8_STAGE(PG8_SA(1, 0), a3, voffA);
            PG8_BAR; PG8_WAIT_L(0); PG8_MMA(1, 0, At, B0); PG8_BAR; PG8_SCHED;
            PG8_STAGE(PG8_SB(1, 1), b3 + hstep, voffB);
            PG8_WAIT_V(6); PG8_BAR; PG8_MMA(1, 1, At, B1); PG8_BAR;
            }
        }
        if constexpr (ALIGN_EPI) { if (wr == 0) PG8_BAR; }
        if constexpr (!Epi::AFTER_DRAIN) { E(acc, cur, wr, wc, fr, fq); S.done(cur); }
        if (!has_next) break;
#pragma unroll
        for (int a = 0; a < 2; ++a)
#pragma unroll
            for (int b = 0; b < 2; ++b)
#pragma unroll
                for (int m = 0; m < 4; ++m)
#pragma unroll
                    for (int n = 0; n < 2; ++n) acc[a][b][m][n] = (f32x4){0.f, 0.f, 0.f, 0.f};
        cur = nxt; cA = nA; cB = nB; ++ui;
        if constexpr (ALIGN_EPI) { if (wr == 1) PG8_BAR; }
    }
    PG8_WAIT_V(0);
    if constexpr (!ALIGN_EPI) { if (wr == 0) PG8_BAR; }
    PG8_BAR;
    if constexpr (Epi::AFTER_DRAIN) { E.fused(acc, cur, wr, wc, fr, fq, lds, wid, lane); S.done(cur); }
#undef PG8_SA
#undef PG8_SB
#undef PG8_STAGE
#undef PG8_LDA
#undef PG8_LDB
#undef PG8_MMA
#undef PG8_WAIT_V
#undef PG8_WAIT_L
#undef PG8_BAR
#undef PG8_SCHED
}
}
namespace att {
using bf16 = unsigned short;
using bf16x8 = __attribute__((ext_vector_type(8))) short;
using s16x4  = __attribute__((ext_vector_type(4))) short;
using f32x16 = __attribute__((ext_vector_type(16))) float;
using u32x4  = __attribute__((ext_vector_type(4))) unsigned;
#define ATT_LAS __attribute__((address_space(3)))
constexpr int D = 128, NW = 8, QBLK = 32, KVBLK = 64;
constexpr float THR = 8.f;
constexpr int SHM_V = KVBLK * D * 2, SHM_K = KVBLK * D * 2, SHM_R = KVBLK * 64 * 2;
constexpr int SHM_ATTN = 3 * (SHM_K + SHM_V + SHM_R) + NW * 64 * 4;
#define KSWZ(row, colB) ((row) * 256 + ((colB) ^ (((row) & 7) << 4)))
#define RSWZ(row, colB) ((row) * 128 + ((colB) ^ (((row) & 7) << 4)))
#define SBAR() __builtin_amdgcn_sched_barrier(0)
__device__ __forceinline__ int crow(int r, int hi) { return (r & 3) + 8 * (r >> 2) + 4 * hi; }
__device__ __forceinline__ unsigned cvtpk(float lo, float hi) { unsigned r; asm volatile("v_cvt_pk_bf16_f32 %0, %1, %2" : "=v"(r) : "v"(lo), "v"(hi)); return r; }

template <int NRB> struct Sc { static constexpr float SCALE = NRB ? 0.07216878364870322f : 0.08838834764831845f; };

template <int NRB> __device__ __forceinline__ void partialSM(f32x16& p0, f32x16& p1, float& m_reg, float& mn, float& alpha) {
  constexpr float SCALE = Sc<NRB>::SCALE, C = SCALE * 1.4426950408889634f;
  float pmax = p0[0];
#pragma unroll
  for (int r = 1; r < 16; ++r) pmax = fmaxf(pmax, p0[r]);
#pragma unroll
  for (int r = 0; r < 16; ++r) pmax = fmaxf(pmax, p1[r]);
  { auto rr = __builtin_amdgcn_permlane32_swap(__float_as_uint(pmax), __float_as_uint(pmax), false, false);
    pmax = fmaxf(__uint_as_float(rr[0]), __uint_as_float(rr[1])); }
  if (__builtin_expect(__all(pmax - m_reg <= THR / SCALE), 1)) { mn = m_reg; alpha = 1.f; }
  else { mn = fmaxf(m_reg, pmax); alpha = __builtin_amdgcn_exp2f((m_reg - mn) * C); m_reg = mn; }
  const float mnC = -mn * C;
#pragma unroll
  for (int r = 0; r < 16; ++r) p0[r] = fmaf(p0[r], C, mnC);
#pragma unroll
  for (int r = 0; r < 16; ++r) p1[r] = fmaf(p1[r], C, mnC);
#pragma unroll
  for (int r = 0; r < 16; ++r) p0[r] = __builtin_amdgcn_exp2f(p0[r]);
}
__device__ __forceinline__ void finishSM(f32x16& p0, f32x16& p1, float alpha, float& l_reg, bf16x8& pa0, bf16x8& pa1, bf16x8& pa2, bf16x8& pa3) {
#pragma unroll
  for (int r = 0; r < 16; ++r) p1[r] = __builtin_amdgcn_exp2f(p1[r]);
  float ps = 0;
#pragma unroll
  for (int r = 0; r < 16; ++r) ps += p0[r];
#pragma unroll
  for (int r = 0; r < 16; ++r) ps += p1[r];
  { auto rr = __builtin_amdgcn_permlane32_swap(__float_as_uint(ps), __float_as_uint(ps), false, false);
    ps = __uint_as_float(rr[0]) + __uint_as_float(rr[1]); }
  l_reg = l_reg * alpha + ps;
#define PK4(P, BASE, OUT) do { unsigned a0 = cvtpk(P[BASE + 0], P[BASE + 1]), a1 = cvtpk(P[BASE + 2], P[BASE + 3]);   \
    unsigned b0 = cvtpk(P[BASE + 4], P[BASE + 5]), b1 = cvtpk(P[BASE + 6], P[BASE + 7]);                              \
    auto r0 = __builtin_amdgcn_permlane32_swap(a0, b0, false, false); auto r1 = __builtin_amdgcn_permlane32_swap(a1, b1, false, false); \
    u32x4 w = {r0[0], r1[0], r0[1], r1[1]}; OUT = *reinterpret_cast<bf16x8*>(&w); } while (0)
  PK4(p0, 0, pa0); PK4(p0, 8, pa1); PK4(p1, 0, pa2); PK4(p1, 8, pa3);
#undef PK4
}
template <int NRB> __device__ __forceinline__ void qkt(f32x16& p0, f32x16& p1, const ATT_LAS char* Ks, const ATT_LAS char* Rs, const bf16x8* qr, int r32, int hi) {
  p0 = f32x16{}; p1 = f32x16{};
#pragma unroll
  for (int d0 = 0; d0 < 8; ++d0) { const int cb = (d0 * 16 + hi * 8) * 2;
    const bf16x8 b0 = *reinterpret_cast<const ATT_LAS bf16x8*>(Ks + KSWZ(r32, cb));
    const bf16x8 b1 = *reinterpret_cast<const ATT_LAS bf16x8*>(Ks + KSWZ(32 + r32, cb));
    p0 = __builtin_amdgcn_mfma_f32_32x32x16_bf16(b0, qr[d0], p0, 0, 0, 0);
    p1 = __builtin_amdgcn_mfma_f32_32x32x16_bf16(b1, qr[d0], p1, 0, 0, 0); }
#pragma unroll
  for (int d0 = 0; d0 < NRB; ++d0) { const int cb = (d0 * 16 + hi * 8) * 2;
    const bf16x8 b0 = *reinterpret_cast<const ATT_LAS bf16x8*>(Rs + RSWZ(r32, cb));
    const bf16x8 b1 = *reinterpret_cast<const ATT_LAS bf16x8*>(Rs + RSWZ(32 + r32, cb));
    p0 = __builtin_amdgcn_mfma_f32_32x32x16_bf16(b0, qr[8 + d0], p0, 0, 0, 0);
    p1 = __builtin_amdgcn_mfma_f32_32x32x16_bf16(b1, qr[8 + d0], p1, 0, 0, 0); }
}
__device__ __forceinline__ void wmask(f32x16& p0, f32x16& p1, int j, int qrel, int hi) {
  const int base = 64 * j + 4 * hi - qrel + 128;
#pragma unroll
  for (int r = 0; r < 16; ++r) { const int d = base + (r & 3) + 8 * (r >> 2);
    if ((unsigned)d > 256u) p0[r] = -1e30f;
    if ((unsigned)(d + 32) > 256u) p1[r] = -1e30f; }
}
__device__ __forceinline__ int v_st(int k, int c) { const int kk = (k & ~0xC) | ((k & 4) << 1) | ((k & 8) >> 1); return ((kk >> 3) * 4 + (c >> 5)) * 512 + ((kk & 7) * 32 + (c & 31)) * 2; }
__device__ __forceinline__ int v_rd_base(int lane) { return ((lane & 3) << 3) | (((lane >> 2) & 3) << 6) | (((lane >> 4) & 1) << 5) | (((lane >> 5) & 1) << 8); }
constexpr int v_rd_off(int d0, int ks, int half) { return d0 * 512 + ks * 4096 + half * 2048; }
template <int OFF> __device__ __forceinline__ s16x4 tr_read(int vb) {
  s16x4 r; asm volatile("ds_read_b64_tr_b16 %0, %1 offset:%2" : "=&v"(r) : "v"(vb), "i"(OFF) : "memory"); return r;
}
template <int D0> __device__ __forceinline__ void pv_one(f32x16& od, int vb, bf16x8 pa0, bf16x8 pa1, bf16x8 pa2, bf16x8 pa3) {
  const s16x4 l0 = tr_read<v_rd_off(D0, 0, 0)>(vb), h0 = tr_read<v_rd_off(D0, 0, 1)>(vb), l1 = tr_read<v_rd_off(D0, 1, 0)>(vb), h1 = tr_read<v_rd_off(D0, 1, 1)>(vb);
  const s16x4 l2 = tr_read<v_rd_off(D0, 2, 0)>(vb), h2 = tr_read<v_rd_off(D0, 2, 1)>(vb), l3 = tr_read<v_rd_off(D0, 3, 0)>(vb), h3 = tr_read<v_rd_off(D0, 3, 1)>(vb);
  asm volatile("s_waitcnt lgkmcnt(0)" ::: "memory"); SBAR();
#define PK(L, H) (bf16x8){L[0], L[1], L[2], L[3], H[0], H[1], H[2], H[3]}
  od = __builtin_amdgcn_mfma_f32_32x32x16_bf16(pa0, PK(l0, h0), od, 0, 0, 0);
  od = __builtin_amdgcn_mfma_f32_32x32x16_bf16(pa1, PK(l1, h1), od, 0, 0, 0);
  od = __builtin_amdgcn_mfma_f32_32x32x16_bf16(pa2, PK(l2, h2), od, 0, 0, 0);
  od = __builtin_amdgcn_mfma_f32_32x32x16_bf16(pa3, PK(l3, h3), od, 0, 0, 0);
#undef PK
}
__device__ __forceinline__ void pv_d0(f32x16* o, int vb, bf16x8 pa0, bf16x8 pa1, bf16x8 pa2, bf16x8 pa3) {
  pv_one<0>(o[0], vb, pa0, pa1, pa2, pa3); pv_one<1>(o[1], vb, pa0, pa1, pa2, pa3); pv_one<2>(o[2], vb, pa0, pa1, pa2, pa3); pv_one<3>(o[3], vb, pa0, pa1, pa2, pa3);
}

__device__ __forceinline__ void glds16(const void* gsrc, unsigned lds_dst) { unsigned keep;
  asm volatile("s_mov_b32 %0, m0\n\ts_mov_b32 m0, %2\n\ts_nop 0\n\tglobal_load_lds_dwordx4 %1, off\n\ts_mov_b32 m0, %0" : "=&s"(keep) : "v"(gsrc), "s"(lds_dst) : "memory"); }

template <int NRB, bool WIN>
__device__ __forceinline__ void attn_body(const bf16* __restrict__ Qb, int ldq, const bf16* __restrict__ Qrb, int ldqr,
                                          const bf16* __restrict__ Kh, int ldk, const bf16* __restrict__ Krh, int ldkr,
                                          const bf16* __restrict__ Vh, int ldv, bf16* __restrict__ Ob, int ldo,
                                          int NT, int qrel0, float m0, float l0, ATT_LAS char* lds) {
  const int tid = opaque_tid(), wid = __builtin_amdgcn_readfirstlane(tid >> 6), lane = tid & 63, r32 = lane & 31, hi = lane >> 5;
  constexpr int SLOT = SHM_K + SHM_V + SHM_R;
  constexpr int OFFK = 0, OFFV = SHM_K, OFFR = SHM_K + SHM_V, OFFWS = 3 * SLOT;
  ATT_LAS float* ws = (ATT_LAS float*)(lds + OFFWS) + wid * 64; ATT_LAS float* li_l = ws; ATT_LAS float* al_l = ws + 32;
  float m_reg = m0, l_reg = l0; f32x16 o[4] = {}; bf16x8 qr[8 + NRB];
  const unsigned lds0 = (unsigned)(uintptr_t)lds;
  long kof[2], vof[2], rof = 0;
#pragma unroll
  for (int p = 0; p < 2; ++p) { const int c = 2 * wid + p;
    { const int row = 4 * c + (lane >> 4), cb = (16 * (lane & 15)) ^ ((row & 7) << 4); kof[p] = (long)row * ldk + (cb >> 1); }
    { const int kk = 8 * (c >> 1) + ((lane & 31) >> 2), key = (kk & ~0xC) | ((kk & 4) << 1) | ((kk & 8) >> 1), col = 32 * (2 * (c & 1) + (lane >> 5)) + 8 * (lane & 3); vof[p] = (long)key * ldv + col; } }
  if constexpr (NRB > 0) { const int row = 8 * wid + (lane >> 3), cb = (16 * (lane & 7)) ^ ((row & 7) << 4); rof = (long)row * ldkr + (cb >> 1); }
#define DMA_TILE(t, slotoff) do { const unsigned d_ = (unsigned)__builtin_amdgcn_readfirstlane((int)(lds0 + (slotoff) + wid * 2048)); \
    glds16(Kh + (long)(t) * KVBLK * ldk + kof[0], d_ + OFFK); glds16(Kh + (long)(t) * KVBLK * ldk + kof[1], d_ + OFFK + 1024); \
    glds16(Vh + (long)(t) * KVBLK * ldv + vof[0], d_ + OFFV); glds16(Vh + (long)(t) * KVBLK * ldv + vof[1], d_ + OFFV + 1024); \
    if constexpr (NRB > 0) glds16(Krh + (long)(t) * KVBLK * ldkr + rof, (unsigned)__builtin_amdgcn_readfirstlane((int)(lds0 + (slotoff) + OFFR + wid * 1024))); } while (0)
  DMA_TILE(0, 0); DMA_TILE(1, SLOT);
  const bf16* Qw = Qb + (long)(wid * QBLK + r32) * ldq + hi * 8;
#pragma unroll
  for (int d0 = 0; d0 < 8; ++d0) qr[d0] = *reinterpret_cast<const bf16x8*>(Qw + d0 * 16);
  if constexpr (NRB > 0) { const bf16* Qrw = Qrb + (long)(wid * QBLK + r32) * ldqr + hi * 8;
#pragma unroll
    for (int d0 = 0; d0 < NRB; ++d0) qr[8 + d0] = *reinterpret_cast<const bf16x8*>(Qrw + d0 * 16); }
  const int vrd = v_rd_base(lane);
  const int qrel = qrel0 + wid * QBLK + r32;
#define WAITSYNC() do { asm volatile("s_waitcnt vmcnt(0)" ::: "memory"); __syncthreads(); } while (0)
#define RESC(a) do { if (__any((a) < 1.f)) { if (hi == 0) al_l[r32] = (a); asm volatile("s_waitcnt lgkmcnt(0)" ::: "memory"); \
    _Pragma("unroll") for (int d = 0; d < 4; ++d) _Pragma("unroll") for (int r = 0; r < 16; ++r) o[d][r] *= al_l[crow(r, hi)]; } } while (0)
  f32x16 pA0, pA1, pB0, pB1; float mnA, mnB, alA, alB; bf16x8 pa0, pa1, pa2, pa3;
  int s_prev = 0, s_cur = 0, s_next = SLOT;
#define ROT() do { s_prev = s_cur; s_cur = s_next; s_next = (s_next == 2 * SLOT) ? 0 : s_next + SLOT; } while (0)
  WAITSYNC();
  if (2 < NT) DMA_TILE(2, 2 * SLOT);
  qkt<NRB>(pA0, pA1, lds + OFFK, lds + OFFR, qr, r32, hi); if constexpr (WIN) wmask(pA0, pA1, 0, qrel, hi); partialSM<NRB>(pA0, pA1, m_reg, mnA, alA);
  ROT();
#define STEP(C0, C1, mnC, alC, P0, P1, alP, t) do { \
    SBAR(); qkt<NRB>(C0, C1, lds + s_cur + OFFK, lds + s_cur + OFFR, qr, r32, hi); if constexpr (WIN) wmask(C0, C1, (t), qrel, hi); \
    finishSM(P0, P1, alP, l_reg, pa0, pa1, pa2, pa3); SBAR(); \
    pv_d0(o, (int)lds0 + s_prev + OFFV + vrd, pa0, pa1, pa2, pa3); partialSM<NRB>(C0, C1, m_reg, mnC, alC); \
    WAITSYNC(); \
    if ((t) + 2 < NT) DMA_TILE((t) + 2, s_prev); \
    RESC(alC); ROT(); } while (0)
  for (int t = 1; t + 1 < NT; t += 2) {
    STEP(pB0, pB1, mnB, alB, pA0, pA1, alA, t);
    STEP(pA0, pA1, mnA, alA, pB0, pB1, alB, t + 1);
  }
  STEP(pB0, pB1, mnB, alB, pA0, pA1, alA, NT - 1);
  finishSM(pB0, pB1, alB, l_reg, pa0, pa1, pa2, pa3); SBAR();
  pv_d0(o, (int)lds0 + s_prev + OFFV + vrd, pa0, pa1, pa2, pa3);
  if (hi == 0) li_l[r32] = l_reg; asm volatile("s_waitcnt lgkmcnt(0)" ::: "memory");
  float rli[16];
#pragma unroll
  for (int r = 0; r < 16; ++r) rli[r] = __builtin_amdgcn_rcpf(li_l[crow(r, hi)]);
  bf16* Ow = Ob + (long)(wid * QBLK) * ldo;
#pragma unroll
  for (int r = 0; r < 16; ++r) { const int orow = crow(r, hi);
#pragma unroll
    for (int d0 = 0; d0 < 4; ++d0) { const unsigned w = cvtpk(o[d0][r] * rli[r], 0.f); Ow[(long)orow * ldo + d0 * 32 + r32] = (bf16)(w & 0xffffu); } }
  __syncthreads();
#undef DMA_TILE
#undef WAITSYNC
#undef RESC
#undef ROT
#undef STEP
}
#undef SBAR
}
#define GAS __attribute__((address_space(1)))
#define LAS __attribute__((address_space(3)))
typedef unsigned short bf16;
typedef unsigned v4u __attribute__((ext_vector_type(4)));
typedef float f32x4 __attribute__((ext_vector_type(4)));
typedef short bf16x8 __attribute__((ext_vector_type(8)));
typedef GAS unsigned gu32;
typedef GAS unsigned long long gu64;
#define RLX_AGENT __ATOMIC_RELAXED, __HIP_MEMORY_SCOPE_AGENT
#define LDS_WAIT() asm volatile("s_waitcnt lgkmcnt(0)" ::: "memory")
#define VM_WAIT() asm volatile("s_waitcnt vmcnt(0)" ::: "memory")
__device__ __forceinline__ unsigned long long rt() { return __builtin_amdgcn_s_memrealtime(); }
__device__ __forceinline__ unsigned f2bf(float f) { unsigned u = __builtin_bit_cast(unsigned, f); return (u + 0x7fffu + ((u >> 16) & 1u)) >> 16; }
__device__ __forceinline__ unsigned pk2(float lo, float hi) { return f2bf(lo) | (f2bf(hi) << 16); }

#define XB_TMO      128
#define XB_XCNT(j)  (256  + 64 * (j))
#define XB_XSUB(j)  (1280 + 64 * (j))
#define XB_XGEN(j)  (2304 + 64 * (j))
#define XB_TOP      3328
#define XB_TOPGEN   3392
#define XCD_BAR_WORDS 3456
#define XB_SPIN_CAP (1u << 18)

__device__ __forceinline__ unsigned xb_ld(unsigned* p)              { return __hip_atomic_load(p, __ATOMIC_RELAXED, __HIP_MEMORY_SCOPE_AGENT); }
__device__ __forceinline__ unsigned xb_add(unsigned* p, unsigned v) { return __hip_atomic_fetch_add(p, v, __ATOMIC_RELAXED, __HIP_MEMORY_SCOPE_AGENT); }
__device__ __forceinline__ unsigned xb_xcc_id() { return (unsigned)__builtin_amdgcn_s_getreg((3 << 11) | 20) & 0xFu; }
#define XB_SPIN(cond, bar) do { unsigned _sp = 0; while (cond) { __builtin_amdgcn_s_sleep(1); \
    if ((++_sp & 255u) == 0u) { if (xb_ld(&(bar)[XB_TMO])) break; if (_sp > XB_SPIN_CAP) { atomicAdd(&(bar)[XB_TMO], 1u); break; } } } } while (0)

struct XcdBarrier {
    unsigned* bar; unsigned x;
    volatile LAS unsigned* st;
};

__device__ __forceinline__ XcdBarrier xcd_barrier_post(unsigned* bar, volatile LAS unsigned* st) {
    XcdBarrier b; b.bar = bar; b.x = xb_xcc_id(); b.st = st;
    if (threadIdx.x == 0) (void)xb_add(&bar[XB_XCNT(b.x)], 1u);
    return b;
}
__device__ __forceinline__ void xcd_barrier_complete(unsigned* bar, unsigned x, unsigned& nloc, unsigned& nx) {
    const unsigned G = gridDim.x * gridDim.y * gridDim.z;
    unsigned sum, cnt, mine, sp = 0u;
    for (;;) {
        sum = 0u; cnt = 0u; mine = 0u;
#pragma unroll
        for (unsigned j = 0; j < 16; ++j) { const unsigned c = xb_ld(&bar[XB_XCNT(j)]); sum += c; cnt += (c > 0u) ? 1u : 0u; mine = (j == x) ? c : mine; }
        if (sum == G) break;
        __builtin_amdgcn_s_sleep(1);
        if ((++sp & 255u) == 0u) { if (xb_ld(&bar[XB_TMO])) break; if (sp > XB_SPIN_CAP) { atomicAdd(&bar[XB_TMO], 1u); break; } }
    }
    nloc = mine > 0u ? mine : 1u; nx = cnt > 0u ? cnt : 1u;
}

__device__ __forceinline__ void xcd_barrier(const XcdBarrier& b) {
    asm volatile("s_waitcnt vmcnt(0)" ::: "memory");
    __syncthreads();
    if (threadIdx.x == 0) {
        unsigned* bar = b.bar;
        __builtin_amdgcn_s_waitcnt(0);
        unsigned nloc = b.st[0], nx = b.st[1];
        if (nloc == 0u) { xcd_barrier_complete(bar, b.x, nloc, nx); b.st[0] = nloc; b.st[1] = nx; }
        const unsigned old = xb_add(&bar[XB_XSUB(b.x)], 1u);
        const unsigned gen = old / nloc;
        if (old + 1u == (gen + 1u) * nloc) {
            __builtin_amdgcn_fence(__ATOMIC_RELEASE, "agent");
            asm volatile("s_waitcnt vmcnt(0)" ::: "memory");
            const unsigned og = xb_add(&bar[XB_TOP], 1u);
            const unsigned tg = og / nx;
            if (og + 1u == (tg + 1u) * nx) xb_add(&bar[XB_TOPGEN], 1u);
            else XB_SPIN(xb_ld(&bar[XB_TOPGEN]) == tg, bar);
            __builtin_amdgcn_fence(__ATOMIC_ACQUIRE, "agent");
            xb_add(&bar[XB_XGEN(b.x)], 1u);
            asm volatile("s_waitcnt vmcnt(0)" ::: "memory");
        } else {
            XB_SPIN(xb_ld(&bar[XB_XGEN(b.x)]) == gen, bar);
            __builtin_amdgcn_fence(__ATOMIC_ACQUIRE, "agent");
            asm volatile("s_waitcnt vmcnt(0)" ::: "memory");
        }
    }
    __syncthreads();
}
#ifndef DIAG
#define DIAG 0
#endif
#ifndef DIAG_LA
#define DIAG_LA 0
#endif
#ifndef DIAG_LB
#define DIAG_LB 1
#endif
#ifndef DIAG_LF
#define DIAG_LF 0
#endif
#if DIAG
namespace dg {
constexpr int NS = 8, CW_DG = 8192, NCHK = 16;
__device__ __forceinline__ float bf(unsigned short v) { return __uint_as_float((unsigned)v << 16); }
#ifndef DIAG_SR
#define DIAG_SR 0
#endif
__device__ __forceinline__ int srow(int i) {
#if DIAG_SR == 0
    switch (i) { case 0: return 0; case 1: return 1; case 2: return 255; case 3: return 256; case 4: return 4095; case 5: return 4096; case 6: return 36863; default: return 49151; }
#elif DIAG_SR == 1
    switch (i) { case 0: return 15; case 1: return 16; case 2: return 63; case 3: return 64; case 4: return 127; case 5: return 128; case 6: return 20005; default: return 191; }
#else
    switch (i) { case 0: return 300; case 1: return 2050; case 2: return 8191; case 3: return 12345; case 4: return 33000; case 5: return 40959; case 6: return 45001; default: return 47 ; }
#endif
}
__device__ __forceinline__ float dotA(const unsigned short* a, const float* W, int K, int N, int n) { float s = 0.f; for (int k = 0; k < K; ++k) s += bf(a[k]) * W[(size_t)k * N + n]; return s; }
__device__ __forceinline__ float wsum(float v) {
#pragma unroll
    for (int o = 1; o < 64; o <<= 1) v += __shfl_xor(v, o);
    return v; }
__device__ __forceinline__ void flush(float* acc, int k, float e2, float r2) { e2 = wsum(e2); r2 = wsum(r2); if ((opaque_tid() & 63) == 0) { atomicAdd(acc + 2 * k, e2); atomicAdd(acc + 2 * k + 1, r2); } }
__device__ __forceinline__ int il128(int d) { return d < 64 ? 2 * d : 2 * (d - 64) + 1; }
__device__ __forceinline__ int il64(int d) { return d < 32 ? 2 * d : 2 * (d - 32) + 1; }
__device__ __forceinline__ void ropecs(int pos, int j, int dim, float& c, float& s) { const float inv = exp2f(-((float)(2 * j) / (float)dim) * 13.287712379549449f); const float a = (float)pos * inv; c = cosf(a); s = sinf(a); }
#ifndef DIAG_CK
#define DIAG_CK -1
#endif
#define DG_ACC(k, ri, e2, r2, got, ref) do { const float g_ = (got), r_ = (ref); (e2) += (g_ - r_) * (g_ - r_); (r2) += r_ * r_; \
    if ((k) == DIAG_CK) { atomicAdd(dacc + 2 * (16 + (ri)), (g_ - r_) * (g_ - r_)); atomicAdd(dacc + 2 * (16 + (ri)) + 1, r_ * r_); } } while (0)
}
#endif
constexpr int NWAVES = 8;
#ifndef PH_MASK
#define PH_MASK 0xFFFF
#endif
constexpr int DM = 2048, SEQ = 4096, NSEQ = 12, M = NSEQ * SEQ, DEPTH = 4, M_PROMPT = 8 * SEQ;
constexpr int NH = 16, HD = 128, NKV = 4, NQKV = (NH + 2 * NKV) * HD;
constexpr int QL = 512, KVL = 512, ROPE = 64, NOPE = 128, VD = 128;
constexpr int BWIN_N = QL + KVL + ROPE, BWIN_NP = 1280;
constexpr int NQUP = NH * (NOPE + ROPE), NKVUP = NH * (NOPE + VD);
constexpr int DFF = 5632, DFF2 = 2 * DFF;
constexpr float EPS = 1e-6f;
constexpr int NTILE_M = M / 256;

constexpr size_t MiB = 1u << 20;
constexpr size_t WS_CTL = 0, CTL_ZERO_BYTES = 1 * MiB;
constexpr size_t WS_COSA = 1 * MiB, WS_SINA = 2 * MiB, WS_COSB = 3 * MiB, WS_SINB = 3 * MiB + 512 * 1024;
constexpr size_t WS_WQKV = 4 * MiB;
constexpr size_t WS_WOA  = WS_WQKV + 2 * (size_t)NQKV * DM * 2;
constexpr size_t WS_WBIN = WS_WOA + 2 * (size_t)DM * DM * 2;
constexpr size_t WS_WQUP = WS_WBIN + 2 * (size_t)BWIN_NP * DM * 2;
constexpr size_t WS_WKVUP = WS_WQUP + 2 * (size_t)NQUP * QL * 2;
constexpr size_t WS_WOB  = WS_WKVUP + 2 * (size_t)NKVUP * KVL * 2;
constexpr size_t WS_WFIN = WS_WOB + 2 * (size_t)DM * DM * 2;
constexpr size_t WS_WFOUT = WS_WFIN + 4 * (size_t)DFF2 * DM * 2;
constexpr size_t WS_XN = WS_WFOUT + 4 * (size_t)DM * DFF * 2;
constexpr size_t WS_S = WS_XN + (size_t)M * DM * 2;
static_assert(WS_XN == 348 * MiB && WS_S == 540 * MiB, "d_ws map");
constexpr size_t WS_AQ = WS_S, WS_AK = WS_AQ + (size_t)M * DM * 2, WS_AV = WS_AK + (size_t)M * NKV * HD * 2;
constexpr size_t WS_BH = WS_S;
constexpr size_t WS_CQ = WS_XN, WS_CKV = WS_CQ + (size_t)M * QL * 2, WS_KR = WS_CKV + (size_t)M * KVL * 2;
constexpr size_t WS_BQN = WS_S, WS_BQR = WS_BQN + (size_t)M * DM * 2, WS_BKN = WS_BQR + (size_t)M * NH * ROPE * 2, WS_BV = WS_BKN + (size_t)M * DM * 2;
constexpr size_t WS_B_END = WS_BV + (size_t)M * DM * 2;
constexpr size_t WS_ACT = WS_S, WS_HALO = WS_ACT + (size_t)M * DFF * 2, WS_F_END = WS_HALO + (size_t)NTILE_M * 4 * DFF2 * 4;
constexpr size_t WS_END = WS_B_END > WS_F_END ? WS_B_END : WS_F_END;
static_assert(WS_KR + (size_t)M * ROPE * 2 <= WS_S, "CQ|CKV|KR inside the XN region");
static_assert(WS_BH + (size_t)M * BWIN_N * 4 <= WS_END, "Hraw");
static_assert(WS_END <= 1408 * MiB, "workspace budget (4 x largest input)");
constexpr size_t WS_DGQ = WS_END, WS_DGX = WS_END + 65536;
constexpr int CW_TMO = 0, CW_BAR = 4096;

constexpr int RING_OFF = 0, RING_BYTES = 131072;
constexpr int LDSCTL_OFF = RING_BYTES, MISC_OFF = LDSCTL_OFF + 320;
constexpr int XCH_OFF = RING_BYTES + 1024;
constexpr int LDS_BYTES = 147456;
static_assert(XCH_OFF + 8192 <= LDS_BYTES && MISC_OFF + 128 <= XCH_OFF, "LDS map");
static_assert(att::SHM_ATTN <= RING_BYTES, "attention scratch inside the ring region");

typedef unsigned short bf16;
typedef unsigned v2u __attribute__((ext_vector_type(2)));
__device__ __forceinline__ float wave_sum(float v) {
#pragma unroll
    for (int o = 1; o < 64; o <<= 1) v += __shfl_xor(v, o);
    return v;
}
__device__ __forceinline__ unsigned pkbf(float lo, float hi) { return pg8::cvt_pk_bf16(lo, hi); }

__device__ __forceinline__ int il128(int d) { return d < 64 ? 2 * d : 2 * (d - 64) + 1; }
__device__ __forceinline__ int il64(int d) { return d < 32 ? 2 * d : 2 * (d - 32) + 1; }
__device__ __forceinline__ int dst_row(int map, int n) {
    switch (map) {
    case 1: return n < (NH + NKV) * HD ? (n & ~127) + il128(n & 127) : n;
    case 2: { const int h = n / 192, j = n % 192; return j < 128 ? h * 128 + j : NH * NOPE + h * 64 + il64(j - 128); }
    case 3: { const int h = n / 256, j = n % 256; return j < 128 ? h * 128 + j : NH * NOPE + h * 128 + (j - 128); }
    case 4: { const int c = n < DFF ? n : n - DFF; return (c >> 7) * 256 + (n < DFF ? 0 : 128) + (c & 127); }
    default: return n;
    }
}
__device__ __forceinline__ void transpose_item(const float* W, int K, int N, bf16* WT, int map, LAS float* scr, int item, int lane) {
    const int nblk = N / 32, kb = item / nblk, nb = item % nblk, k0 = 64 * kb, n0 = 32 * nb;
#pragma unroll 8
    for (int i = 0; i < 32; ++i) { const int kk = 2 * i + (lane >> 5); scr[kk * 33 + (lane & 31)] = W[(size_t)(k0 + kk) * N + n0 + (lane & 31)]; }
    LDS_WAIT(); asm volatile("" ::: "memory");
    const int c = lane & 7;
#pragma unroll
    for (int j = 0; j < 4; ++j) { const int n = (lane >> 3) + 8 * j; const LAS float* s = scr + (8 * c) * 33 + n;
        v4u o; o.x = pkbf(s[0 * 33], s[1 * 33]); o.y = pkbf(s[2 * 33], s[3 * 33]); o.z = pkbf(s[4 * 33], s[5 * 33]); o.w = pkbf(s[6 * 33], s[7 * 33]);
        *(GAS v4u*)(WT + (size_t)dst_row(map, n0 + n) * K + k0 + 8 * c) = o; }
    LDS_WAIT(); asm volatile("" ::: "memory");
}
__device__ __forceinline__ void rms_row_to_bf16(const float* xrow, const float* g, bf16* orow, float* copy, int lane) {
    const GAS f32x4* xr = (const GAS f32x4*)xrow + lane; const GAS f32x4* gr = (const GAS f32x4*)g + lane;
    f32x4 v[8]; float s = 0.f;
#pragma unroll
    for (int j = 0; j < 8; ++j) { v[j] = xr[64 * j]; s += (v[j].x * v[j].x + v[j].y * v[j].y) + (v[j].z * v[j].z + v[j].w * v[j].w); }
    const float r = 1.0f / sqrtf(wave_sum(s) * (1.f / DM) + EPS);
    if (copy) { GAS f32x4* cr = (GAS f32x4*)copy + lane;
#pragma unroll
        for (int j = 0; j < 8; ++j) cr[64 * j] = v[j]; }
    GAS v2u* o8 = (GAS v2u*)orow + lane;
#pragma unroll
    for (int j = 0; j < 8; ++j) { const f32x4 gg = gr[64 * j]; v2u w; w.x = pkbf(v[j].x * r * gg.x, v[j].y * r * gg.y); w.y = pkbf(v[j].z * r * gg.z, v[j].w * r * gg.w); o8[64 * j] = w; }
}

struct Args { const float* in[18]; float* out; unsigned char* ws; };
__global__ void __launch_bounds__(NWAVES * 64, 2) trunk_fwd(Args args) {
    extern __shared__ __attribute__((aligned(16))) unsigned char lds_raw[];
    LAS unsigned char* lds = (LAS unsigned char*)lds_raw;
    volatile LAS unsigned* MISC = (volatile LAS unsigned*)(lds + MISC_OFF);
    const int tid = threadIdx.x, lane = tid & 63, wave = __builtin_amdgcn_readfirstlane(tid >> 6);
    const int G = gridDim.x; const int bx = blockIdx.x; const int vcu = (G % 8 == 0) ? (bx % 8) * (G / 8) + bx / 8 : bx;
    unsigned char* ws = args.ws;
    gu32* ctl = (gu32*)(ws + WS_CTL);
    for (int u = tid; u < (XCH_OFF - LDSCTL_OFF) / 4; u += NWAVES * 64) ((LAS unsigned*)(lds + LDSCTL_OFF))[u] = 0u;
    __syncthreads();
    XcdBarrier bar = xcd_barrier_post((unsigned*)(ctl + CW_BAR), MISC + 8);
    const int gw = vcu * NWAVES + wave, NGW = G * NWAVES;
#define GRID_BAR() do { XcdBarrier b_ = bar; asm volatile("" : "+s"(b_.x)); xcd_barrier(b_); } while (0)
    float* X = args.out;
    bf16* XN = (bf16*)(ws + WS_XN);
    const float* cosA = (const float*)(ws + WS_COSA); const float* sinA = (const float*)(ws + WS_SINA);
    const float* cosB = (const float*)(ws + WS_COSB); const float* sinB = (const float*)(ws + WS_SINB);

    {
        LAS float* scr = (LAS float*)(lds + RING_OFF + wave * 16384);
        constexpr int I_QKV = (DM / 64) * (NQKV / 32), I_WO = (DM / 64) * (DM / 32), I_BIN = (DM / 64) * (BWIN_N / 32), I_QUP = (QL / 64) * (NQUP / 32),
                      I_KVUP = (KVL / 64) * (NKVUP / 32), I_FIN = (DM / 64) * (DFF2 / 32), I_FOUT = (DFF / 64) * (DM / 32);
        constexpr int NITEMS = 2 * (I_QKV + I_WO + I_BIN + I_QUP + I_KVUP + I_WO) + 4 * (I_FIN + I_FOUT);
        for (int it = gw; it < NITEMS; it += NGW) {
            int r = it;
            if (r < 2 * I_QKV) { const int l = r / I_QKV; transpose_item(args.in[5] + (size_t)l * DM * NQKV, DM, NQKV, (bf16*)(ws + WS_WQKV) + (size_t)l * NQKV * DM, 1, scr, r % I_QKV, lane); continue; } r -= 2 * I_QKV;
            if (r < 2 * I_WO) { const int l = r / I_WO; transpose_item(args.in[6] + (size_t)l * DM * DM, DM, DM, (bf16*)(ws + WS_WOA) + (size_t)l * DM * DM, 0, scr, r % I_WO, lane); continue; } r -= 2 * I_WO;
            if (r < 2 * I_BIN) { const int l = r / I_BIN; transpose_item(args.in[8] + (size_t)l * DM * BWIN_N, DM, BWIN_N, (bf16*)(ws + WS_WBIN) + (size_t)l * BWIN_NP * DM, 0, scr, r % I_BIN, lane); continue; } r -= 2 * I_BIN;
            if (r < 2 * I_QUP) { const int l = r / I_QUP; transpose_item(args.in[10] + (size_t)l * QL * NQUP, QL, NQUP, (bf16*)(ws + WS_WQUP) + (size_t)l * NQUP * QL, 2, scr, r % I_QUP, lane); continue; } r -= 2 * I_QUP;
            if (r < 2 * I_KVUP) { const int l = r / I_KVUP; transpose_item(args.in[12] + (size_t)l * KVL * NKVUP, KVL, NKVUP, (bf16*)(ws + WS_WKVUP) + (size_t)l * NKVUP * KVL, 3, scr, r % I_KVUP, lane); continue; } r -= 2 * I_KVUP;
            if (r < 2 * I_WO) { const int l = r / I_WO; transpose_item(args.in[13] + (size_t)l * DM * DM, DM, DM, (bf16*)(ws + WS_WOB) + (size_t)l * DM * DM, 0, scr, r % I_WO, lane); continue; } r -= 2 * I_WO;
            if (r < 4 * I_FIN) { const int l = r / I_FIN; transpose_item(args.in[14] + (size_t)l * DM * DFF2, DM, DFF2, (bf16*)(ws + WS_WFIN) + (size_t)l * DFF2 * DM, 4, scr, r % I_FIN, lane); continue; } r -= 4 * I_FIN;
            { const int l = r / I_FOUT; transpose_item(args.in[17] + (size_t)l * DFF * DM, DFF, DM, (bf16*)(ws + WS_WFOUT) + (size_t)l * DM * DFF, 0, scr, r % I_FOUT, lane); }
        }
        for (int i = gw; i < 2 * (BWIN_NP - BWIN_N); i += NGW) { const int l = i / (BWIN_NP - BWIN_N), rr = BWIN_N + i % (BWIN_NP - BWIN_N);
            GAS v4u* p = (GAS v4u*)((bf16*)(ws + WS_WBIN) + ((size_t)l * BWIN_NP + rr) * DM) + lane;
#pragma unroll
            for (int j = 0; j < 4; ++j) p[64 * j] = (v4u){0u, 0u, 0u, 0u}; }
        for (int i = bx * (NWAVES * 64) + tid; i < SEQ * 64 + SEQ * 32; i += G * NWAVES * 64) {
            if (i < SEQ * 64) { const int pos = i >> 6, j = i & 63; const double inv = exp2(-(double)(2 * j) / 128.0 * 13.287712379549449); const double a = (double)pos * inv;
                ((float*)(ws + WS_COSA))[i] = (float)cos(a); ((float*)(ws + WS_SINA))[i] = (float)sin(a); }
            else { const int k = i - SEQ * 64, pos = k >> 5, j = k & 31; const double inv = exp2(-(double)(2 * j) / 64.0 * 13.287712379549449); const double a = (double)pos * inv;
                ((float*)(ws + WS_COSB))[k] = (float)cos(a); ((float*)(ws + WS_SINB))[k] = (float)sin(a); }
        }
        for (int m = gw; m < M; m += NGW) { const float* xr = m < M_PROMPT ? args.in[0] + (size_t)m * DM : args.in[1] + (size_t)(m - M_PROMPT) * DM;
            rms_row_to_bf16(xr, args.in[2], XN + (size_t)m * DM, X + (size_t)m * DM, lane); }
    }
    GRID_BAR();

#if DIAG
    {
        const int gt = bx * 512 + opaque_tid(), GT = G * 512; float e2 = 0.f, r2 = 0.f; float* dacc = (float*)(ctl + dg::CW_DG); (void)dacc;
        for (int it = gt; it < dg::NS * DM; it += GT) { const int ri = it / DM, n = it % DM, row = dg::srow(ri);
            const float* xr = row < M_PROMPT ? args.in[0] + (size_t)row * DM : args.in[1] + (size_t)(row - M_PROMPT) * DM;
            float ss = 0.f; for (int k = 0; k < DM; ++k) ss += xr[k] * xr[k];
            const float ref = xr[n] * (1.0f / sqrtf(ss / DM + EPS)) * args.in[2][n];
            DG_ACC(0, ri, e2, r2, dg::bf(XN[(size_t)row * DM + n]), ref); }
        dg::flush(dacc, 0, e2, r2);
    }
#endif

    for (int layer = 0; layer < DEPTH; ++layer) {
        const int jl = layer >> 1;
        if ((layer & 1) == 0) {
            bf16* AQ = (bf16*)(ws + WS_AQ); bf16* AK = (bf16*)(ws + WS_AK); bf16* AV = (bf16*)(ws + WS_AV);
            if constexpr (PH_MASK & 1) {
                pg8::Gemm g{XN, (const bf16*)(ws + WS_WQKV) + (size_t)jl * NQKV * DM, M, NQKV, DM}; pg8::StaticOrder S; S.init(M, NQKV, G, bx);
                pg8::EpiRope E{AQ, AK, AV, DM, NKV * HD, NKV * HD, 8, 10, 3, cosA, sinA, 64};
                pg8::gemm_phase<pg8::EpiRope, pg8::StaticOrder, true, true>(lds + RING_OFF, g, S, E);
            }
            GRID_BAR();

#if DIAG
            if (layer == DIAG_LA) {
                const int gt = bx * 512 + opaque_tid(), GT = G * 512; float e2 = 0.f, r2 = 0.f; float* dacc = (float*)(ctl + dg::CW_DG); (void)dacc;
                const float* Wl = args.in[5] + (size_t)jl * DM * NQKV;
                for (int it = gt; it < dg::NS * NQKV; it += GT) { const int ri = it / NQKV, n = it % NQKV, row = dg::srow(ri); const bf16* a = XN + (size_t)row * DM;
                    float ref, got;
                    if (n < 2560) { const int base = n & ~127, d = n & 127, j = d & 63; const float x1 = dg::dotA(a, Wl, DM, NQKV, base + j), x2 = dg::dotA(a, Wl, DM, NQKV, base + j + 64);
                        float c, sn; dg::ropecs(row & 4095, j, 128, c, sn); ref = d < 64 ? x1 * c - x2 * sn : x2 * c + x1 * sn;
                        got = n < 2048 ? dg::bf(AQ[(size_t)row * DM + base + dg::il128(d)]) : dg::bf(AK[(size_t)row * 512 + (base - 2048) + dg::il128(d)]); }
                    else { ref = dg::dotA(a, Wl, DM, NQKV, n); got = dg::bf(AV[(size_t)row * 512 + n - 2560]); }
                    DG_ACC(1, ri, e2, r2, got, ref); }
                dg::flush(dacc, 1, e2, r2);
                bf16* QS = (bf16*)(ws + WS_DGQ); float* XS = (float*)(ws + WS_DGX);
                for (int it = gt; it < dg::NS * DM; it += GT) { const int ri = it / DM, n = it % DM, row = dg::srow(ri); QS[ri * 3072 + n] = AQ[(size_t)row * DM + n]; XS[ri * DM + n] = X[(size_t)row * DM + n]; }
                GRID_BAR();
            }
#endif
            if constexpr (PH_MASK & 2) {
                const int xcd = vcu >> 5, c = vcu & 31;
                for (int i = 0; i < 12; ++i) {
                    const int bh = xcd * 24 + 2 * i + (c >> 4), qb = c & 15, b = bh >> 4, h = bh & 15, kvh = h >> 2;
                    const int q0 = qb * 256, k0 = q0 >= 128 ? q0 - 128 : 0, k1 = (q0 + 384 <= SEQ) ? q0 + 384 : SEQ;
                    const size_t row0 = (size_t)b * SEQ;
                    const float sink = args.in[7][jl * NH + h];
                    att::attn_body<0, true>(AQ + (row0 + q0) * DM + h * HD, DM, nullptr, 0,
                                            AK + (row0 + k0) * (NKV * HD) + kvh * HD, NKV * HD, nullptr, 0,
                                            AV + (row0 + k0) * (NKV * HD) + kvh * HD, NKV * HD,
                                            AQ + (row0 + q0) * DM + h * HD, DM, (k1 - k0) / 64, q0 - k0, sink * 11.313708498984761f, 1.0f, (LAS char*)(lds + RING_OFF));
                }
            }
            GRID_BAR();

#if DIAG
            if (layer == DIAG_LA) {
                const int gt = bx * 512 + opaque_tid(), GT = G * 512; float e2 = 0.f, r2 = 0.f; float* dacc = (float*)(ctl + dg::CW_DG); (void)dacc;
                const bf16* QS = (const bf16*)(ws + WS_DGQ);
                for (int it = gt; it < dg::NS * NH * HD; it += GT) { const int ri = it / (NH * HD), h = (it / HD) % NH, d = it % HD, row = dg::srow(ri), b = row >> 12, p = row & 4095, kvh = h >> 2;
                    const bf16* q = QS + ri * 3072 + h * HD; const float sink = args.in[7][jl * NH + h];
                    const int j0 = p - 128 > 0 ? p - 128 : 0, j1 = p + 128 < SEQ - 1 ? p + 128 : SEQ - 1;
                    float mx = sink, den = 1.f, o = 0.f;
                    for (int j = j0; j <= j1; ++j) { const bf16* kr = AK + ((size_t)b * SEQ + j) * 512 + kvh * HD; float sc = 0.f;
                        for (int dd = 0; dd < HD; ++dd) sc += dg::bf(q[dd]) * dg::bf(kr[dd]);
                        sc *= 0.08838834764831845f;
                        if (sc > mx) { const float f = expf(mx - sc); den *= f; o *= f; mx = sc; }
                        const float e = expf(sc - mx); den += e; o += e * dg::bf(AV[((size_t)b * SEQ + j) * 512 + kvh * HD + d]); }
                    DG_ACC(2, ri, e2, r2, dg::bf(AQ[(size_t)row * DM + h * HD + d]), o / den); }
                dg::flush(dacc, 2, e2, r2);
            }
#endif
            if constexpr (PH_MASK & 4) {
                pg8::Gemm g{AQ, (const bf16*)(ws + WS_WOA) + (size_t)jl * DM * DM, M, DM, DM}; pg8::StaticOrder S; S.init(M, DM, G, bx);
                pg8::EpiResid E{X, X, DM};
                pg8::gemm_phase<pg8::EpiResid, pg8::StaticOrder, true, true>(lds + RING_OFF, g, S, E);
            }
            GRID_BAR();

#if DIAG
            if (layer == DIAG_LA) {
                const int gt = bx * 512 + opaque_tid(), GT = G * 512; float e2 = 0.f, r2 = 0.f; float* dacc = (float*)(ctl + dg::CW_DG); (void)dacc;
                const float* Wl = args.in[6] + (size_t)jl * DM * DM; const float* XS = (const float*)(ws + WS_DGX);
                for (int it = gt; it < dg::NS * DM; it += GT) { const int ri = it / DM, n = it % DM, row = dg::srow(ri);
                    const float ref = XS[ri * DM + n] + dg::dotA(AQ + (size_t)row * DM, Wl, DM, DM, n);
                    DG_ACC(3, ri, e2, r2, X[(size_t)row * DM + n], ref); }
                dg::flush(dacc, 3, e2, r2);
            }
#endif
        } else {
            float* BH = (float*)(ws + WS_BH); bf16* CQ = (bf16*)(ws + WS_CQ); bf16* CKV = (bf16*)(ws + WS_CKV); bf16* KR = (bf16*)(ws + WS_KR);
            bf16* BQN = (bf16*)(ws + WS_BQN); bf16* BQR = (bf16*)(ws + WS_BQR); bf16* BKN = (bf16*)(ws + WS_BKN); bf16* BV = (bf16*)(ws + WS_BV);
            if constexpr (PH_MASK & 8) {
                pg8::Gemm g{XN, (const bf16*)(ws + WS_WBIN) + (size_t)jl * BWIN_NP * DM, M, BWIN_NP, DM}; pg8::StaticOrder S; S.init(M, BWIN_NP, G, bx);
                pg8::EpiF32 E{BH, BWIN_N, BWIN_N};
                pg8::gemm_phase<pg8::EpiF32, pg8::StaticOrder, true, true>(lds + RING_OFF, g, S, E);
            }
            GRID_BAR();

#if DIAG
            if (layer == DIAG_LB) {
                const int gt = bx * 512 + opaque_tid(), GT = G * 512; float e2 = 0.f, r2 = 0.f; float* dacc = (float*)(ctl + dg::CW_DG); (void)dacc;
                const float* Wl = args.in[8] + (size_t)jl * DM * BWIN_N;
                for (int it = gt; it < dg::NS * BWIN_N; it += GT) { const int ri = it / BWIN_N, n = it % BWIN_N, row = dg::srow(ri);
                    DG_ACC(7, ri, e2, r2, BH[(size_t)row * BWIN_N + n], dg::dotA(XN + (size_t)row * DM, Wl, DM, BWIN_N, n)); }
                dg::flush(dacc, 7, e2, r2);
                GRID_BAR();
            }
#endif
            if constexpr (PH_MASK & 16) { const int ln = opaque_tid() & 63;
                const float* qn = args.in[9] + jl * QL; const float* kn = args.in[11] + jl * KVL;
                const GAS f32x4* qg = (const GAS f32x4*)qn + ln; const GAS f32x4* kg = (const GAS f32x4*)kn + ln;
                const f32x4 qg0 = qg[0], qg1 = qg[64], kg0 = kg[0], kg1 = kg[64];
                for (int m = gw; m < M; m += NGW) {
                    const float* hr = BH + (size_t)m * BWIN_N; const GAS f32x4* h4 = (const GAS f32x4*)hr + ln;
                    const f32x4 a0 = h4[0], a1 = h4[64], b0 = h4[128], b1 = h4[192];
                    float x1 = 0.f, x2 = 0.f; if (ln < 32) { x1 = hr[QL + KVL + ln]; x2 = hr[QL + KVL + 32 + ln]; }
                    float sa = (a0.x * a0.x + a0.y * a0.y) + (a0.z * a0.z + a0.w * a0.w) + (a1.x * a1.x + a1.y * a1.y) + (a1.z * a1.z + a1.w * a1.w);
                    float sb = (b0.x * b0.x + b0.y * b0.y) + (b0.z * b0.z + b0.w * b0.w) + (b1.x * b1.x + b1.y * b1.y) + (b1.z * b1.z + b1.w * b1.w);
                    const float ra = 1.0f / sqrtf(wave_sum(sa) * (1.f / QL) + EPS), rb = 1.0f / sqrtf(wave_sum(sb) * (1.f / KVL) + EPS);
                    GAS v2u* oq = (GAS v2u*)(CQ + (size_t)m * QL) + ln; GAS v2u* ok = (GAS v2u*)(CKV + (size_t)m * KVL) + ln;
                    v2u w;
                    w.x = pkbf(a0.x * ra * qg0.x, a0.y * ra * qg0.y); w.y = pkbf(a0.z * ra * qg0.z, a0.w * ra * qg0.w); oq[0] = w;
                    w.x = pkbf(a1.x * ra * qg1.x, a1.y * ra * qg1.y); w.y = pkbf(a1.z * ra * qg1.z, a1.w * ra * qg1.w); oq[64] = w;
                    w.x = pkbf(b0.x * rb * kg0.x, b0.y * rb * kg0.y); w.y = pkbf(b0.z * rb * kg0.z, b0.w * rb * kg0.w); ok[0] = w;
                    w.x = pkbf(b1.x * rb * kg1.x, b1.y * rb * kg1.y); w.y = pkbf(b1.z * rb * kg1.z, b1.w * rb * kg1.w); ok[64] = w;
                    if (ln < 32) { const int pos = m & (SEQ - 1); const float cc = cosB[pos * 32 + ln], ss = sinB[pos * 32 + ln];
                        ((GAS unsigned*)(KR + (size_t)m * ROPE))[ln] = pkbf(x1 * cc - x2 * ss, x2 * cc + x1 * ss); }
                }
            }
            GRID_BAR();

#if DIAG
            if (layer == DIAG_LB) {
                const int gt = bx * 512 + opaque_tid(), GT = G * 512; float e2 = 0.f, r2 = 0.f; float* dacc = (float*)(ctl + dg::CW_DG); (void)dacc;
                for (int it = gt; it < dg::NS * BWIN_N; it += GT) { const int ri = it / BWIN_N, n = it % BWIN_N, row = dg::srow(ri); const float* hr = BH + (size_t)row * BWIN_N;
                    float ref, got;
                    if (n < 1024) { const int o0 = n < 512 ? 0 : 512; float ss = 0.f; for (int k = 0; k < 512; ++k) ss += hr[o0 + k] * hr[o0 + k];
                        const float gn = n < 512 ? args.in[9][jl * QL + n] : args.in[11][jl * KVL + n - 512];
                        ref = hr[n] * (1.0f / sqrtf(ss / 512.f + EPS)) * gn; got = n < 512 ? dg::bf(CQ[(size_t)row * QL + n]) : dg::bf(CKV[(size_t)row * KVL + n - 512]); }
                    else { const int rr = n - 1024, j = rr & 31; const float x1 = hr[1024 + j], x2 = hr[1024 + 32 + j]; float c, sn; dg::ropecs(row & 4095, j, 64, c, sn);
                        ref = rr < 32 ? x1 * c - x2 * sn : x2 * c + x1 * sn; got = dg::bf(KR[(size_t)row * ROPE + dg::il64(rr)]); }
                    DG_ACC(8, ri, e2, r2, got, ref); }
                dg::flush(dacc, 8, e2, r2);
                GRID_BAR();
            }
#endif
            if constexpr (PH_MASK & 32) {
                pg8::Gemm g{CQ, (const bf16*)(ws + WS_WQUP) + (size_t)jl * NQUP * QL, M, NQUP, QL}; pg8::StaticOrder S; S.init(M, NQUP, G, bx);
                pg8::EpiRope E{BQN, BQR, BQR, DM, NH * ROPE, NH * ROPE, 8, 12, 2, cosB, sinB, 32};
                pg8::gemm_phase<pg8::EpiRope, pg8::StaticOrder, true, true>(lds + RING_OFF, g, S, E);
            }
            if constexpr (PH_MASK & 64) {
                pg8::Gemm g{CKV, (const bf16*)(ws + WS_WKVUP) + (size_t)jl * NKVUP * KVL, M, NKVUP, KVL}; pg8::StaticOrder S; S.init(M, NKVUP, G, bx);
                pg8::EpiBf16Split E{BKN, BV, DM, 8};
                pg8::gemm_phase<pg8::EpiBf16Split, pg8::StaticOrder, true, true>(lds + RING_OFF, g, S, E);
            }
            GRID_BAR();

#if DIAG
            if (layer == DIAG_LB) {
                const int gt = bx * 512 + opaque_tid(), GT = G * 512; float e2 = 0.f, r2 = 0.f; float* dacc = (float*)(ctl + dg::CW_DG); (void)dacc;
                const float* Wq = args.in[10] + (size_t)jl * QL * NQUP; const float* Wk = args.in[12] + (size_t)jl * KVL * NKVUP;
                for (int it = gt; it < dg::NS * NQUP; it += GT) { const int ri = it / NQUP, n = it % NQUP, row = dg::srow(ri), h = n / 192, j = n % 192; const bf16* a = CQ + (size_t)row * QL;
                    float ref, got;
                    if (j < 128) { ref = dg::dotA(a, Wq, QL, NQUP, n); got = dg::bf(BQN[(size_t)row * DM + h * 128 + j]); }
                    else { const int rr = j - 128, jj = rr & 31; const float x1 = dg::dotA(a, Wq, QL, NQUP, h * 192 + 128 + jj), x2 = dg::dotA(a, Wq, QL, NQUP, h * 192 + 160 + jj);
                        float c, sn; dg::ropecs(row & 4095, jj, 64, c, sn); ref = rr < 32 ? x1 * c - x2 * sn : x2 * c + x1 * sn; got = dg::bf(BQR[(size_t)row * (NH * ROPE) + h * 64 + dg::il64(rr)]); }
                    DG_ACC(9, ri, e2, r2, got, ref); }
                dg::flush(dacc, 9, e2, r2);
                e2 = 0.f; r2 = 0.f;
                for (int it = gt; it < dg::NS * NKVUP; it += GT) { const int ri = it / NKVUP, n = it % NKVUP, row = dg::srow(ri), h = n / 256, j = n % 256;
                    const float ref = dg::dotA(CKV + (size_t)row * KVL, Wk, KVL, NKVUP, n);
                    const float got = j < 128 ? dg::bf(BKN[(size_t)row * DM + h * 128 + j]) : dg::bf(BV[(size_t)row * DM + h * 128 + j - 128]);
                    DG_ACC(10, ri, e2, r2, got, ref); }
                dg::flush(dacc, 10, e2, r2);
                bf16* QS = (bf16*)(ws + WS_DGQ); float* XS = (float*)(ws + WS_DGX);
                for (int it = gt; it < dg::NS * DM; it += GT) { const int ri = it / DM, n = it % DM, row = dg::srow(ri); QS[ri * 3072 + n] = BQN[(size_t)row * DM + n]; XS[ri * DM + n] = X[(size_t)row * DM + n];
                    if (n < NH * ROPE) QS[ri * 3072 + 2048 + n] = BQR[(size_t)row * (NH * ROPE) + n]; }
                GRID_BAR();
            }
#endif
            if constexpr (PH_MASK & 128) {
                const int xcd = vcu >> 5, c = vcu & 31;
                for (int i = 0; i < 12; ++i) {
                    const int bh = xcd * 24 + 2 * i + (c >> 4), qb = c & 15, b = bh >> 4, h = bh & 15;
                    const size_t row0 = (size_t)b * SEQ; const int q0 = qb * 256;
                    att::attn_body<4, false>(BQN + (row0 + q0) * DM + h * NOPE, DM, BQR + (row0 + q0) * (NH * ROPE) + h * ROPE, NH * ROPE,
                                             BKN + row0 * DM + h * NOPE, DM, KR + row0 * ROPE, ROPE,
                                             BV + row0 * DM + h * VD, DM,
                                             BQN + (row0 + q0) * DM + h * NOPE, DM, SEQ / 64, 0, -1e30f, 0.f, (LAS char*)(lds + RING_OFF));
                }
            }
            GRID_BAR();

#if DIAG
            if (layer == DIAG_LB) {
                const int gt = bx * 512 + opaque_tid(), GT = G * 512; float e2 = 0.f, r2 = 0.f; float* dacc = (float*)(ctl + dg::CW_DG); (void)dacc;
                const bf16* QS = (const bf16*)(ws + WS_DGQ);
                for (int it = gt; it < dg::NS * NH * VD; it += GT) { const int ri = it / (NH * VD), h = (it / VD) % NH, d = it % VD, row = dg::srow(ri), b = row >> 12;
                    const bf16* qn = QS + ri * 3072 + h * 128; const bf16* qq = QS + ri * 3072 + 2048 + h * 64;
                    float mx = -1e30f, den = 0.f, o = 0.f;
                    for (int j = 0; j < SEQ; ++j) { const bf16* kn = BKN + ((size_t)b * SEQ + j) * DM + h * 128; const bf16* kr = KR + ((size_t)b * SEQ + j) * ROPE; float sc = 0.f;
                        for (int dd = 0; dd < 128; ++dd) sc += dg::bf(qn[dd]) * dg::bf(kn[dd]);
                        for (int dd = 0; dd < 64; ++dd) sc += dg::bf(qq[dd]) * dg::bf(kr[dd]);
                        sc *= 0.07216878364870322f;
                        if (sc > mx) { const float f = expf(mx - sc); den *= f; o *= f; mx = sc; }
                        const float e = expf(sc - mx); den += e; o += e * dg::bf(BV[((size_t)b * SEQ + j) * DM + h * 128 + d]); }
                    DG_ACC(11, ri, e2, r2, dg::bf(BQN[(size_t)row * DM + h * 128 + d]), o / den); }
                dg::flush(dacc, 11, e2, r2);
            }
#endif
            if constexpr (PH_MASK & 256) {
                pg8::Gemm g{BQN, (const bf16*)(ws + WS_WOB) + (size_t)jl * DM * DM, M, DM, DM}; pg8::StaticOrder S; S.init(M, DM, G, bx);
                pg8::EpiResid E{X, X, DM};
                pg8::gemm_phase<pg8::EpiResid, pg8::StaticOrder, true, true>(lds + RING_OFF, g, S, E);
            }
            GRID_BAR();

#if DIAG
            if (layer == DIAG_LB) {
                const int gt = bx * 512 + opaque_tid(), GT = G * 512; float e2 = 0.f, r2 = 0.f; float* dacc = (float*)(ctl + dg::CW_DG); (void)dacc;
                const float* Wl = args.in[13] + (size_t)jl * DM * DM; const float* XS = (const float*)(ws + WS_DGX);
                for (int it = gt; it < dg::NS * DM; it += GT) { const int ri = it / DM, n = it % DM, row = dg::srow(ri);
                    const float ref = XS[ri * DM + n] + dg::dotA(BQN + (size_t)row * DM, Wl, DM, DM, n);
                    DG_ACC(12, ri, e2, r2, X[(size_t)row * DM + n], ref); }
                dg::flush(dacc, 12, e2, r2);
            }
#endif
        }
        { const int ln = opaque_tid() & 63; for (int m = gw; m < M; m += NGW) rms_row_to_bf16(X + (size_t)m * DM, args.in[3] + layer * DM, XN + (size_t)m * DM, nullptr, ln); }
        GRID_BAR();

#if DIAG
        if (layer == DIAG_LF) {
            const int gt = bx * 512 + opaque_tid(), GT = G * 512; float e2 = 0.f, r2 = 0.f; float* dacc = (float*)(ctl + dg::CW_DG); (void)dacc;
            for (int it = gt; it < dg::NS * DM; it += GT) { const int ri = it / DM, n = it % DM, row = dg::srow(ri); const float* xr = X + (size_t)row * DM;
                float ss = 0.f; for (int k = 0; k < DM; ++k) ss += xr[k] * xr[k];
                DG_ACC(4, ri, e2, r2, dg::bf(XN[(size_t)row * DM + n]), xr[n] * (1.0f / sqrtf(ss / DM + EPS)) * args.in[3][layer * DM + n]); }
            dg::flush(dacc, 4, e2, r2);
        }
#endif
        bf16* ACT = (bf16*)(ws + WS_ACT); float* HALO = (float*)(ws + WS_HALO);
        const float* cw = args.in[15] + (size_t)layer * 3 * DFF2; const float* cb = args.in[16] + (size_t)layer * DFF2;
        if constexpr (PH_MASK & 512) {
            pg8::Gemm g{XN, (const bf16*)(ws + WS_WFIN) + (size_t)layer * DFF2 * DM, M, DFF2, DM}; pg8::StaticOrder S; S.init(M, DFF2, G, bx);
            pg8::EpiConv E{ACT, HALO, cw, cb, (LAS float*)(lds + XCH_OFF), DFF};
            pg8::gemm_phase<pg8::EpiConv, pg8::StaticOrder, true, true>(lds + RING_OFF, g, S, E);
        }
        GRID_BAR();
        if constexpr (PH_MASK & 1024) { const int ln = opaque_tid() & 63;
            constexpr int NCH = DFF / 256;
            for (int it = gw; it < NTILE_M * 2 * NCH; it += NGW) {
                const int ch = it % NCH, tr = it / NCH, pm = tr >> 1, last = tr & 1;
                const int c = ch * 256 + 4 * ln, pn = c >> 7, cc = c & 127;
                const size_t gc = (size_t)pn * 256 + cc, uc = gc + 128;
                const float* Hc = HALO + ((size_t)pm * 4 + (last ? 3 : 0)) * DFF2;
                const bool hasP = last ? true : (pm & 15) != 0, hasN = last ? (pm & 15) != 15 : true;
                const float* Hp = last ? HALO + ((size_t)pm * 4 + 2) * DFF2 : HALO + ((size_t)(pm - 1) * 4 + 3) * DFF2;
                const float* Hn = last ? HALO + ((size_t)(pm + 1) * 4 + 0) * DFF2 : HALO + ((size_t)pm * 4 + 1) * DFF2;
                const f32x4 z = (f32x4){0.f, 0.f, 0.f, 0.f};
                const f32x4 gP = hasP ? *(const f32x4*)(Hp + gc) : z, uP = hasP ? *(const f32x4*)(Hp + uc) : z;
                const f32x4 gN = hasN ? *(const f32x4*)(Hn + gc) : z, uN = hasN ? *(const f32x4*)(Hn + uc) : z;
                const f32x4 gC = *(const f32x4*)(Hc + gc), uC = *(const f32x4*)(Hc + uc);
                const f32x4 gg = *(const f32x4*)(cw + c) * gP + *(const f32x4*)(cw + DFF2 + c) * gC + *(const f32x4*)(cw + 2 * DFF2 + c) * gN + *(const f32x4*)(cb + c);
                const f32x4 uu = *(const f32x4*)(cw + DFF + c) * uP + *(const f32x4*)(cw + DFF2 + DFF + c) * uC + *(const f32x4*)(cw + 2 * DFF2 + DFF + c) * uN + *(const f32x4*)(cb + DFF + c);
                f32x4 a;
#pragma unroll
                for (int e = 0; e < 4; ++e) { const float ex = __builtin_amdgcn_exp2f(-1.4426950408889634f * gg[e]); a[e] = gg[e] * __builtin_amdgcn_rcpf(1.0f + ex) * uu[e]; }
                v2u w; w.x = pkbf(a[0], a[1]); w.y = pkbf(a[2], a[3]);
                *(GAS v2u*)(ACT + ((size_t)pm * 256 + (last ? 255 : 0)) * DFF + c) = w;
            }
        }
        GRID_BAR();

#if DIAG
        if (layer == DIAG_LF) {
            const int gt = bx * 512 + opaque_tid(), GT = G * 512; float e2 = 0.f, r2 = 0.f; float* dacc = (float*)(ctl + dg::CW_DG); (void)dacc;
            const float* Wl = args.in[14] + (size_t)layer * DM * DFF2;
            for (int it = gt; it < dg::NS * DFF; it += GT) { const int ri = it / DFF, c = it % DFF, row = dg::srow(ri), sq = row >> 12;
                float gp = cb[c], up = cb[DFF + c];
                for (int tap = 0; tap < 3; ++tap) { const int t = row + tap - 1; if (t >= 0 && t < M && (t >> 12) == sq) { const bf16* a = XN + (size_t)t * DM;
                    gp += cw[tap * DFF2 + c] * dg::dotA(a, Wl, DM, DFF2, c); up += cw[tap * DFF2 + DFF + c] * dg::dotA(a, Wl, DM, DFF2, DFF + c); } }
                DG_ACC(5, ri, e2, r2, dg::bf(ACT[(size_t)row * DFF + c]), gp / (1.0f + expf(-gp)) * up); }
            dg::flush(dacc, 5, e2, r2);
            float* XS = (float*)(ws + WS_DGX);
            for (int it = gt; it < dg::NS * DM; it += GT) { const int ri = it / DM, n = it % DM, row = dg::srow(ri); XS[ri * DM + n] = X[(size_t)row * DM + n]; }
            GRID_BAR();
        }
#endif
        if constexpr (PH_MASK & 2048) {
            pg8::Gemm g{ACT, (const bf16*)(ws + WS_WFOUT) + (size_t)layer * DM * DFF, M, DM, DFF}; pg8::StaticOrder S; S.init(M, DM, G, bx);
            pg8::EpiResid E{X, X, DM};
            pg8::gemm_phase<pg8::EpiResid, pg8::StaticOrder, true, true>(lds + RING_OFF, g, S, E);
        }
        GRID_BAR();

#if DIAG
        if (layer == DIAG_LF) {
            const int gt = bx * 512 + opaque_tid(), GT = G * 512; float e2 = 0.f, r2 = 0.f; float* dacc = (float*)(ctl + dg::CW_DG); (void)dacc;
            const float* Wl = args.in[17] + (size_t)layer * DFF * DM; const float* XS = (const float*)(ws + WS_DGX);
            for (int it = gt; it < dg::NS * DM; it += GT) { const int ri = it / DM, n = it % DM, row = dg::srow(ri);
                DG_ACC(6, ri, e2, r2, X[(size_t)row * DM + n], XS[ri * DM + n] + dg::dotA(ACT + (size_t)row * DFF, Wl, DFF, DM, n)); }
            dg::flush(dacc, 6, e2, r2);
        }
#endif
        if (layer + 1 < DEPTH) {
            { const int ln = opaque_tid() & 63; for (int m = gw; m < M; m += NGW) rms_row_to_bf16(X + (size_t)m * DM, args.in[2] + (layer + 1) * DM, XN + (size_t)m * DM, nullptr, ln); }
            GRID_BAR();
        }
    }
    {
        const int lane = opaque_tid() & 63;
        const GAS f32x4* gr = (const GAS f32x4*)args.in[4] + lane;
        for (int m = gw; m < M; m += NGW) {
            GAS f32x4* xr = (GAS f32x4*)(X + (size_t)m * DM) + lane;
            f32x4 v[8]; float s = 0.f;
#pragma unroll
            for (int j = 0; j < 8; ++j) { v[j] = xr[64 * j]; s += (v[j].x * v[j].x + v[j].y * v[j].y) + (v[j].z * v[j].z + v[j].w * v[j].w); }
            const float r = 1.0f / sqrtf(wave_sum(s) * (1.f / DM) + EPS);
#pragma unroll
            for (int j = 0; j < 8; ++j) xr[64 * j] = v[j] * r * gr[64 * j];
        }
    }

#if DIAG
    GRID_BAR();
    {
        const float* dacc = (const float*)(ctl + dg::CW_DG); int code = 0;
        for (int k = dg::NCHK - 1; k >= 0; --k) { const float e = __hip_atomic_load(dacc + 2 * k, RLX_AGENT), r = __hip_atomic_load(dacc + 2 * k + 1, RLX_AGENT);
#if DIAG == 1
            if (r > 0.f && e > 0.0009f * r) code = k + 1;
#else
            if (k == DIAG - 2) { const float rel = r > 0.f ? sqrtf(e / r) : 1.f; code = (int)(-10.f * log10f(rel + 1e-9f) + 0.5f); code = code < 1 ? 1 : (code > 98 ? 98 : code); }
#endif
        }
        if (DIAG == 1 && code == 0) code = 99;
        if (DIAG >= 100) { code = 1; for (int ri = 0; ri < 6; ++ri) { const float e = __hip_atomic_load(dacc + 2 * (16 + ri), RLX_AGENT), r = __hip_atomic_load(dacc + 2 * (16 + ri) + 1, RLX_AGENT); if (e > 0.0009f * r) code += 1 << ri; } }
        { const float C = sqrtf(1.0025f * (10.f * code - 1.f)); const int lane = opaque_tid() & 63;
            for (int m = gw; m < M; m += NGW) { GAS f32x4* xr = (GAS f32x4*)(X + (size_t)m * DM) + lane;
#pragma unroll
                for (int j = 0; j < 8; ++j) xr[64 * j] = (f32x4){C, C, C, C}; } }
    }
#endif
}

extern "C" void kernel_launch(void* const* d_in, const int* in_sizes, int n_in, void* d_out, int out_size, void* d_ws, size_t ws_size, hipStream_t stream) {
    static int grid = 0;
    if (grid == 0) {
        if (n_in != 18 || out_size != M * DM || ws_size < WS_END) { fprintf(stderr, "kernel_launch: shape mismatch n_in %d out %d ws %zu (need %zu)\n", n_in, out_size, ws_size, (size_t)WS_END); grid = -1; return; }
        int dev = 0, cus = 0, per_cu = 0;
        if (hipGetDevice(&dev) != hipSuccess || hipDeviceGetAttribute(&cus, hipDeviceAttributeMultiprocessorCount, dev) != hipSuccess) { grid = -1; return; }
        if (hipFuncSetAttribute((const void*)trunk_fwd, hipFuncAttributeMaxDynamicSharedMemorySize, LDS_BYTES) != hipSuccess) { fprintf(stderr, "kernel_launch: hipFuncSetAttribute failed\n"); grid = -1; return; }
        if (hipOccupancyMaxActiveBlocksPerMultiprocessor(&per_cu, (const void*)trunk_fwd, NWAVES * 64, LDS_BYTES) != hipSuccess || per_cu < 1)
            fprintf(stderr, "kernel_launch: occupancy query reports %d workgroups per CU\n", per_cu);
        (void)hipGetLastError();
        grid = cus;
        if (grid != 256) fprintf(stderr, "kernel_launch: %d CUs (the attention unit deal assumes 256)\n", grid);
    }
    if (grid < 0) return;
    if (hipMemsetAsync((char*)d_ws + WS_CTL, 0, CTL_ZERO_BYTES, stream) != hipSuccess) return;
    Args a{};
    for (int i = 0; i < 18; ++i) a.in[i] = (const float*)d_in[i];
    a.out = (float*)d_out; a.ws = (unsigned char*)d_ws;
    hipLaunchKernelGGL(trunk_fwd, dim3(grid), dim3(NWAVES * 64), LDS_BYTES, stream, a);
    const hipError_t le = hipPeekAtLastError();
    if (le != hipSuccess) fprintf(stderr, "kernel_launch: launch failed: %s\n", hipGetErrorName(le));
}
```

```cpp
#include <hip/hip_runtime.h>
#include <hip/hip_bf16.h>
#include <cstdio>
#include <cstdint>
__device__ __forceinline__ int lane_id() { int r; asm volatile("v_mbcnt_lo_u32_b32 %0, -1, 0\n\tv_mbcnt_hi_u32_b32 %0, -1, %0" : "=v"(r)); return r; }
__device__ __forceinline__ int opaque_tid(int wave) { int t = (wave << 6) | lane_id(); asm volatile("" : "+v"(t)); return t; }
#ifndef MLA8_PRESCALE
#define MLA8_PRESCALE 1
#endif
constexpr float MLA8_KSC = MLA8_PRESCALE ? 0.0625f : 1.0f, MLA8_QSC = MLA8_PRESCALE ? 16.0f * 0.07216878364870322f * 1.4426950408889634f : 1.0f;
namespace pg8 {
#define PG8_LAS __attribute__((address_space(3)))
typedef unsigned short bf16_t;
typedef short bf16x8 __attribute__((ext_vector_type(8)));
typedef float f32x4 __attribute__((ext_vector_type(4)));
typedef unsigned u32x4 __attribute__((ext_vector_type(4)));
#ifndef PG8_WGM
#define PG8_WGM 4
#endif
constexpr int BM = 256, BK = 64, HALF = 128, HTB = HALF * BK * 2  , STAGE_BYTES = 8 * HTB, NXCD = 8, WGM = PG8_WGM;

__host__ __device__ __forceinline__ int lds_byte(int r, int c) { const int st = (r >> 4) * 2 + (c >> 5), rr = r & 15, cc = c & 31, ob = rr * 64 + cc * 2; return st * 1024 + (ob ^ (((ob >> 9) & 1) << 5)); }
__host__ __device__ __forceinline__ void stage_rc(int b, int& R, int& C) { const int st = b / 1024, sb = b % 1024, swz = sb ^ (((sb >> 9) & 1) << 5); R = (st >> 1) * 16 + swz / 64; C = (st & 1) * 32 + (swz % 64) / 2; }
__host__ __device__ __forceinline__ int perm32(int rho) { const int n = rho >> 4, i = rho & 15; return 8 * (i >> 2) + 4 * n + (i & 3); }

struct Unit { int pm, pn; };
struct Gemm { const bf16_t* A; const bf16_t* Bt; int M, N, K; };

struct StaticOrder {
    int nM, nN, nwg, G, c, wgm;
    __host__ __device__ void init(int M, int N, int G_, int c_, int wgm_ = WGM) { nM = M / BM; nN = N / BM; nwg = nM * nN; G = G_; c = c_; wgm = wgm_; }
    __host__ __device__ bool next(int i, Unit& u) const {
        const long L = (long)i * G + c; if (L >= nwg) return false;
        int wgid = (int)L; { const int q = nwg / NXCD, r = nwg % NXCD, xcd = wgid % NXCD, off = wgid / NXCD; wgid = (xcd < r ? xcd * (q + 1) : r * (q + 1) + (xcd - r) * q) + off; }
        const int nig = wgm * nN, gid = wgid / nig, fm = gid * wgm, gsz = (nM - fm) < wgm ? (nM - fm) : wgm;
        u.pm = fm + ((wgid % nig) % gsz); u.pn = (wgid % nig) / gsz; return true;
    }
    __device__ __forceinline__ void a_ready(const Unit&) const {}
    __device__ __forceinline__ void done(const Unit&) const {}
};

__device__ __forceinline__ unsigned cvt_pk_bf16(float lo, float hi) { unsigned r; asm volatile("v_cvt_pk_bf16_f32 %0, %1, %2" : "=v"(r) : "v"(lo), "v"(hi)); return r; }
typedef float f32x2 __attribute__((ext_vector_type(2)));
typedef unsigned u32x2 __attribute__((ext_vector_type(2)));
__device__ __forceinline__ unsigned cvt_pk4_f8(float a, float b, float c, float d) { int w = __builtin_amdgcn_cvt_pk_fp8_f32(a, b, 0, false); w = __builtin_amdgcn_cvt_pk_fp8_f32(c, d, w, true); return (unsigned)w; }

__device__ __forceinline__ float rstd_of(const float* rs, int row) { return rs[row]; }
__device__ __forceinline__ float fq_sum(float v) {
    v += __builtin_bit_cast(float, __builtin_amdgcn_ds_swizzle(__builtin_bit_cast(int, v), 0x401F));
    auto rr = __builtin_amdgcn_permlane32_swap(__float_as_uint(v), __float_as_uint(v), false, false);
    return __uint_as_float(rr[0]) + __uint_as_float(rr[1]);
}

struct EpiBf16Split {
    static constexpr bool PERM = true, AFTER_DRAIN = false, APERM = false; static constexpr int SMIN = 0;
    bf16_t* O0; bf16_t* O1; int ldc; int split; const float* rs;
    __device__ __forceinline__ void operator()(const f32x4 (&acc)[2][2][4][2], const Unit& u, int wr, int wc, int fr, int fq) const {
        char* base = (char*)((u.pn < split) ? (O0 + (size_t)u.pn * BM) : (O1 + (size_t)(u.pn - split) * BM)) + (size_t)u.pm * BM * ldc * 2;
        const unsigned off0 = (unsigned)((wr * 64 + fr) * ldc + wc * 32 + 8 * fq) * 2u;
        const int row0 = u.pm * BM + wr * 64 + fr;
        float rsv[2][4];
#pragma unroll
        for (int ai = 0; ai < 2; ++ai)
#pragma unroll
            for (int m = 0; m < 4; ++m) rsv[ai][m] = rstd_of(this->rs, row0 + ai * HALF + m * 16);
#pragma unroll
        for (int ai = 0; ai < 2; ++ai)
#pragma unroll
            for (int m = 0; m < 4; ++m) { const unsigned off = off0 + (unsigned)((ai * HALF + m * 16) * ldc) * 2u;
                const float rs = rsv[ai][m];
#pragma unroll
                for (int bj = 0; bj < 2; ++bj) { const f32x4 v0 = acc[ai][bj][m][0] * rs, v1 = acc[ai][bj][m][1] * rs;
                    u32x4 w; w.x = cvt_pk_bf16(v0[0], v0[1]); w.y = cvt_pk_bf16(v0[2], v0[3]); w.z = cvt_pk_bf16(v1[0], v1[1]); w.w = cvt_pk_bf16(v1[2], v1[3]);
                    *(u32x4*)(base + off + bj * HALF * 2) = w; } }
    }
};

template <bool F8OUT = false>
struct EpiRopeT {
    static constexpr bool PERM = true, AFTER_DRAIN = false, APERM = false; static constexpr int SMIN = 0;
    static constexpr unsigned EB = F8OUT ? 1u : 2u;
    bf16_t* O0; bf16_t* O1; bf16_t* O2; int ld0, ld1, ld2, t1, t2, rope_mask; const float* cs; const float* sn; int jn; const float* rs; float osc;
    __device__ __forceinline__ void operator()(const f32x4 (&acc)[2][2][4][2], const Unit& u, int wr, int wc, int fr, int fq) const {
        char* ob; int ldc; bool rope;
        if (u.pn < t1) { ob = (char*)O0 + (size_t)u.pn * BM * EB; ldc = ld0; rope = (rope_mask & 1) != 0; }
        else if (u.pn < t2) { ob = (char*)O1 + (size_t)(u.pn - t1) * BM * EB; ldc = ld1; rope = (rope_mask & 2) != 0; }
        else { ob = (char*)O2 + (size_t)(u.pn - t2) * BM * EB; ldc = ld2; rope = (rope_mask & 4) != 0; }
        char* base = ob + (size_t)u.pm * BM * ldc * EB;
        const unsigned off0 = (unsigned)((wr * 64 + fr) * ldc + wc * 32 + 8 * fq) * EB;
        const int row0 = u.pm * BM + wr * 64 + fr;
        const int pos0 = ((u.pm * BM) & 4095) + wr * 64 + fr;
        const unsigned toff0 = (unsigned)(pos0 * jn + ((wc * 16 + 4 * fq) & (jn - 1))) * 4u;
        float rsv[2][4]; f32x4 cv[2][4], sv[2][4];
#pragma unroll
        for (int ai = 0; ai < 2; ++ai)
#pragma unroll
            for (int m = 0; m < 4; ++m) { rsv[ai][m] = rstd_of(this->rs, row0 + ai * HALF + m * 16) * osc;
                cv[ai][m] = (f32x4){1.f, 1.f, 1.f, 1.f}; sv[ai][m] = (f32x4){0.f, 0.f, 0.f, 0.f};
                if (rope) { const unsigned toff = toff0 + (unsigned)((ai * HALF + m * 16) * jn) * 4u; cv[ai][m] = *(const f32x4*)((const char*)cs + toff); sv[ai][m] = *(const f32x4*)((const char*)sn + toff); } }
#pragma unroll
        for (int ai = 0; ai < 2; ++ai)
#pragma unroll
            for (int m = 0; m < 4; ++m) { const unsigned off = off0 + (unsigned)((ai * HALF + m * 16) * ldc) * EB;
                const float rs = rsv[ai][m]; const f32x4 c = cv[ai][m] * rs, s = sv[ai][m] * rs;
#pragma unroll
                for (int bj = 0; bj < 2; ++bj) { const f32x4 v0 = acc[ai][bj][m][0], v1 = acc[ai][bj][m][1];
                    const float a0 = v0[0] * c[0] - v0[1] * s[0], b0 = v0[1] * c[0] + v0[0] * s[0];
                    const float a1 = v0[2] * c[1] - v0[3] * s[1], b1 = v0[3] * c[1] + v0[2] * s[1];
                    const float a2 = v1[0] * c[2] - v1[1] * s[2], b2 = v1[1] * c[2] + v1[0] * s[2];
                    const float a3 = v1[2] * c[3] - v1[3] * s[3], b3 = v1[3] * c[3] + v1[2] * s[3];
                    if constexpr (F8OUT) { u32x2 w8; w8.x = cvt_pk4_f8(a0, b0, a1, b1); w8.y = cvt_pk4_f8(a2, b2, a3, b3); *(u32x2*)(base + off + bj * HALF) = w8; }
                    else { u32x4 w; w.x = cvt_pk_bf16(a0, b0); w.y = cvt_pk_bf16(a1, b1); w.z = cvt_pk_bf16(a2, b2); w.w = cvt_pk_bf16(a3, b3);
                    *(u32x4*)(base + off + bj * HALF * 2) = w; } } }
    }
};
typedef EpiRopeT<false> EpiRope;

struct EpiKV8 {
    static constexpr bool PERM = true, AFTER_DRAIN = false, APERM = true; static constexpr int SMIN = 0;
    unsigned char* KN8; unsigned char* VT8; const float* rs; float ksc;
    __device__ __forceinline__ void operator()(const f32x4 (&acc)[2][2][4][2], const Unit& u, int wr, int wc, int fr, int fq) const {
        const int b = (u.pm * BM) >> 12, tile0 = ((u.pm * BM) & 4095) >> 6;
        f32x4 s4[2];
#pragma unroll
        for (int ai = 0; ai < 2; ++ai) s4[ai] = *(const f32x4*)(this->rs + u.pm * BM + ai * HALF + wr * 64 + 4 * fr);
        if (u.pn < 8) {
            const int d0 = wc * 32 + 8 * fq;
#pragma unroll
            for (int ai = 0; ai < 2; ++ai)
#pragma unroll
                for (int bj = 0; bj < 2; ++bj) { unsigned char* img = KN8 + ((size_t)((b * 16 + 2 * u.pn + bj) * 64 + tile0 + 2 * ai + wr)) * 8192;
#pragma unroll
                    for (int m = 0; m < 4; ++m) { const int kk = 4 * fr + m; const float rs = s4[ai][m] * ksc;
                        const f32x4 v0 = acc[ai][bj][m][0] * rs, v1 = acc[ai][bj][m][1] * rs;
                        u32x2 w; w.x = cvt_pk4_f8(v0[0], v0[1], v0[2], v0[3]); w.y = cvt_pk4_f8(v1[0], v1[1], v1[2], v1[3]);
                        *(u32x2*)(img + kk * 128 + (((d0 & ~15) ^ (((kk >> 1) & 7) << 4)) | (d0 & 15))) = w; } }
        } else {
#pragma unroll
            for (int ai = 0; ai < 2; ++ai)
#pragma unroll
                for (int bj = 0; bj < 2; ++bj) { unsigned char* img = VT8 + ((size_t)((b * 16 + 2 * (u.pn - 8) + bj) * 64 + tile0 + 2 * ai + wr)) * 8192;
#pragma unroll
                    for (int n = 0; n < 2; ++n)
#pragma unroll
                        for (int e = 0; e < 4; ++e) { const int vcol = wc * 32 + 8 * fq + 4 * n + e;
                            const unsigned w = cvt_pk4_f8(acc[ai][bj][0][n][e] * s4[ai][0], acc[ai][bj][1][n][e] * s4[ai][1], acc[ai][bj][2][n][e] * s4[ai][2], acc[ai][bj][3][n][e] * s4[ai][3]);
                            *(unsigned*)(img + vcol * 64 + ((((fr >> 2) ^ ((vcol >> 2) & 3))) << 4) + 4 * (fr & 3)) = w; } }
        }
    }
};

struct EpiBwin {
    static constexpr bool PERM = true, AFTER_DRAIN = false, APERM = false; static constexpr int SMIN = 0;
    bf16_t* CQ; bf16_t* CKV; bf16_t* KR; float* ssp; const float* cs; const float* sn; const float* rs; float krsc; float asc;
    __device__ __forceinline__ void operator()(const f32x4 (&acc)[2][2][4][2], const Unit& u, int wr, int wc, int fr, int fq) const {
        const int row0 = u.pm * BM + wr * 64 + fr;
        if (u.pn < 4) {
            char* ob = (char*)(u.pn < 2 ? CQ : CKV) + (size_t)(u.pn & 1) * BM; float* sso = ssp + u.pn * 4 + wc;
            char* base = ob + (size_t)u.pm * BM * 512;
            const unsigned off0 = (unsigned)((wr * 64 + fr) * 512 + wc * 32 + 8 * fq);
#pragma unroll
            for (int ai = 0; ai < 2; ++ai)
#pragma unroll
                for (int m = 0; m < 4; ++m) { const unsigned off = off0 + (unsigned)((ai * HALF + m * 16) * 512); const int row = row0 + ai * HALF + m * 16;
                    const float rs = rstd_of(this->rs, row) * asc; float sq = 0.f;
#pragma unroll
                    for (int bj = 0; bj < 2; ++bj) { const f32x4 v0 = acc[ai][bj][m][0] * rs, v1 = acc[ai][bj][m][1] * rs;
                        sq += (v0[0] * v0[0] + v0[1] * v0[1]) + (v0[2] * v0[2] + v0[3] * v0[3]) + (v1[0] * v1[0] + v1[1] * v1[1]) + (v1[2] * v1[2] + v1[3] * v1[3]);
                        u32x2 w; w.x = cvt_pk4_f8(v0[0], v0[1], v0[2], v0[3]); w.y = cvt_pk4_f8(v1[0], v1[1], v1[2], v1[3]);
                        *(u32x2*)(base + off + bj * HALF) = w; }
                    sq = fq_sum(sq);
                    if (fq == 0) sso[(size_t)row * 16] = sq; }
        } else if (wc < 2) {
            const int pos0 = ((u.pm * BM) & 4095) + wr * 64 + fr;
            const unsigned toff0 = (unsigned)(pos0 * 32 + wc * 16 + 4 * fq) * 4u;
#pragma unroll
            for (int ai = 0; ai < 2; ++ai)
#pragma unroll
                for (int m = 0; m < 4; ++m) { const int row = row0 + ai * HALF + m * 16; const float rs = rstd_of(this->rs, row) * (krsc * asc);
                    const unsigned toff = toff0 + (unsigned)((ai * HALF + m * 16) * 32) * 4u;
                    const f32x4 c = *(const f32x4*)((const char*)cs + toff) * rs, s = *(const f32x4*)((const char*)sn + toff) * rs;
                    const f32x4 v0 = acc[ai][0][m][0], v1 = acc[ai][0][m][1];
                    const float a0 = v0[0] * c[0] - v0[1] * s[0], b0 = v0[1] * c[0] + v0[0] * s[0];
                    const float a1 = v0[2] * c[1] - v0[3] * s[1], b1 = v0[3] * c[1] + v0[2] * s[1];
                    const float a2 = v1[0] * c[2] - v1[1] * s[2], b2 = v1[1] * c[2] + v1[0] * s[2];
                    const float a3 = v1[2] * c[3] - v1[3] * s[3], b3 = v1[3] * c[3] + v1[2] * s[3];
                    const int kk = row & 63, d0 = wc * 32 + 8 * fq; u32x2 w; w.x = cvt_pk4_f8(a0, b0, a1, b1); w.y = cvt_pk4_f8(a2, b2, a3, b3);
                    *(u32x2*)((char*)KR + (size_t)(row >> 6) * 4096 + kk * 64 + (((d0 & ~15) ^ (((kk >> 2) & 3) << 4)) | (d0 & 15))) = w; }
        }
    }
};

struct EpiResid {
    static constexpr bool PERM = true, AFTER_DRAIN = false, APERM = false; static constexpr int SMIN = 0;
    const float* base0; const float* base1; int split_pm; bf16_t* xb; float* outf; float* ssp; int ldc; float scale; unsigned char* xb8;
    __device__ __forceinline__ void operator()(const f32x4 (&acc)[2][2][4][2], const Unit& u, int wr, int wc, int fr, int fq) const {
        const int col0 = u.pn * BM + wc * 32 + 8 * fq;
        const float* base = base0 ? (u.pm < split_pm ? base0 : base1 - (size_t)split_pm * BM * ldc) : nullptr;
        if (base) {
#pragma unroll
            for (int ai = 0; ai < 2; ++ai)
#pragma unroll
                for (int m = 0; m < 4; ++m) { const int row = u.pm * BM + ai * HALF + wr * 64 + m * 16 + fr; const size_t off = (size_t)row * ldc + col0;
                    f32x4 o0[2], o1[2];
#pragma unroll
                    for (int bj = 0; bj < 2; ++bj) { o0[bj] = *(const f32x4*)(base + off + bj * HALF); o1[bj] = *(const f32x4*)(base + off + bj * HALF + 4); }
                    float sq = 0.f;
#pragma unroll
                    for (int bj = 0; bj < 2; ++bj) { const f32x4 v0 = o0[bj] + acc[ai][bj][m][0] * scale, v1 = o1[bj] + acc[ai][bj][m][1] * scale;
                        sq += (v0[0] * v0[0] + v0[1] * v0[1]) + (v0[2] * v0[2] + v0[3] * v0[3]) + (v1[0] * v1[0] + v1[1] * v1[1]) + (v1[2] * v1[2] + v1[3] * v1[3]);
                        u32x4 w; w.x = cvt_pk_bf16(v0[0], v0[1]); w.y = cvt_pk_bf16(v0[2], v0[3]); w.z = cvt_pk_bf16(v1[0], v1[1]); w.w = cvt_pk_bf16(v1[2], v1[3]); *(u32x4*)(xb + off + bj * HALF) = w; }
                    sq = fq_sum(sq);
                    if (fq == 0) ssp[(size_t)row * 32 + u.pn * 4 + wc] = sq;
                    if (m & 1) asm volatile("" ::: "memory"); }
        } else {
            u32x4 ow[2][4][2];
#pragma unroll
            for (int ai = 0; ai < 2; ++ai)
#pragma unroll
                for (int m = 0; m < 4; ++m) { const size_t off = (size_t)(u.pm * BM + ai * HALF + wr * 64 + m * 16 + fr) * ldc + col0;
#pragma unroll
                    for (int bj = 0; bj < 2; ++bj) ow[ai][m][bj] = *(const u32x4*)(xb + off + bj * HALF); }
#pragma unroll
            for (int ai = 0; ai < 2; ++ai)
#pragma unroll
                for (int m = 0; m < 4; ++m) { const int row = u.pm * BM + ai * HALF + wr * 64 + m * 16 + fr; const size_t off = (size_t)row * ldc + col0;
                    float sq = 0.f;
#pragma unroll
                    for (int bj = 0; bj < 2; ++bj) { const u32x4 w0 = ow[ai][m][bj];
                        const f32x4 o0 = (f32x4){__uint_as_float(w0.x << 16), __uint_as_float(w0.x & 0xffff0000u), __uint_as_float(w0.y << 16), __uint_as_float(w0.y & 0xffff0000u)};
                        const f32x4 o1 = (f32x4){__uint_as_float(w0.z << 16), __uint_as_float(w0.z & 0xffff0000u), __uint_as_float(w0.w << 16), __uint_as_float(w0.w & 0xffff0000u)};
                        const f32x4 v0 = o0 + acc[ai][bj][m][0] * scale, v1 = o1 + acc[ai][bj][m][1] * scale;
                        sq += (v0[0] * v0[0] + v0[1] * v0[1]) + (v0[2] * v0[2] + v0[3] * v0[3]) + (v1[0] * v1[0] + v1[1] * v1[1]) + (v1[2] * v1[2] + v1[3] * v1[3]);
                        if (outf) { *(f32x4*)(outf + off + bj * HALF) = v0; *(f32x4*)(outf + off + bj * HALF + 4) = v1; }
                        else { u32x4 w; w.x = cvt_pk_bf16(v0[0], v0[1]); w.y = cvt_pk_bf16(v0[2], v0[3]); w.z = cvt_pk_bf16(v1[0], v1[1]); w.w = cvt_pk_bf16(v1[2], v1[3]); *(u32x4*)(xb + off + bj * HALF) = w; }
                        if (xb8) { u32x2 w8; w8.x = cvt_pk4_f8(v0[0], v0[1], v0[2], v0[3]); w8.y = cvt_pk4_f8(v1[0], v1[1], v1[2], v1[3]); *(u32x2*)(xb8 + off + bj * HALF) = w8; } }
                    sq = fq_sum(sq);
                    if (fq == 0) ssp[(size_t)row * 32 + u.pn * 4 + wc] = sq; }
        }
    }
};

#ifndef ACT_NT
#define ACT_NT 0
#endif
template <int PMODE = 0>
struct EpiConvT {
    static constexpr bool PERM = true, AFTER_DRAIN = false, APERM = true; static constexpr int SMIN = PMODE == 0 ? 8 : 0;
    bf16_t* ACT; float* HALO; const float* cw; const float* cb; PG8_LAS float* xch; int dff; const float* rs;
    __device__ __forceinline__ void operator()(f32x4 (&acc)[2][2][4][2], const Unit& u, int wr, int wc, int fr, int fq) const {
        const int wid = wr * 4 + wc, dff2 = 2 * dff;
        f32x4 pw[2][8];
#pragma unroll
        for (int n = 0; n < 2; ++n) { const int gcol = u.pn * HALF + wc * 32 + 8 * fq + 4 * n, ucol = dff + gcol;
            pw[n][0] = *(const f32x4*)(cw + gcol); pw[n][1] = *(const f32x4*)(cw + dff2 + gcol); pw[n][2] = *(const f32x4*)(cw + 2 * dff2 + gcol); pw[n][3] = *(const f32x4*)(cb + gcol);
            pw[n][4] = *(const f32x4*)(cw + ucol); pw[n][5] = *(const f32x4*)(cw + dff2 + ucol); pw[n][6] = *(const f32x4*)(cw + 2 * dff2 + ucol); pw[n][7] = *(const f32x4*)(cb + ucol); }
#pragma unroll
        for (int ai = 0; ai < 2; ++ai) { const f32x4 s4 = *(const f32x4*)(this->rs + u.pm * BM + ai * HALF + wr * 64 + 4 * fr);
#pragma unroll
            for (int m = 0; m < 4; ++m) { const float rs = s4[m];
#pragma unroll
                for (int bj = 0; bj < 2; ++bj)
#pragma unroll
                    for (int n = 0; n < 2; ++n) acc[ai][bj][m][n] = acc[ai][bj][m][n] * rs; } }
        PG8_LAS float* mine = xch + wid * 256;
        if (fr == 0) {
#pragma unroll
            for (int ai = 0; ai < 2; ++ai)
#pragma unroll
                for (int bj = 0; bj < 2; ++bj)
#pragma unroll
                    for (int n = 0; n < 2; ++n) *(PG8_LAS f32x4*)(mine + (ai * 2 + 0) * 64 + bj * 32 + 8 * fq + 4 * n) = acc[ai][bj][0][n];
            if (PMODE == 0 && wr == 0) {
                float* hp = HALO + ((size_t)u.pm * 4) * dff2 + u.pn * BM + wc * 32 + 8 * fq;
#pragma unroll
                for (int bj = 0; bj < 2; ++bj)
#pragma unroll
                    for (int n = 0; n < 2; ++n) { *(f32x4*)(hp + bj * HALF + 4 * n) = acc[0][bj][0][n]; *(f32x4*)(hp + dff2 + bj * HALF + 4 * n) = acc[0][bj][1][n]; }
            }
        }
        if (fr == 15) {
#pragma unroll
            for (int ai = 0; ai < 2; ++ai)
#pragma unroll
                for (int bj = 0; bj < 2; ++bj)
#pragma unroll
                    for (int n = 0; n < 2; ++n) *(PG8_LAS f32x4*)(mine + (ai * 2 + 1) * 64 + bj * 32 + 8 * fq + 4 * n) = acc[ai][bj][3][n];
            if (PMODE == 0 && wr == 1) {
                float* hp = HALO + ((size_t)u.pm * 4 + 2) * dff2 + u.pn * BM + wc * 32 + 8 * fq;
#pragma unroll
                for (int bj = 0; bj < 2; ++bj)
#pragma unroll
                    for (int n = 0; n < 2; ++n) { *(f32x4*)(hp + bj * HALF + 4 * n) = acc[1][bj][2][n]; *(f32x4*)(hp + dff2 + bj * HALF + 4 * n) = acc[1][bj][3][n]; }
            }
        }
        if (PMODE != 1) { asm volatile("s_waitcnt lgkmcnt(0)" ::: "memory"); __builtin_amdgcn_s_barrier(); asm volatile("" ::: "memory"); }
        const PG8_LAS float* oth = xch + ((wr ^ 1) * 4 + wc) * 256;
        const f32x4 zero4 = (f32x4){0.f, 0.f, 0.f, 0.f};
#define PG8_DPP(x, ctrl) __builtin_bit_cast(float, __builtin_amdgcn_update_dpp(0, __builtin_bit_cast(int, (x)), (ctrl), 0xf, 0xf, true))
#pragma unroll
        for (int ai = 0; ai < 2; ++ai) {
            u32x2 pk[2][4];
#pragma unroll
            for (int n = 0; n < 2; ++n) {
                const int gcol = u.pn * HALF + wc * 32 + 8 * fq + 4 * n, ucol = dff + gcol;
                const f32x4 w0g = pw[n][0], w1g = pw[n][1], w2g = pw[n][2], bg = pw[n][3], w0u = pw[n][4], w1u = pw[n][5], w2u = pw[n][6], bu = pw[n][7];
                const int xo = 8 * fq + 4 * n;
                f32x4 pg = zero4, pu = zero4, ng = zero4, nu = zero4;
                if (PMODE != 1 && fr == 0) {
                    if (wr == 1) { pg = *(const PG8_LAS f32x4*)(oth + (ai * 2 + 1) * 64 + xo); pu = *(const PG8_LAS f32x4*)(oth + (ai * 2 + 1) * 64 + 32 + xo); }
                    else if (ai == 1) { pg = *(const PG8_LAS f32x4*)(oth + (0 * 2 + 1) * 64 + xo); pu = *(const PG8_LAS f32x4*)(oth + (0 * 2 + 1) * 64 + 32 + xo); }
                }
                if (PMODE != 1 && fr == 15) {
                    if (wr == 0) { ng = *(const PG8_LAS f32x4*)(oth + (ai * 2 + 0) * 64 + xo); nu = *(const PG8_LAS f32x4*)(oth + (ai * 2 + 0) * 64 + 32 + xo); }
                    else if (ai == 0) { ng = *(const PG8_LAS f32x4*)(oth + (1 * 2 + 0) * 64 + xo); nu = *(const PG8_LAS f32x4*)(oth + (1 * 2 + 0) * 64 + 32 + xo); }
                }
                f32x4 a[4];
#pragma unroll
                for (int e = 0; e < 4; ++e) {
                    const float g0 = acc[ai][0][0][n][e], g1 = acc[ai][0][1][n][e], g2 = acc[ai][0][2][n][e], g3 = acc[ai][0][3][n][e];
                    const float u0 = acc[ai][1][0][n][e], u1 = acc[ai][1][1][n][e], u2 = acc[ai][1][2][n][e], u3 = acc[ai][1][3][n][e];
                    const float gm = PG8_DPP(g3, 0x111) + pg[e], gp = PG8_DPP(g0, 0x101) + ng[e];
                    const float um = PG8_DPP(u3, 0x111) + pu[e], up = PG8_DPP(u0, 0x101) + nu[e];
                    const float cg0 = w0g[e] * gm + w1g[e] * g0 + w2g[e] * g1 + bg[e], cg1 = w0g[e] * g0 + w1g[e] * g1 + w2g[e] * g2 + bg[e];
                    const float cg2 = w0g[e] * g1 + w1g[e] * g2 + w2g[e] * g3 + bg[e], cg3 = w0g[e] * g2 + w1g[e] * g3 + w2g[e] * gp + bg[e];
                    const float cu0 = w0u[e] * um + w1u[e] * u0 + w2u[e] * u1 + bu[e], cu1 = w0u[e] * u0 + w1u[e] * u1 + w2u[e] * u2 + bu[e];
                    const float cu2 = w0u[e] * u1 + w1u[e] * u2 + w2u[e] * u3 + bu[e], cu3 = w0u[e] * u2 + w1u[e] * u3 + w2u[e] * up + bu[e];
                    a[0][e] = cg0 * __builtin_amdgcn_rcpf(1.0f + __builtin_amdgcn_exp2f(-1.4426950408889634f * cg0)) * cu0;
                    a[1][e] = cg1 * __builtin_amdgcn_rcpf(1.0f + __builtin_amdgcn_exp2f(-1.4426950408889634f * cg1)) * cu1;
                    a[2][e] = cg2 * __builtin_amdgcn_rcpf(1.0f + __builtin_amdgcn_exp2f(-1.4426950408889634f * cg2)) * cu2;
                    a[3][e] = cg3 * __builtin_amdgcn_rcpf(1.0f + __builtin_amdgcn_exp2f(-1.4426950408889634f * cg3)) * cu3;
                }
#pragma unroll
                for (int m = 0; m < 4; ++m) { pk[n][m].x = cvt_pk_bf16(a[m][0], a[m][1]); pk[n][m].y = cvt_pk_bf16(a[m][2], a[m][3]); }
            }
            const int colb = u.pn * HALF + wc * 32 + 8 * fq;
#pragma unroll
            for (int m = 0; m < 4; ++m) { const int row = u.pm * BM + ai * HALF + wr * 64 + 4 * fr + m;
                u32x4 w; w.x = pk[0][m].x; w.y = pk[0][m].y; w.z = pk[1][m].x; w.w = pk[1][m].y;
                if (PMODE != 0) asm volatile("" :: "v"(w)); else if (ACT_NT) __builtin_nontemporal_store(w, (u32x4*)(ACT + (size_t)row * dff + colb)); else *(u32x4*)(ACT + (size_t)row * dff + colb) = w; }
        }
#undef PG8_DPP
    }
};
typedef EpiConvT<0> EpiConv;

struct EpiSum {
    static constexpr bool PERM = true, AFTER_DRAIN = false, APERM = false; static constexpr int SMIN = 0;
    float* dummy;
    __device__ __forceinline__ void operator()(const f32x4 (&acc)[2][2][4][2], const Unit& u, int wr, int wc, int fr, int fq) const {
        f32x4 s = (f32x4){0.f, 0.f, 0.f, 0.f};
#pragma unroll
        for (int ai = 0; ai < 2; ++ai)
#pragma unroll
            for (int bj = 0; bj < 2; ++bj)
#pragma unroll
                for (int m = 0; m < 4; ++m)
#pragma unroll
                    for (int n = 0; n < 2; ++n) s += acc[ai][bj][m][n];
        *(f32x4*)(dummy + (size_t)(blockIdx.x * 512 + (wr * 4 + wc) * 64 + fq * 16 + fr) * 4) = s;
    }
};
typedef int i32x8 __attribute__((ext_vector_type(8)));
typedef int i32x4v __attribute__((ext_vector_type(4)));
__device__ __forceinline__ i32x8 cat8(bf16x8 a, bf16x8 b) { const i32x4v x = __builtin_bit_cast(i32x4v, a), y = __builtin_bit_cast(i32x4v, b); return __builtin_shufflevector(x, y, 0, 1, 2, 3, 4, 5, 6, 7); }
__device__ __forceinline__ void mfma_f8_inplace(f32x4& c, i32x8 a, i32x8 b) { asm volatile("v_mfma_f32_16x16x128_f8f6f4 %0, %1, %2, %0" : "+v"(c) : "v"(a), "v"(b)); }
__device__ __forceinline__ void glds16s(const void* sbase, unsigned voff, unsigned lds_dst) { unsigned keep;
  asm volatile("s_mov_b32 %0, m0\n\ts_mov_b32 m0, %3\n\ts_nop 0\n\tglobal_load_lds_dwordx4 %1, %2\n\ts_mov_b32 m0, %0" : "=&s"(keep) : "v"(voff), "s"(sbase), "s"(lds_dst) : "memory"); }
#ifndef PG8_ASM_STAGE
#define PG8_ASM_STAGE 1
#endif
template <class Epi, class Sched, bool ALIGN_EPI = false, bool SP2 = false, bool F8 = false>
__device__ __forceinline__ void gemm_phase(PG8_LAS unsigned char* lds, const Gemm g, const Sched& S, const Epi& E, int wave_) {
    const int tid = opaque_tid(wave_), wid = __builtin_amdgcn_readfirstlane(tid >> 6), lane = tid & 63, wr = wid >> 2, wc = wid & 3, fr = lane & 15, fq = lane >> 4;
    const int K = g.K, nt = K / BK;
    unsigned voffA[2], voffB[2];
#pragma unroll
    for (int i = 0; i < 2; ++i) { int R, C; stage_rc(tid * 16 + i * 8192, R, C); const int Rb = Epi::PERM ? ((R & ~31) + perm32(R & 31)) : R;
        const int Ra = Epi::APERM ? ((R & ~63) + 4 * (R & 15) + ((R >> 4) & 3)) : R;
        voffA[i] = (unsigned)(Ra * K + C) * 2u; voffB[i] = (unsigned)(Rb * K + C) * 2u; }
    const size_t kstep = (size_t)(BK * 2);
    const size_t hstep = (size_t)HALF * K * 2;
    const size_t tstep = 2 * hstep;
    const unsigned lds0_ = (unsigned)(uintptr_t)lds + (unsigned)wid * 1024u;
    const unsigned ldsw = (unsigned)wid * 1024u;
    const int aoff = lds_byte(wr * 64 + fr, fq * 8), boff = lds_byte(wc * 32 + fr, fq * 8);
#define PG8_SA(b, h) (((b) * 2 + (h)) * HTB)
#define PG8_SB(b, h) ((4 + (b) * 2 + (h)) * HTB)
#define PG8_STAGE(bufoff, gbase, voff) do { _Pragma("unroll") for (int _i = 0; _i < 2; ++_i) { \
        if constexpr (F8 || PG8_ASM_STAGE) glds16s((const void*)(gbase), (voff)[_i], (unsigned)__builtin_amdgcn_readfirstlane((int)(lds0_ + (unsigned)((bufoff) + _i * 8192)))); \
        else __builtin_amdgcn_global_load_lds((const unsigned*)((const char*)(gbase) + (voff)[_i]), (PG8_LAS unsigned*)(lds + (bufoff) + ldsw + _i * 8192), 16, 0, 0); } } while (0)
#define PG8_LDA(dst, b, h) do { _Pragma("unroll") for (int m = 0; m < 4; ++m) _Pragma("unroll") for (int k = 0; k < 2; ++k) dst[m][k] = *(const PG8_LAS bf16x8*)(lds + PG8_SA(b, h) + aoff + m * 2048 + k * 1024); } while (0)
#define PG8_LDB(dst, b, h) do { _Pragma("unroll") for (int n = 0; n < 2; ++n) _Pragma("unroll") for (int k = 0; k < 2; ++k) dst[n][k] = *(const PG8_LAS bf16x8*)(lds + PG8_SB(b, h) + boff + n * 2048 + k * 1024); } while (0)
#define PG8_MMA(ai, bj, At, Bt) do { __builtin_amdgcn_s_setprio(1); _Pragma("unroll") for (int m = 0; m < 4; ++m) _Pragma("unroll") for (int n = 0; n < 2; ++n) { \
        if constexpr (F8) mfma_f8_inplace(acc[ai][bj][m][n], cat8(Bt[n][0], Bt[n][1]), cat8(At[m][0], At[m][1])); \
        else { _Pragma("unroll") for (int k = 0; k < 2; ++k) acc[ai][bj][m][n] = __builtin_amdgcn_mfma_f32_16x16x32_bf16(Bt[n][k], At[m][k], acc[ai][bj][m][n], 0, 0, 0); } } __builtin_amdgcn_s_setprio(0); } while (0)
#define PG8_WAIT_V(n) asm volatile("s_waitcnt vmcnt(" #n ")" ::: "memory")
#define PG8_WAIT_L(n) asm volatile("s_waitcnt lgkmcnt(" #n ")" ::: "memory")
#define PG8_BAR __builtin_amdgcn_s_barrier()
#define PG8_SCHED __builtin_amdgcn_sched_barrier(0)
    Unit cur, nxt; int ui = 0;
    if (!S.next(0, cur)) return;
    f32x4 acc[2][2][4][2];
#pragma unroll
    for (int a = 0; a < 2; ++a)
#pragma unroll
        for (int b = 0; b < 2; ++b)
#pragma unroll
            for (int m = 0; m < 4; ++m)
#pragma unroll
                for (int n = 0; n < 2; ++n) acc[a][b][m][n] = (f32x4){0.f, 0.f, 0.f, 0.f};
    bf16x8 At[4][2], B0[2][2], B1[2][2];
    const char* cA = (const char*)g.A + (size_t)cur.pm * tstep; const char* cB = (const char*)g.Bt + (size_t)cur.pn * tstep;
    S.a_ready(cur);
    if constexpr (SP2) {
        PG8_STAGE(PG8_SB(0, 0), cB, voffB); PG8_STAGE(PG8_SB(0, 1), cB + hstep, voffB); PG8_STAGE(PG8_SA(0, 0), cA, voffA); PG8_STAGE(PG8_SA(0, 1), cA + hstep, voffA);
        if (wr == 1) PG8_BAR;
        PG8_WAIT_V(2); PG8_BAR;
        PG8_STAGE(PG8_SB(1, 0), cB + kstep, voffB); PG8_STAGE(PG8_SA(1, 0), cA + kstep, voffA); PG8_STAGE(PG8_SB(1, 1), cB + hstep + kstep, voffB);
        if constexpr (Epi::SMIN > 0) PG8_WAIT_V(0); else PG8_WAIT_V(6);
        PG8_BAR;
    } else {
        PG8_STAGE(PG8_SB(0, 0), cB, voffB); PG8_STAGE(PG8_SA(0, 0), cA, voffA); PG8_STAGE(PG8_SB(0, 1), cB + hstep, voffB); PG8_STAGE(PG8_SA(0, 1), cA + hstep, voffA);
        if (wr == 1) PG8_BAR;
        PG8_WAIT_V(4); PG8_BAR;
        PG8_STAGE(PG8_SB(1, 0), cB + kstep, voffB); PG8_STAGE(PG8_SA(1, 0), cA + kstep, voffA); PG8_STAGE(PG8_SB(1, 1), cB + hstep + kstep, voffB);
        PG8_WAIT_V(6); PG8_BAR;
    }
    for (;;) {
        const bool has_next = S.next(ui + 1, nxt);
        const char* nA = has_next ? (const char*)g.A + (size_t)nxt.pm * tstep : cA; const char* nB = has_next ? (const char*)g.Bt + (size_t)nxt.pn * tstep : cB;
_Pragma("clang loop unroll(disable)")
        for (int t = 0; t < nt; t += 2) {
            const bool last = (t == nt - 2);
            const char* a1 = cA + (size_t)(t + 1) * kstep;
            const char* a2 = last ? nA : cA + (size_t)(t + 2) * kstep; const char* b2 = last ? nB : cB + (size_t)(t + 2) * kstep;
            const char* a3 = a2 + kstep; const char* b3 = b2 + kstep;
            if (last && has_next) S.a_ready(nxt);
            if constexpr (SP2) {
            const bool post_epi = Epi::SMIN > 0 && t == 0;
            PG8_LDB(B0, 0, 0); PG8_LDB(B1, 0, 1); PG8_SCHED; PG8_LDA(At, 0, 0); PG8_STAGE(PG8_SA(1, 1), a1 + hstep, voffA);
            if (post_epi) asm volatile("s_waitcnt vmcnt(%0)" :: "n"(8 + Epi::SMIN) : "memory"); else PG8_WAIT_V(8);
            PG8_WAIT_L(0); PG8_BAR; PG8_MMA(0, 0, At, B0); PG8_MMA(0, 1, At, B1); PG8_BAR; PG8_SCHED;
            PG8_LDA(At, 0, 1); PG8_STAGE(PG8_SB(0, 0), b2, voffB); PG8_STAGE(PG8_SB(0, 1), b2 + hstep, voffB); PG8_STAGE(PG8_SA(0, 0), a2, voffA);
            if (post_epi) asm volatile("s_waitcnt vmcnt(%0)" :: "n"(8 + Epi::SMIN) : "memory"); else PG8_WAIT_V(8);
            PG8_WAIT_L(0); PG8_BAR; PG8_MMA(1, 0, At, B0); PG8_MMA(1, 1, At, B1); PG8_BAR; PG8_SCHED;
            PG8_LDB(B0, 1, 0); PG8_LDB(B1, 1, 1); PG8_SCHED; PG8_LDA(At, 1, 0); PG8_STAGE(PG8_SA(0, 1), a2 + hstep, voffA);
            PG8_WAIT_V(8); PG8_WAIT_L(0); PG8_BAR; PG8_MMA(0, 0, At, B0); PG8_MMA(0, 1, At, B1); PG8_BAR; PG8_SCHED;
            PG8_LDA(At, 1, 1); PG8_STAGE(PG8_SB(1, 0), b3, voffB); PG8_STAGE(PG8_SB(1, 1), b3 + hstep, voffB); PG8_STAGE(PG8_SA(1, 0), a3, voffA);
            PG8_WAIT_V(8); PG8_WAIT_L(0); PG8_BAR; PG8_MMA(1, 0, At, B0); PG8_MMA(1, 1, At, B1); PG8_BAR; PG8_SCHED;
            } else {
            PG8_LDB(B0, 0, 0); PG8_SCHED; PG8_LDA(At, 0, 0); PG8_STAGE(PG8_SA(1, 1), a1 + hstep, voffA);
            PG8_WAIT_L(8); PG8_BAR; PG8_WAIT_L(0); PG8_MMA(0, 0, At, B0); PG8_BAR; PG8_SCHED;
            PG8_LDB(B1, 0, 1); PG8_STAGE(PG8_SB(0, 0), b2, voffB);
            PG8_BAR; PG8_WAIT_L(0); PG8_MMA(0, 1, At, B1); PG8_BAR;
            PG8_LDA(At, 0, 1); PG8_STAGE(PG8_SA(0, 0), a2, voffA);
            PG8_BAR; PG8_WAIT_L(0); PG8_MMA(1, 0, At, B0); PG8_BAR; PG8_SCHED;
            PG8_STAGE(PG8_SB(0, 1), b2 + hstep, voffB);
            PG8_WAIT_V(6); PG8_BAR; PG8_MMA(1, 1, At, B1); PG8_BAR;
            PG8_LDB(B0, 1, 0); PG8_SCHED; PG8_LDA(At, 1, 0); PG8_STAGE(PG8_SA(0, 1), a2 + hstep, voffA);
            PG8_WAIT_L(8); PG8_BAR; PG8_WAIT_L(0); PG8_MMA(0, 0, At, B0); PG8_BAR; PG8_SCHED;
            PG8_LDB(B1, 1, 1); PG8_STAGE(PG8_SB(1, 0), b3, voffB);
            PG8_BAR; PG8_WAIT_L(0); PG8_MMA(0, 1, At, B1); PG8_BAR;
            PG8_LDA(At, 1, 1); PG8_STAGE(PG8_SA(1, 0), a3, voffA);
            PG8_BAR; PG8_WAIT_L(0); PG8_MMA(1, 0, At, B0); PG8_BAR; PG8_SCHED;
            PG8_STAGE(PG8_SB(1, 1), b3 + hstep, voffB);
            PG8_WAIT_V(6); PG8_BAR; PG8_MMA(1, 1, At, B1); PG8_BAR;
            }
        }
        if constexpr (ALIGN_EPI) { if (wr == 0) PG8_BAR; }
        if constexpr (!Epi::AFTER_DRAIN) { const int te_ = opaque_tid(wave_); const int fr_ = te_ & 15, fq_ = (te_ >> 4) & 3;
            E(acc, cur, wr, wc, fr_, fq_); S.done(cur); }
        if (!has_next) break;
#pragma unroll
        for (int a = 0; a < 2; ++a)
#pragma unroll
            for (int b = 0; b < 2; ++b)
#pragma unroll
                for (int m = 0; m < 4; ++m)
#pragma unroll
                    for (int n = 0; n < 2; ++n) acc[a][b][m][n] = (f32x4){0.f, 0.f, 0.f, 0.f};
        cur = nxt; cA = nA; cB = nB; ++ui;
        if constexpr (ALIGN_EPI) { if (wr == 1) PG8_BAR; }
    }
    PG8_WAIT_V(0);
    if constexpr (!ALIGN_EPI) { if (wr == 0) PG8_BAR; }
    PG8_BAR;
    if constexpr (Epi::AFTER_DRAIN) { E.fused(acc, cur, wr, wc, fr, fq, lds, wid, lane); S.done(cur); }
#undef PG8_SA
#undef PG8_SB
#undef PG8_STAGE
#undef PG8_LDA
#undef PG8_LDB
#undef PG8_MMA
#undef PG8_WAIT_V
#undef PG8_WAIT_L
#undef PG8_BAR
#undef PG8_SCHED
}
}
namespace att {
using bf16 = unsigned short;
using bf16x8 = __attribute__((ext_vector_type(8))) short;
using s16x4  = __attribute__((ext_vector_type(4))) short;
using f32x16 = __attribute__((ext_vector_type(16))) float;
using u32x4  = __attribute__((ext_vector_type(4))) unsigned;
#define ATT_LAS __attribute__((address_space(3)))
#ifndef ATT_PRIO
#define ATT_PRIO 0
#endif
constexpr int D = 128, NW = 8, QBLK = 32, KVBLK = 64;
constexpr float THR = 8.f;
constexpr int SHM_V = KVBLK * D * 2, SHM_K = KVBLK * D * 2, SHM_R = KVBLK * 64 * 2;
constexpr int SHM_ATTN = 3 * (SHM_K + SHM_V + SHM_R) + NW * 64 * 4;
#define KSWZ(row, colB) ((row) * 256 + ((colB) ^ (((row) & 15) << 4)))
#define RSWZ(row, colB) ((row) * 128 + ((colB) ^ ((((row) >> 1) & 7) << 4)))
#define SBAR() __builtin_amdgcn_sched_barrier(0)
__device__ __forceinline__ int crow(int r, int hi) { return (r & 3) + 8 * (r >> 2) + 4 * hi; }
__device__ __forceinline__ unsigned cvtpk(float lo, float hi) { unsigned r; asm volatile("v_cvt_pk_bf16_f32 %0, %1, %2" : "=v"(r) : "v"(lo), "v"(hi)); return r; }

template <int NRB> struct Sc { static constexpr float SCALE = NRB ? 0.07216878364870322f : 0.08838834764831845f; };

template <int NRB> __device__ __forceinline__ void partialSM(f32x16& p0, f32x16& p1, float& m_reg, float& mn, float& alpha) {
  constexpr float SCALE = Sc<NRB>::SCALE, C = SCALE * 1.4426950408889634f;
  float pmax = p0[0];
#pragma unroll
  for (int r = 1; r < 16; ++r) pmax = fmaxf(pmax, p0[r]);
#pragma unroll
  for (int r = 0; r < 16; ++r) pmax = fmaxf(pmax, p1[r]);
  { auto rr = __builtin_amdgcn_permlane32_swap(__float_as_uint(pmax), __float_as_uint(pmax), false, false);
    pmax = fmaxf(__uint_as_float(rr[0]), __uint_as_float(rr[1])); }
  if (__builtin_expect(__all(pmax - m_reg <= THR / SCALE), 1)) { mn = m_reg; alpha = 1.f; }
  else { mn = fmaxf(m_reg, pmax); alpha = __builtin_amdgcn_exp2f((m_reg - mn) * C); m_reg = mn; }
  const float mnC = -mn * C;
#pragma unroll
  for (int r = 0; r < 16; ++r) p0[r] = fmaf(p0[r], C, mnC);
#pragma unroll
  for (int r = 0; r < 16; ++r) p1[r] = fmaf(p1[r], C, mnC);
#pragma unroll
  for (int r = 0; r < 16; ++r) p0[r] = __builtin_amdgcn_exp2f(p0[r]);
}
__device__ __forceinline__ void finishSM(f32x16& p0, f32x16& p1, float alpha, float& l_reg, bf16x8& pa0, bf16x8& pa1, bf16x8& pa2, bf16x8& pa3) {
#pragma unroll
  for (int r = 0; r < 16; ++r) p1[r] = __builtin_amdgcn_exp2f(p1[r]);
  float ps = 0;
#pragma unroll
  for (int r = 0; r < 16; ++r) ps += p0[r];
#pragma unroll
  for (int r = 0; r < 16; ++r) ps += p1[r];
  { auto rr = __builtin_amdgcn_permlane32_swap(__float_as_uint(ps), __float_as_uint(ps), false, false);
    ps = __uint_as_float(rr[0]) + __uint_as_float(rr[1]); }
  l_reg = l_reg * alpha + ps;
#define PK4(P, BASE, OUT) do { unsigned a0 = cvtpk(P[BASE + 0], P[BASE + 1]), a1 = cvtpk(P[BASE + 2], P[BASE + 3]);   \
    unsigned b0 = cvtpk(P[BASE + 4], P[BASE + 5]), b1 = cvtpk(P[BASE + 6], P[BASE + 7]);                              \
    auto r0 = __builtin_amdgcn_permlane32_swap(a0, b0, false, false); auto r1 = __builtin_amdgcn_permlane32_swap(a1, b1, false, false); \
    u32x4 w = {r0[0], r1[0], r0[1], r1[1]}; OUT = *reinterpret_cast<bf16x8*>(&w); } while (0)
  PK4(p0, 0, pa0); PK4(p0, 8, pa1); PK4(p1, 0, pa2); PK4(p1, 8, pa3);
#undef PK4
}
template <int NRB> __device__ __forceinline__ void qkt(f32x16& p0, f32x16& p1, const ATT_LAS char* Ks, const ATT_LAS char* Rs, const bf16x8* qr, int r32, int hi) {
  asm volatile("" : "+v"(r32));
  p0 = f32x16{}; p1 = f32x16{};
#pragma unroll
  for (int d0 = 0; d0 < 8; ++d0) { const int cb = (d0 * 16 + hi * 8) * 2;
    const bf16x8 b0 = *reinterpret_cast<const ATT_LAS bf16x8*>(Ks + KSWZ(r32, cb));
    const bf16x8 b1 = *reinterpret_cast<const ATT_LAS bf16x8*>(Ks + KSWZ(32 + r32, cb));
    p0 = __builtin_amdgcn_mfma_f32_32x32x16_bf16(b0, qr[d0], p0, 0, 0, 0);
    p1 = __builtin_amdgcn_mfma_f32_32x32x16_bf16(b1, qr[d0], p1, 0, 0, 0); }
#pragma unroll
  for (int d0 = 0; d0 < NRB; ++d0) { const int cb = (d0 * 16 + hi * 8) * 2;
    const bf16x8 b0 = *reinterpret_cast<const ATT_LAS bf16x8*>(Rs + RSWZ(r32, cb));
    const bf16x8 b1 = *reinterpret_cast<const ATT_LAS bf16x8*>(Rs + RSWZ(32 + r32, cb));
    p0 = __builtin_amdgcn_mfma_f32_32x32x16_bf16(b0, qr[8 + d0], p0, 0, 0, 0);
    p1 = __builtin_amdgcn_mfma_f32_32x32x16_bf16(b1, qr[8 + d0], p1, 0, 0, 0); }
}
__device__ __forceinline__ void wmask(f32x16& p0, f32x16& p1, int j, int qrel, int hi) {
  const int base = 64 * j + 4 * hi - qrel + 128;
#pragma unroll
  for (int r = 0; r < 16; ++r) { const int d = base + (r & 3) + 8 * (r >> 2);
    if ((unsigned)d > 256u) p0[r] = -1e30f;
    if ((unsigned)(d + 32) > 256u) p1[r] = -1e30f; }
}
__device__ __forceinline__ int v_st(int k, int c) { const int kk = (k & ~0xC) | ((k & 4) << 1) | ((k & 8) >> 1); return ((kk >> 3) * 4 + (c >> 5)) * 512 + ((kk & 7) * 32 + (c & 31)) * 2; }
__device__ __forceinline__ int v_rd_base(int lane) { return ((lane & 3) << 3) | (((lane >> 2) & 3) << 6) | (((lane >> 4) & 1) << 5) | (((lane >> 5) & 1) << 8); }
constexpr int v_rd_off(int d0, int ks, int half) { return d0 * 512 + ks * 4096 + half * 2048; }
template <int OFF> __device__ __forceinline__ s16x4 tr_read(int vb) {
  s16x4 r; asm volatile("ds_read_b64_tr_b16 %0, %1 offset:%2" : "=&v"(r) : "v"(vb), "i"(OFF) : "memory"); return r;
}
template <int D0> __device__ __forceinline__ void pv_one(f32x16& od, int vb, bf16x8 pa0, bf16x8 pa1, bf16x8 pa2, bf16x8 pa3) {
  const s16x4 l0 = tr_read<v_rd_off(D0, 0, 0)>(vb), h0 = tr_read<v_rd_off(D0, 0, 1)>(vb), l1 = tr_read<v_rd_off(D0, 1, 0)>(vb), h1 = tr_read<v_rd_off(D0, 1, 1)>(vb);
  const s16x4 l2 = tr_read<v_rd_off(D0, 2, 0)>(vb), h2 = tr_read<v_rd_off(D0, 2, 1)>(vb), l3 = tr_read<v_rd_off(D0, 3, 0)>(vb), h3 = tr_read<v_rd_off(D0, 3, 1)>(vb);
  asm volatile("s_waitcnt lgkmcnt(0)" ::: "memory"); SBAR();
#define PK(L, H) (bf16x8){L[0], L[1], L[2], L[3], H[0], H[1], H[2], H[3]}
  od = __builtin_amdgcn_mfma_f32_32x32x16_bf16(pa0, PK(l0, h0), od, 0, 0, 0);
  od = __builtin_amdgcn_mfma_f32_32x32x16_bf16(pa1, PK(l1, h1), od, 0, 0, 0);
  od = __builtin_amdgcn_mfma_f32_32x32x16_bf16(pa2, PK(l2, h2), od, 0, 0, 0);
  od = __builtin_amdgcn_mfma_f32_32x32x16_bf16(pa3, PK(l3, h3), od, 0, 0, 0);
#undef PK
}
__device__ __forceinline__ void pv_d0(f32x16* o, int vb, bf16x8 pa0, bf16x8 pa1, bf16x8 pa2, bf16x8 pa3) {
  pv_one<0>(o[0], vb, pa0, pa1, pa2, pa3); pv_one<1>(o[1], vb, pa0, pa1, pa2, pa3); pv_one<2>(o[2], vb, pa0, pa1, pa2, pa3); pv_one<3>(o[3], vb, pa0, pa1, pa2, pa3);
}

template <int NRB, int MODE> __device__ __forceinline__ void seg1_fused(f32x16& c0, f32x16& c1, const ATT_LAS char* Ks, const ATT_LAS char* Rs, const bf16x8* qr, int r32, int hi,
                                                              f32x16& p0, f32x16& p1, float alP, float& l_reg, bf16x8& pa0, bf16x8& pa1, bf16x8& pa2, bf16x8& pa3) {
  constexpr int DB = 8 + NRB;
  asm volatile("" : "+v"(r32));
  c0 = f32x16{}; c1 = f32x16{};
  float ps0 = 0.f, ps1 = 0.f;
#define KADDR(d0, half) ((d0) < 8 ? (Ks + KSWZ((half) * 32 + r32, ((d0) * 16 + hi * 8) * 2)) : (Rs + RSWZ((half) * 32 + r32, (((d0) - 8) * 16 + hi * 8) * 2)))
#define PK4(P, BASE, OUT) do { unsigned a0_ = cvtpk(P[BASE + 0], P[BASE + 1]), a1_ = cvtpk(P[BASE + 2], P[BASE + 3]);   \
    unsigned b0_ = cvtpk(P[BASE + 4], P[BASE + 5]), b1_ = cvtpk(P[BASE + 6], P[BASE + 7]);                              \
    auto r0_ = __builtin_amdgcn_permlane32_swap(a0_, b0_, false, false); auto r1_ = __builtin_amdgcn_permlane32_swap(a1_, b1_, false, false); \
    u32x4 w_ = {r0_[0], r1_[0], r0_[1], r1_[1]}; OUT = *reinterpret_cast<bf16x8*>(&w_); } while (0)
#define EX2(i) do { p1[i] = __builtin_amdgcn_exp2f(p1[i]); p1[(i) + 1] = __builtin_amdgcn_exp2f(p1[(i) + 1]); } while (0)
#define SUM4(acc_, P, i) do { acc_ += (P[i] + P[(i) + 1]) + (P[(i) + 2] + P[(i) + 3]); } while (0)
  bf16x8 kf[2][2];
  kf[0][0] = *reinterpret_cast<const ATT_LAS bf16x8*>(KADDR(0, 0)); kf[0][1] = *reinterpret_cast<const ATT_LAS bf16x8*>(KADDR(0, 1));
#pragma unroll
  for (int d0 = 0; d0 < DB; ++d0) {
    if (MODE != 2) if (d0 + 1 < DB) { kf[(d0 + 1) & 1][0] = *reinterpret_cast<const ATT_LAS bf16x8*>(KADDR(d0 + 1, 0)); kf[(d0 + 1) & 1][1] = *reinterpret_cast<const ATT_LAS bf16x8*>(KADDR(d0 + 1, 1)); }
    if (MODE != 3) { c0 = __builtin_amdgcn_mfma_f32_32x32x16_bf16(kf[MODE == 2 ? 0 : (d0 & 1)][0], qr[d0], c0, 0, 0, 0);
    c1 = __builtin_amdgcn_mfma_f32_32x32x16_bf16(kf[MODE == 2 ? 0 : (d0 & 1)][1], qr[d0], c1, 0, 0, 0); }
    else { asm volatile("" :: "v"(kf[d0 & 1][0]), "v"(kf[d0 & 1][1])); }
    if (MODE != 1) {
    if (d0 == 0) { EX2(0); SUM4(ps0, p0, 0); }
    if (d0 == 1) { EX2(2); SUM4(ps0, p0, 4); PK4(p0, 0, pa0); }
    if (d0 == 2) { EX2(4); SUM4(ps0, p0, 8); }
    if (d0 == 3) { EX2(6); SUM4(ps0, p0, 12); PK4(p0, 8, pa1); }
    if (d0 == 4) { EX2(8); SUM4(ps1, p1, 0); }
    if (d0 == 5) { EX2(10); SUM4(ps1, p1, 4); PK4(p1, 0, pa2); }
    if (d0 == 6) { EX2(12); SUM4(ps1, p1, 8); }
    if (d0 == 7) { EX2(14); SUM4(ps1, p1, 12); }
    if (d0 == (DB > 8 ? 8 : 7)) { PK4(p1, 8, pa3); float ps = ps0 + ps1;
      { auto rr = __builtin_amdgcn_permlane32_swap(__float_as_uint(ps), __float_as_uint(ps), false, false); ps = __uint_as_float(rr[0]) + __uint_as_float(rr[1]); }
      l_reg = l_reg * alP + ps; }
    }
    SBAR();
  }
#undef KADDR
#undef PK4
#undef EX2
#undef SUM4
}
template <int NRB, int MODE> __device__ __forceinline__ void seg2_fused(f32x16* o, int vb, bf16x8 pa0, bf16x8 pa1, bf16x8 pa2, bf16x8 pa3,
                                                              f32x16& c0, f32x16& c1, float& m_reg, float& alpha) {
  constexpr float SCALE = Sc<NRB>::SCALE, C = SCALE * 1.4426950408889634f;
  s16x4 vl[4], vh[4];
#define VRD(D0) do { vl[0] = tr_read<v_rd_off(D0, 0, 0)>(vb); vh[0] = tr_read<v_rd_off(D0, 0, 1)>(vb); vl[1] = tr_read<v_rd_off(D0, 1, 0)>(vb); vh[1] = tr_read<v_rd_off(D0, 1, 1)>(vb); \
    vl[2] = tr_read<v_rd_off(D0, 2, 0)>(vb); vh[2] = tr_read<v_rd_off(D0, 2, 1)>(vb); vl[3] = tr_read<v_rd_off(D0, 3, 0)>(vb); vh[3] = tr_read<v_rd_off(D0, 3, 1)>(vb); } while (0)
#define PKV(k) (bf16x8){vl[k][0], vl[k][1], vl[k][2], vl[k][3], vh[k][0], vh[k][1], vh[k][2], vh[k][3]}
#define MX4(x, P, i) do { x = fmaxf(fmaxf(x, P[i]), fmaxf(P[(i) + 1], fmaxf(P[(i) + 2], P[(i) + 3]))); } while (0)
#define VWAIT() do { asm volatile("s_waitcnt lgkmcnt(0)" ::: "memory"); SBAR(); } while (0)
  float mxa = c0[0], mxb = c1[0], mnC = 0.f;
  if (MODE != 2) VRD(0); VWAIT();
  if (MODE != 3) { o[0] = __builtin_amdgcn_mfma_f32_32x32x16_bf16(pa0, PKV(0), o[0], 0, 0, 0); } if (MODE != 1) { MX4(mxa, c0, 0); } if (MODE != 1) { MX4(mxb, c1, 0); } SBAR();
  if (MODE != 3) { o[0] = __builtin_amdgcn_mfma_f32_32x32x16_bf16(pa1, PKV(1), o[0], 0, 0, 0); } if (MODE != 1) { MX4(mxa, c0, 4); } if (MODE != 1) { MX4(mxb, c1, 4); } SBAR();
  if (MODE != 3) { o[0] = __builtin_amdgcn_mfma_f32_32x32x16_bf16(pa2, PKV(2), o[0], 0, 0, 0); } if (MODE != 1) { MX4(mxa, c0, 8); } if (MODE != 1) { MX4(mxb, c1, 8); } SBAR();
  if (MODE != 3) { o[0] = __builtin_amdgcn_mfma_f32_32x32x16_bf16(pa3, PKV(3), o[0], 0, 0, 0); } SBAR();
  if (MODE != 2) VRD(1); if (MODE != 1) { MX4(mxa, c0, 12); } if (MODE != 1) { MX4(mxb, c1, 12); }
  if (MODE == 1) { alpha = 1.f; } else { float pmax = fmaxf(mxa, mxb); auto rr = __builtin_amdgcn_permlane32_swap(__float_as_uint(pmax), __float_as_uint(pmax), false, false);
    pmax = fmaxf(__uint_as_float(rr[0]), __uint_as_float(rr[1]));
    const bool anyx = __any(pmax - m_reg > THR / SCALE);
    const float mn = anyx ? fmaxf(m_reg, pmax) : m_reg; alpha = __builtin_amdgcn_exp2f((m_reg - mn) * C); m_reg = mn; mnC = -mn * C; }
  VWAIT();
  if (MODE != 3) { o[1] = __builtin_amdgcn_mfma_f32_32x32x16_bf16(pa0, PKV(0), o[1], 0, 0, 0); }
  if (MODE != 1) { _Pragma("unroll") for (int r = 0; r < 8; ++r) c0[r] = fmaf(c0[r], C, mnC); }
  SBAR();
  if (MODE != 3) { o[1] = __builtin_amdgcn_mfma_f32_32x32x16_bf16(pa1, PKV(1), o[1], 0, 0, 0); }
  if (MODE != 1) { _Pragma("unroll") for (int r = 8; r < 16; ++r) c0[r] = fmaf(c0[r], C, mnC); }
  SBAR();
  if (MODE != 3) { o[1] = __builtin_amdgcn_mfma_f32_32x32x16_bf16(pa2, PKV(2), o[1], 0, 0, 0); }
  if (MODE != 1) { _Pragma("unroll") for (int r = 0; r < 8; ++r) c1[r] = fmaf(c1[r], C, mnC); }
  SBAR();
  if (MODE != 3) { o[1] = __builtin_amdgcn_mfma_f32_32x32x16_bf16(pa3, PKV(3), o[1], 0, 0, 0); } SBAR();
  if (MODE != 2) VRD(2);
  if (MODE != 1) { _Pragma("unroll") for (int r = 8; r < 16; ++r) c1[r] = fmaf(c1[r], C, mnC); }
  VWAIT();
  if (MODE != 3) { o[2] = __builtin_amdgcn_mfma_f32_32x32x16_bf16(pa0, PKV(0), o[2], 0, 0, 0); }
  if (MODE != 1) { _Pragma("unroll") for (int r = 0; r < 2; ++r) c0[r] = __builtin_amdgcn_exp2f(c0[r]); }
  SBAR();
  if (MODE != 3) { o[2] = __builtin_amdgcn_mfma_f32_32x32x16_bf16(pa1, PKV(1), o[2], 0, 0, 0); }
  if (MODE != 1) { _Pragma("unroll") for (int r = 2; r < 4; ++r) c0[r] = __builtin_amdgcn_exp2f(c0[r]); }
  SBAR();
  if (MODE != 3) { o[2] = __builtin_amdgcn_mfma_f32_32x32x16_bf16(pa2, PKV(2), o[2], 0, 0, 0); }
  if (MODE != 1) { _Pragma("unroll") for (int r = 4; r < 6; ++r) c0[r] = __builtin_amdgcn_exp2f(c0[r]); }
  SBAR();
  if (MODE != 3) { o[2] = __builtin_amdgcn_mfma_f32_32x32x16_bf16(pa3, PKV(3), o[2], 0, 0, 0); } SBAR();
  if (MODE != 2) VRD(3);
  if (MODE != 1) { _Pragma("unroll") for (int r = 6; r < 9; ++r) c0[r] = __builtin_amdgcn_exp2f(c0[r]); }
  VWAIT();
  if (MODE != 3) { o[3] = __builtin_amdgcn_mfma_f32_32x32x16_bf16(pa0, PKV(0), o[3], 0, 0, 0); }
  if (MODE != 1) { _Pragma("unroll") for (int r = 9; r < 11; ++r) c0[r] = __builtin_amdgcn_exp2f(c0[r]); }
  SBAR();
  if (MODE != 3) { o[3] = __builtin_amdgcn_mfma_f32_32x32x16_bf16(pa1, PKV(1), o[3], 0, 0, 0); }
  if (MODE != 1) { _Pragma("unroll") for (int r = 11; r < 13; ++r) c0[r] = __builtin_amdgcn_exp2f(c0[r]); }
  SBAR();
  if (MODE != 3) { o[3] = __builtin_amdgcn_mfma_f32_32x32x16_bf16(pa2, PKV(2), o[3], 0, 0, 0); }
  if (MODE != 1) { _Pragma("unroll") for (int r = 13; r < 15; ++r) c0[r] = __builtin_amdgcn_exp2f(c0[r]); }
  SBAR();
  if (MODE != 3) { o[3] = __builtin_amdgcn_mfma_f32_32x32x16_bf16(pa3, PKV(3), o[3], 0, 0, 0); }
  if (MODE != 1) c0[15] = __builtin_amdgcn_exp2f(c0[15]);
  SBAR();
#undef VWAIT
#undef VRD
#undef PKV
#undef MX4
}

__device__ __forceinline__ float g_add(float a, float b) { float r; asm("v_add_f32_e32 %0, %1, %2" : "=v"(r) : "v"(a), "v"(b)); return r; }
__device__ __forceinline__ float g_fma(float a, float b, float c) { float r; asm("v_fma_f32 %0, %1, %2, %3" : "=v"(r) : "v"(a), "v"(b), "v"(c)); return r; }
__device__ __forceinline__ float g_max3(float a, float b, float c) { float r; asm("v_max3_f32 %0, %1, %2, %3" : "=v"(r) : "v"(a), "v"(b), "v"(c)); return r; }
__device__ __forceinline__ float g_exp2(float a) { float r; asm("v_exp_f32_e32 %0, %1" : "=v"(r) : "v"(a)); return r; }
__device__ __forceinline__ unsigned g_cvtpk(float lo, float hi) { unsigned r; asm("v_cvt_pk_bf16_f32 %0, %1, %2" : "=v"(r) : "v"(lo), "v"(hi)); return r; }
template <int NRB, int MODE> __device__ __forceinline__ void seg1_gap(f32x16& c0, f32x16& c1, const ATT_LAS char* Ks, const ATT_LAS char* Rs, const bf16x8* qr, int r32, int hi,
                                                            f32x16& p0, f32x16& p1, float alP, float& l_reg, bf16x8& pa0, bf16x8& pa1, bf16x8& pa2, bf16x8& pa3) {
  constexpr bool DOE = (MODE == 0 || MODE == 4 || MODE == 9), DOS = (MODE == 0 || MODE == 5 || MODE == 7 || MODE == 9);
  constexpr int DB = 8 + NRB, NG = 2 * DB;
  static_assert(NG >= 24, "the filler schedule below needs 24 gaps");
  asm volatile("" : "+v"(r32));
  c0 = f32x16{}; c1 = f32x16{};
  float s0 = 0.f, s1 = 0.f; unsigned cv[8], cw[8]; u32x4 wa = {0u, 0u, 0u, 0u}, wb = {0u, 0u, 0u, 0u}, wc = {0u, 0u, 0u, 0u}, wd = {0u, 0u, 0u, 0u};
#define KADDR(d0, half) ((d0) < 8 ? (Ks + KSWZ((half) * 32 + r32, ((d0) * 16 + hi * 8) * 2)) : (Rs + RSWZ((half) * 32 + r32, (((d0) - 8) * 16 + hi * 8) * 2)))
#define FILL(i) do { \
    if (DOE && (i) < 16) p1[(i) < 16 ? (i) : 0] = g_exp2(p1[(i) < 16 ? (i) : 0]); \
    if (DOS) { \
    if ((i) < 8) { s0 = g_add(s0, p0[2 * ((i) & 7)]); s1 = g_add(s1, p0[2 * ((i) & 7) + 1]); cv[(i) & 7] = g_cvtpk(p0[2 * ((i) & 7)], p0[2 * ((i) & 7) + 1]); } \
    if ((i) >= 8) { if ((i) & 1) s1 = g_add(s1, p1[((i) - 8) & 15]); else s0 = g_add(s0, p1[((i) - 8) & 15]); } \
    if ((i) == 8)  { auto r_ = __builtin_amdgcn_permlane32_swap(cv[0], cv[2], false, false); wa.x = r_[0]; wa.z = r_[1]; } \
    if ((i) == 9)  { auto r_ = __builtin_amdgcn_permlane32_swap(cv[1], cv[3], false, false); wa.y = r_[0]; wa.w = r_[1]; } \
    if ((i) == 10) { auto r_ = __builtin_amdgcn_permlane32_swap(cv[4], cv[6], false, false); wb.x = r_[0]; wb.z = r_[1]; } \
    if ((i) == 11) { auto r_ = __builtin_amdgcn_permlane32_swap(cv[5], cv[7], false, false); wb.y = r_[0]; wb.w = r_[1]; } \
    if ((i) >= 12 && (i) < 20) cw[((i) - 12) & 7] = g_cvtpk(p1[2 * (((i) - 12) & 7)], p1[2 * (((i) - 12) & 7) + 1]); \
    if ((i) == 20) { auto r_ = __builtin_amdgcn_permlane32_swap(cw[0], cw[2], false, false); wc.x = r_[0]; wc.z = r_[1]; } \
    if ((i) == 21) { auto r_ = __builtin_amdgcn_permlane32_swap(cw[1], cw[3], false, false); wc.y = r_[0]; wc.w = r_[1]; } \
    if ((i) == 22) { auto r_ = __builtin_amdgcn_permlane32_swap(cw[4], cw[6], false, false); wd.x = r_[0]; wd.z = r_[1]; } \
    if ((i) == 23) { auto r_ = __builtin_amdgcn_permlane32_swap(cw[5], cw[7], false, false); wd.y = r_[0]; wd.w = r_[1]; } \
    } \
  } while (0)
  bf16x8 kf[3][2];
  kf[0][0] = *reinterpret_cast<const ATT_LAS bf16x8*>(KADDR(0, 0)); kf[0][1] = *reinterpret_cast<const ATT_LAS bf16x8*>(KADDR(0, 1));
  kf[1][0] = *reinterpret_cast<const ATT_LAS bf16x8*>(KADDR(1, 0)); kf[1][1] = *reinterpret_cast<const ATT_LAS bf16x8*>(KADDR(1, 1));
  kf[2][0] = kf[0][0]; kf[2][1] = kf[0][1];
#pragma unroll
  for (int d0 = 0; d0 < DB; ++d0) {
    if (MODE != 2) if (d0 + 2 < DB) { kf[(d0 + 2) % 3][0] = *reinterpret_cast<const ATT_LAS bf16x8*>(KADDR(d0 + 2, 0)); kf[(d0 + 2) % 3][1] = *reinterpret_cast<const ATT_LAS bf16x8*>(KADDR(d0 + 2, 1)); }
    if (ATT_PRIO) __builtin_amdgcn_s_setprio(1);
    c0 = __builtin_amdgcn_mfma_f32_32x32x16_bf16(kf[d0 % 3][0], qr[d0], c0, 0, 0, 0);
    if (ATT_PRIO) __builtin_amdgcn_s_setprio(0);
    if (2 * d0 < 24) FILL(2 * d0);
    SBAR();
    if (ATT_PRIO) __builtin_amdgcn_s_setprio(1);
    c1 = __builtin_amdgcn_mfma_f32_32x32x16_bf16(kf[d0 % 3][1], qr[d0], c1, 0, 0, 0);
    if (ATT_PRIO) __builtin_amdgcn_s_setprio(0);
    if (2 * d0 + 1 < 24) FILL(2 * d0 + 1);
    SBAR();
  }
  { float ps = g_add(s0, s1); auto rr = __builtin_amdgcn_permlane32_swap(__float_as_uint(ps), __float_as_uint(ps), false, false); ps = __uint_as_float(rr[0]) + __uint_as_float(rr[1]);
    l_reg = l_reg * alP + ps; }
  pa0 = *reinterpret_cast<bf16x8*>(&wa); pa1 = *reinterpret_cast<bf16x8*>(&wb); pa2 = *reinterpret_cast<bf16x8*>(&wc); pa3 = *reinterpret_cast<bf16x8*>(&wd);
#undef KADDR
#undef FILL
}
template <int NRB, int MODE> __device__ __forceinline__ void seg2_gap(f32x16* o, int vb, bf16x8 pa0, bf16x8 pa1, bf16x8 pa2, bf16x8 pa3,
                                                            f32x16& c0, f32x16& c1, float& m_reg, float& alpha) {
  constexpr bool DOE = (MODE == 0 || MODE == 4 || MODE == 9), DOS = (MODE == 0 || MODE == 5 || MODE == 8 || MODE == 9);
  constexpr float SCALE = Sc<NRB>::SCALE, C = SCALE * 1.4426950408889634f, THRL = THR * 1.4426950408889634f;
  s16x4 vl[2][4], vh[2][4];
#define VRD(buf, D0) do { vl[buf][0] = tr_read<v_rd_off(D0, 0, 0)>(vb); vh[buf][0] = tr_read<v_rd_off(D0, 0, 1)>(vb); vl[buf][1] = tr_read<v_rd_off(D0, 1, 0)>(vb); vh[buf][1] = tr_read<v_rd_off(D0, 1, 1)>(vb); \
    vl[buf][2] = tr_read<v_rd_off(D0, 2, 0)>(vb); vh[buf][2] = tr_read<v_rd_off(D0, 2, 1)>(vb); vl[buf][3] = tr_read<v_rd_off(D0, 3, 0)>(vb); vh[buf][3] = tr_read<v_rd_off(D0, 3, 1)>(vb); } while (0)
#define PKV(buf, k) (bf16x8){vl[buf][k][0], vl[buf][k][1], vl[buf][k][2], vl[buf][k][3], vh[buf][k][0], vh[buf][k][1], vh[buf][k][2], vh[buf][k][3]}
#define VWAIT8() do { asm volatile("s_waitcnt lgkmcnt(8)" ::: "memory"); SBAR(); } while (0)
#define VWAIT0() do { asm volatile("s_waitcnt lgkmcnt(0)" ::: "memory"); SBAR(); } while (0)
#define XFORM4(V, b) do { V[b] = g_fma(V[b], C, mnC); V[(b) + 1] = g_fma(V[(b) + 1], C, mnC); V[(b) + 2] = g_fma(V[(b) + 2], C, mnC); V[(b) + 3] = g_fma(V[(b) + 3], C, mnC); \
    ma = g_max3(ma, V[b], V[(b) + 1]); mb = g_max3(mb, V[(b) + 2], V[(b) + 3]); } while (0)
  const float mnC = -m_reg * C; float ma = -1e30f, mb = -1e30f;
  const bf16x8 pa[4] = {pa0, pa1, pa2, pa3};
  VRD(0, 0); VRD(1, 1); VWAIT8();
#pragma unroll
  for (int g = 0; g < 16; ++g) {
    if (MODE != 2) { if (g == 4) { VRD(0, 2); VWAIT8(); } if (g == 8) { VRD(1, 3); VWAIT8(); } } if (g == 12) { VWAIT0(); }
    if (ATT_PRIO) __builtin_amdgcn_s_setprio(1);
    o[g >> 2] = __builtin_amdgcn_mfma_f32_32x32x16_bf16(pa[g & 3], PKV((g >> 2) & 1, g & 3), o[g >> 2], 0, 0, 0);
    if (ATT_PRIO) __builtin_amdgcn_s_setprio(0);
    if (DOS && g < 4) XFORM4(c0, 4 * (g & 3));
    if (DOS && g >= 4 && g < 8) XFORM4(c1, 4 * (g & 3));
    if (!DOS && g == 8) alpha = 1.f;
    if (DOS && g == 8) { float pmax = fmaxf(ma, mb); auto rr = __builtin_amdgcn_permlane32_swap(__float_as_uint(pmax), __float_as_uint(pmax), false, false);
      pmax = fmaxf(__uint_as_float(rr[0]), __uint_as_float(rr[1]));
      alpha = 1.f;
      if (__builtin_expect(__any(pmax > THRL), 0)) {
        const float dl = fmaxf(pmax, 0.f); m_reg += dl * (1.0f / C); alpha = __builtin_amdgcn_exp2f(-dl);
#pragma unroll
        for (int r = 0; r < 16; ++r) { c0[r] -= dl; c1[r] -= dl; } } }
    if (DOE && g == 9)  { c0[0] = g_exp2(c0[0]); c0[1] = g_exp2(c0[1]); c0[2] = g_exp2(c0[2]); }
    if (DOE && g == 10) { c0[3] = g_exp2(c0[3]); c0[4] = g_exp2(c0[4]); c0[5] = g_exp2(c0[5]); }
    if (DOE && g >= 11) { c0[6 + 2 * ((g - 11) & 7)] = g_exp2(c0[6 + 2 * ((g - 11) & 7)]); c0[7 + 2 * ((g - 11) & 7)] = g_exp2(c0[7 + 2 * ((g - 11) & 7)]); }
    SBAR();
  }
  if (MODE != 0) asm volatile("" :: "v"(c0), "v"(c1));
#undef VRD
#undef PKV
#undef VWAIT8
#undef VWAIT0
#undef XFORM4
}

__device__ __forceinline__ void glds16(const void* sbase, unsigned voff, unsigned lds_dst) { unsigned keep;
  asm volatile("s_mov_b32 %0, m0\n\ts_mov_b32 m0, %3\n\ts_nop 0\n\tglobal_load_lds_dwordx4 %1, %2\n\ts_mov_b32 m0, %0" : "=&s"(keep) : "v"(voff), "s"(sbase), "s"(lds_dst) : "memory"); }

template <int NRB, bool WIN, int MODE = 0, bool O8 = false, bool HSPLIT = false>
__device__ __forceinline__ void attn_body(const bf16* __restrict__ Qb, int ldq, const bf16* __restrict__ Qrb, int ldqr,
                                          const bf16* __restrict__ Kh, int ldk, const bf16* __restrict__ Krh, int ldkr,
                                          const bf16* __restrict__ Vh, int ldv, bf16* __restrict__ Ob, int ldo,
                                          int NT, int qrel0, float m0, float l0, ATT_LAS char* lds, int wave_, float oscale = 1.f, float m0b = 0.f) {
  const int wrow = HSPLIT ? (wave_ & 3) : wave_, hsel = HSPLIT ? (wave_ >> 2) : 0;
  const int tid = opaque_tid(wave_), wid = wave_, lane = tid & 63, r32 = lane & 31, hi = lane >> 5;
  constexpr int SLOTK = SHM_K + SHM_R, VRING = 3 * SLOTK, OFFWS = VRING + 3 * SHM_V;
  ATT_LAS float* ws = (ATT_LAS float*)(lds + OFFWS) + wid * 64; ATT_LAS float* li_l = ws; ATT_LAS float* al_l = ws + 32;
  float m_reg = (HSPLIT && hsel) ? m0b : m0, l_reg = l0; f32x16 o[4] = {}; bf16x8 qr[8 + NRB];
  const unsigned lds0 = (unsigned)(uintptr_t)lds;
#define DMA_K(t, ks) do { const unsigned d_ = (unsigned)__builtin_amdgcn_readfirstlane((int)(lds0 + (ks) + wid * 2048)); \
    const int ln_ = lane_id(); const bf16* kt_ = Kh + (long)(t) * KVBLK * ldk; \
    _Pragma("unroll") for (int p_ = 0; p_ < 2; ++p_) { const int row_ = 4 * (2 * wid + p_) + (ln_ >> 4), cb_ = (16 * (ln_ & 15)) ^ ((row_ & 15) << 4); glds16(kt_, (unsigned)(row_ * ldk * 2 + cb_), d_ + p_ * 1024); } \
    if constexpr (NRB > 0) { const int row_ = 8 * wid + (ln_ >> 3), cb_ = (16 * (ln_ & 7)) ^ (((row_ >> 1) & 7) << 4); \
      glds16(Krh + (long)(t) * KVBLK * ldkr, (unsigned)(row_ * ldkr * 2 + cb_), (unsigned)__builtin_amdgcn_readfirstlane((int)(lds0 + (ks) + SHM_K + wid * 1024))); } } while (0)
#define DMA_V(t, vs) do { const unsigned d_ = (unsigned)__builtin_amdgcn_readfirstlane((int)(lds0 + (vs) + wid * 2048)); \
    const int ln_ = lane_id(); const bf16* vt_ = Vh + (long)(t) * KVBLK * ldv; \
    _Pragma("unroll") for (int p_ = 0; p_ < 2; ++p_) { const int c_ = 2 * wid + p_, kk_ = 8 * (c_ >> 1) + ((ln_ & 31) >> 2), key_ = (kk_ & ~0xC) | ((kk_ & 4) << 1) | ((kk_ & 8) >> 1), col_ = 32 * (2 * (c_ & 1) + (ln_ >> 5)) + 8 * (ln_ & 3); \
      glds16(vt_, (unsigned)((key_ * ldv + col_) * 2), d_ + p_ * 1024); } } while (0)
  if constexpr (WIN) { DMA_K(0, 0); DMA_V(0, VRING); DMA_K(1, SLOTK); DMA_V(1, VRING + SHM_V); }
  else { DMA_K(0, 0); DMA_K(1, SLOTK); DMA_V(0, VRING); if (2 < NT) DMA_K(2, 2 * SLOTK); DMA_V(1, VRING + SHM_V); }
  const bf16* Qw = Qb + hsel * D + (long)(wrow * QBLK + r32) * ldq + hi * 8;
#pragma unroll
  for (int d0 = 0; d0 < 8; ++d0) qr[d0] = *reinterpret_cast<const bf16x8*>(Qw + d0 * 16);
  if constexpr (NRB > 0) { const bf16* Qrw = Qrb + (long)(wid * QBLK + r32) * ldqr + hi * 8;
#pragma unroll
    for (int d0 = 0; d0 < NRB; ++d0) qr[8 + d0] = *reinterpret_cast<const bf16x8*>(Qrw + d0 * 16); }
  const int vrd = v_rd_base(lane);
  const int qrel = qrel0 + wrow * QBLK + r32;
#define WAITSYNC() do { asm volatile("s_waitcnt vmcnt(0)" ::: "memory"); __syncthreads(); } while (0)
#define RESC(a) do { if (__any((a) < 1.f)) { if (hi == 0) al_l[r32] = (a); asm volatile("s_waitcnt lgkmcnt(0)" ::: "memory"); \
    _Pragma("unroll") for (int d = 0; d < 4; ++d) _Pragma("unroll") for (int r = 0; r < 16; ++r) o[d][r] *= al_l[crow(r, hi)]; } } while (0)
  f32x16 pA0, pA1, pB0, pB1; float mnA, alA, alB; bf16x8 pa0, pa1, pa2, pa3;
  WAITSYNC();
  if constexpr (WIN) {
    const int qlo_ = qrel0 + wrow * QBLK - 128, qhi_ = qrel0 + wrow * QBLK + QBLK - 1 + 128;
    int ks = 0, vs = VRING;
    for (int t = 0; t < NT; ++t) {
      const int ks2 = ks >= SLOTK ? ks - SLOTK : ks + 2 * SLOTK, vs2 = vs >= VRING + SHM_V ? vs - SHM_V : vs + 2 * SHM_V;
      if (t + 2 < NT) { DMA_K(t + 2, ks2); DMA_V(t + 2, vs2); }
      if (64 * t + 63 >= qlo_ && 64 * t <= qhi_) {
        qkt<NRB>(pA0, pA1, lds + ks, lds + ks + SHM_K, qr, r32, hi);
        if (64 * t < qlo_ + QBLK - 1 || 64 * t + 63 > qhi_ - (QBLK - 1)) wmask(pA0, pA1, t, qrel, hi);
        partialSM<NRB>(pA0, pA1, m_reg, mnA, alA); RESC(alA);
        finishSM(pA0, pA1, alA, l_reg, pa0, pa1, pa2, pa3); SBAR();
        pv_d0(o, (int)lds0 + vs + vrd, pa0, pa1, pa2, pa3);
      }
      if (t + 2 < NT) asm volatile("s_waitcnt vmcnt(4) lgkmcnt(0)" ::: "memory"); else asm volatile("s_waitcnt vmcnt(0) lgkmcnt(0)" ::: "memory");
      __builtin_amdgcn_s_barrier(); asm volatile("" ::: "memory");
      ks = ks == 2 * SLOTK ? 0 : ks + SLOTK; vs = vs == VRING + 2 * SHM_V ? VRING : vs + SHM_V;
    }
  } else {
    constexpr int NKI = NRB > 0 ? 3 : 2;
    qkt<NRB>(pA0, pA1, lds, lds + SHM_K, qr, r32, hi); partialSM<NRB>(pA0, pA1, m_reg, mnA, alA);
    asm volatile("s_waitcnt lgkmcnt(0)" ::: "memory"); __builtin_amdgcn_s_barrier(); asm volatile("" ::: "memory");
    if (3 < NT) DMA_K(3, 0);
    if (2 < NT) DMA_V(2, VRING + 2 * SHM_V);
    int kcur = SLOTK, vprev = VRING;
#ifndef ATT_STAGGER
#define ATT_STAGGER 0
#endif
#define STEP_TAIL(alC, t) do { \
      if ((t) + 2 < NT) asm volatile("s_waitcnt vmcnt(%0) lgkmcnt(0)" :: "n"(NKI + 2) : "memory"); \
      else if ((t) + 1 < NT) asm volatile("s_waitcnt vmcnt(2) lgkmcnt(0)" ::: "memory"); \
      else asm volatile("s_waitcnt vmcnt(0) lgkmcnt(0)" ::: "memory"); \
      __builtin_amdgcn_s_barrier(); asm volatile("" ::: "memory"); \
      if (MODE != 9) { if ((t) + 3 < NT) DMA_K((t) + 3, kcur); \
      if ((t) + 2 < NT) DMA_V((t) + 2, vprev); } \
      RESC(alC); kcur = kcur == 2 * SLOTK ? 0 : kcur + SLOTK; vprev = vprev == VRING + 2 * SHM_V ? VRING : vprev + SHM_V; } while (0)
#define STEP_A(C0, C1, alC, P0, P1, alP, t) do { \
      SBAR(); seg1_gap<NRB, MODE>(C0, C1, lds + kcur, lds + kcur + SHM_K, qr, r32, hi, P0, P1, alP, l_reg, pa0, pa1, pa2, pa3); \
      SBAR(); seg2_gap<NRB, MODE>(o, (int)lds0 + vprev + vrd, pa0, pa1, pa2, pa3, C0, C1, m_reg, alC); SBAR(); \
      STEP_TAIL(alC, t); } while (0)
#define STEP_B(C0, C1, alC, P0, P1, alP, t) do { float mn_; \
      SBAR(); finishSM(P0, P1, alP, l_reg, pa0, pa1, pa2, pa3); SBAR(); \
      qkt<NRB>(C0, C1, lds + kcur, lds + kcur + SHM_K, qr, r32, hi); SBAR(); \
      partialSM<NRB>(C0, C1, m_reg, mn_, alC); SBAR(); \
      pv_d0(o, (int)lds0 + vprev + vrd, pa0, pa1, pa2, pa3); SBAR(); \
      STEP_TAIL(alC, t); } while (0)
#define TILE_LOOP(STEP) do { \
    for (int t = 1; t + 1 < NT; t += 2) { \
      STEP(pB0, pB1, alB, pA0, pA1, alA, t); \
      STEP(pA0, pA1, alA, pB0, pB1, alB, t + 1); \
    } \
    STEP(pB0, pB1, alB, pA0, pA1, alA, NT - 1); } while (0)
    if (ATT_STAGGER && wid >= 4) TILE_LOOP(STEP_B); else TILE_LOOP(STEP_A);
#undef TILE_LOOP
#undef STEP_A
#undef STEP_B
#undef STEP_TAIL
    finishSM(pB0, pB1, alB, l_reg, pa0, pa1, pa2, pa3); SBAR();
    pv_d0(o, (int)lds0 + vprev + vrd, pa0, pa1, pa2, pa3);
  }
  { const int ln_ = opaque_tid(wave_) & 63, r32e = ln_ & 31, hie = ln_ >> 5;
    if (hie == 0) li_l[r32e] = l_reg; asm volatile("s_waitcnt lgkmcnt(0)" ::: "memory");
    bf16* Ow = Ob + hsel * D + (long)(wrow * QBLK) * ldo + r32e; unsigned char* Ow8 = (unsigned char*)Ob + hsel * D + (long)(wrow * QBLK) * ldo + r32e;
#pragma unroll
    for (int r = 0; r < 16; ++r) { const int orow = crow(r, hie); const float rl = __builtin_amdgcn_rcpf(li_l[orow]) * (O8 ? oscale : 1.f);
#pragma unroll
      for (int d0 = 0; d0 < 4; ++d0) {
        if constexpr (O8) { if (d0 == 0) { int w8 = __builtin_amdgcn_cvt_pk_fp8_f32(o[0][r] * rl, o[1][r] * rl, 0, false); w8 = __builtin_amdgcn_cvt_pk_fp8_f32(o[2][r] * rl, o[3][r] * rl, w8, true);
            if (MODE == 0) *(int*)(Ow8 + (long)orow * ldo + 3 * r32e) = w8; else asm volatile("" :: "v"(w8)); } }
        else { const unsigned w = cvtpk(o[d0][r] * rl, 0.f); if (MODE == 0) Ow[(long)orow * ldo + d0 * 32] = (bf16)(w & 0xffffu); else asm volatile("" :: "v"(w)); } } } }
  __syncthreads();
#undef DMA_K
#undef DMA_V
#undef WAITSYNC
#undef RESC
}
using i32x8 = __attribute__((ext_vector_type(8))) int;
using i32x4 = __attribute__((ext_vector_type(4))) int;
constexpr int S8_KN = 8192, S8_KR = 4096, S8_SLOTK = S8_KN + S8_KR, S8_V = 8192, S8_VRING = 6 * S8_SLOTK, S8_WS = S8_VRING + 6 * S8_V, SHM_ATTN8 = S8_WS + NW * 64 * 4;
#ifndef MLA8_VSPLIT
#define MLA8_VSPLIT 1
#endif
#ifndef MLA8_THR
#define MLA8_THR 4.f
#endif
constexpr float THR8 = MLA8_THR, OFF8 = 2.f, SC8 = MLA8_PRESCALE ? 1.0f : 0.07216878364870322f * 1.4426950408889634f, THRL8 = THR8 * 1.4426950408889634f;
__device__ __forceinline__ i32x8 lds32(const ATT_LAS char* p) { const i32x4 a = *(const ATT_LAS i32x4*)p, b = *(const ATT_LAS i32x4*)(p + 16); return __builtin_shufflevector(a, b, 0, 1, 2, 3, 4, 5, 6, 7); }
__device__ __forceinline__ i32x8 lds16x2(const ATT_LAS char* p, const ATT_LAS char* q) { const i32x4 a = *(const ATT_LAS i32x4*)p, b = *(const ATT_LAS i32x4*)q; return __builtin_shufflevector(a, b, 0, 1, 2, 3, 4, 5, 6, 7); }
__device__ __forceinline__ i32x8 ldsx(const ATT_LAS char* base, int off) { return lds16x2(base + off, base + (off ^ 16)); }
__device__ __forceinline__ f32x16 mfma8(i32x8 a, i32x8 b, f32x16 c) { return __builtin_amdgcn_mfma_scale_f32_32x32x64_f8f6f4(a, b, c, 0, 0, 0, 0, 0, 0); }
__device__ __forceinline__ int pk4f8(float a, float b, float c, float d) { int w = __builtin_amdgcn_cvt_pk_fp8_f32(a, b, 0, false); return __builtin_amdgcn_cvt_pk_fp8_f32(c, d, w, true); }
__device__ __forceinline__ int pk4f8o(int prev, float a, float b, float c, float d) { int w = __builtin_amdgcn_cvt_pk_fp8_f32(a, b, prev, false); return __builtin_amdgcn_cvt_pk_fp8_f32(c, d, w, true); }

template <bool DOMMA, bool DOFILL, bool LDV>
__device__ __forceinline__ void seg1_8(f32x16& c0, f32x16& c1, const ATT_LAS char* Ks, int ra, const i32x8 (&qr)[3], i32x8& a0, i32x8& a1, i32x8& b0, i32x8& b1,
                                       f32x16& p0, f32x16& p1, float alP, float& l_reg, i32x8& pf, const ATT_LAS char* Vs, int va, i32x8& f0, i32x8& f1, i32x8& f2, i32x8& f3,
                                       const f32x16& z = f32x16{}) {
  asm volatile("" : "+v"(ra), "+v"(va));
  const ATT_LAS char* kr = Ks + S8_KN; const ATT_LAS char* v0 = Vs + va; const ATT_LAS char* v1 = Vs + (va ^ 32);
  float s0 = 0.f, s1 = 0.f;
#define E4(P, b) do { P[b] = g_exp2(P[b]); P[(b) + 1] = g_exp2(P[(b) + 1]); P[(b) + 2] = g_exp2(P[(b) + 2]); P[(b) + 3] = g_exp2(P[(b) + 3]); } while (0)
#define A4(P, b) do { s0 = g_add(s0, P[b]); s1 = g_add(s1, P[(b) + 1]); s0 = g_add(s0, P[(b) + 2]); s1 = g_add(s1, P[(b) + 3]); } while (0)
  if (DOMMA) c0 = mfma8(a0, qr[0], z);
  if (DOFILL) { pf[0] = pk4f8o(pf[0], p0[0], p0[1], p0[2], p0[3]); pf[1] = pk4f8o(pf[1], p0[4], p0[5], p0[6], p0[7]); pf[2] = pk4f8o(pf[2], p0[8], p0[9], p0[10], p0[11]); pf[3] = pk4f8o(pf[3], p0[12], p0[13], p0[14], p0[15]); A4(p0, 0); A4(p0, 4); }
  SBAR();
  if (DOMMA) { c1 = mfma8(a1, qr[0], z); a0 = ldsx(kr, ra); a1 = ldsx(kr + 2048, ra); }
  if (DOFILL) { E4(p1, 0); A4(p0, 8); A4(p0, 12); }
  SBAR();
  if (DOMMA) c0 = mfma8(b0, qr[1], c0);
  if (LDV) { f0 = lds16x2(v0, v1); f1 = lds16x2(v0 + 2048, v1 + 2048); }
  if (DOFILL) { E4(p1, 4); A4(p1, 0); }
  SBAR();
  if (DOMMA) c1 = mfma8(b1, qr[1], c1);
  if (LDV && !MLA8_VSPLIT) { f2 = lds16x2(v0 + 4096, v1 + 4096); f3 = lds16x2(v0 + 6144, v1 + 6144); }
  if (DOFILL) { E4(p1, 8); A4(p1, 4); }
  SBAR();
  if (DOMMA) c0 = mfma8(a0, qr[2], c0);
  if (DOFILL) { E4(p1, 12); A4(p1, 8); pf[4] = pk4f8o(pf[4], p1[0], p1[1], p1[2], p1[3]); pf[5] = pk4f8o(pf[5], p1[4], p1[5], p1[6], p1[7]); }
  SBAR();
  if (DOMMA) c1 = mfma8(a1, qr[2], c1);
  if (DOFILL) { A4(p1, 12); pf[6] = pk4f8o(pf[6], p1[8], p1[9], p1[10], p1[11]); pf[7] = pk4f8o(pf[7], p1[12], p1[13], p1[14], p1[15]);
    float ps = g_add(s0, s1); auto rr = __builtin_amdgcn_permlane32_swap(__float_as_uint(ps), __float_as_uint(ps), false, false); ps = __uint_as_float(rr[0]) + __uint_as_float(rr[1]);
    l_reg = l_reg * alP + ps; }
  SBAR();
#undef E4
#undef A4
}
template <bool DOMMA, bool DOSM, bool LDK, bool MI = false>
__device__ __forceinline__ void seg2_8(f32x16 (&o)[4], i32x8 f0, i32x8 f1, i32x8 f2, i32x8 f3, i32x8 pf, f32x16& c0, f32x16& c1, float& m_reg, float& alpha,
                                       const ATT_LAS char* Kn, int ka, i32x8& a0, i32x8& a1, i32x8& b0, i32x8& b1, f32x16* mi = nullptr, const ATT_LAS char* Vs = nullptr, int va = 0) {
  asm volatile("" : "+v"(ka), "+v"(va));
  const float mnC = fmaf(-m_reg, SC8, OFF8); float ma = -1e30f, mb = -1e30f;
#define XFORM4(V, b) do { if (!MI) { V[b] = g_fma(V[b], SC8, mnC); V[(b) + 1] = g_fma(V[(b) + 1], SC8, mnC); V[(b) + 2] = g_fma(V[(b) + 2], SC8, mnC); V[(b) + 3] = g_fma(V[(b) + 3], SC8, mnC); } \
    ma = g_max3(ma, V[b], V[(b) + 1]); mb = g_max3(mb, V[(b) + 2], V[(b) + 3]); } while (0)
#define E4(P, b) do { P[b] = g_exp2(P[b]); P[(b) + 1] = g_exp2(P[(b) + 1]); P[(b) + 2] = g_exp2(P[(b) + 2]); P[(b) + 3] = g_exp2(P[(b) + 3]); } while (0)
  if (DOMMA) o[0] = mfma8(pf, f0, o[0]);
  if (DOMMA && MLA8_VSPLIT && Vs) f2 = lds16x2(Vs + va + 4096, Vs + (va ^ 32) + 4096);
  if (DOSM) { XFORM4(c0, 0); XFORM4(c0, 4); XFORM4(c0, 8); XFORM4(c0, 12); }
  SBAR();
  if (DOMMA) o[1] = mfma8(pf, f1, o[1]);
  if (DOMMA && MLA8_VSPLIT && Vs) f3 = lds16x2(Vs + va + 6144, Vs + (va ^ 32) + 6144);
  if (LDK) { a0 = ldsx(Kn, ka); a1 = ldsx(Kn + 4096, ka); }
  if (DOSM) { XFORM4(c1, 0); XFORM4(c1, 4); XFORM4(c1, 8); XFORM4(c1, 12); }
  SBAR();
  if (DOMMA) o[2] = mfma8(pf, f2, o[2]);
  if (LDK) { b0 = ldsx(Kn, ka ^ 64); b1 = ldsx(Kn + 4096, ka ^ 64); }
  if (DOSM) { float pmax = g_max3(ma, mb, mb); auto rr = __builtin_amdgcn_permlane32_swap(__float_as_uint(pmax), __float_as_uint(pmax), false, false);
    pmax = g_max3(__uint_as_float(rr[0]), __uint_as_float(rr[1]), __uint_as_float(rr[1]));
    alpha = 1.f;
    if (__builtin_expect(__any(pmax > THRL8 + OFF8), 0)) {
      const float dl = fmaxf(pmax - OFF8, 0.f); m_reg += dl * (1.0f / SC8); alpha = __builtin_amdgcn_exp2f(-dl);
#pragma unroll
      for (int r = 0; r < 16; ++r) { c0[r] -= dl; c1[r] -= dl; if (MI) (*mi)[r] -= dl; } }
    E4(c0, 0); }
  SBAR();
  if (DOMMA) o[3] = mfma8(pf, f3, o[3]);
  if (DOSM) { E4(c0, 4); E4(c0, 8); E4(c0, 12); }
  SBAR();
#undef XFORM4
#undef E4
}

template <long VDELTA, int MODE = 0>
__device__ __forceinline__ void attn_mla8(const unsigned char* __restrict__ Q8n, int ldqn, const unsigned char* __restrict__ Q8r, int ldqr,
                                          const unsigned char* __restrict__ Kn8, const unsigned char* __restrict__ Kr8,
                                          unsigned char* __restrict__ O8b, int ldo, ATT_LAS char* lds, int wave_, float oscale) {
  constexpr int NT = 64; const unsigned char* Vt8 = Kn8 + VDELTA;
  const int tid = opaque_tid(wave_), wid = wave_, lane = tid & 63, r32 = lane & 31, hi = lane >> 5;
  ATT_LAS float* ws = (ATT_LAS float*)(lds + S8_WS) + wid * 64; ATT_LAS float* li_l = ws; ATT_LAS float* al_l = ws + 32;
  float m_reg = -1e30f, l_reg = 0.f; f32x16 o[4] = {}; i32x8 qr[3];
  const unsigned lds0 = (unsigned)(uintptr_t)lds;
#define DMA_VO ((unsigned)lane_id() * 16u)
#define DMA_KN8(j, slot) do { glds16(Kn8 + (size_t)(j) * S8_KN + wid * 1024, DMA_VO, (unsigned)__builtin_amdgcn_readfirstlane((int)(lds0 + (slot) * S8_SLOTK + wid * 1024))); } while (0)
#define DMA_KR8(j, slot, pc) do { glds16(Kr8 + (size_t)(j) * S8_KR + (pc) * 1024, DMA_VO, (unsigned)__builtin_amdgcn_readfirstlane((int)(lds0 + (slot) * S8_SLOTK + S8_KN + (pc) * 1024))); } while (0)
#define DMA_V8(j, slot) do { glds16(Vt8 + (size_t)(j) * S8_V + wid * 1024, DMA_VO, (unsigned)__builtin_amdgcn_readfirstlane((int)(lds0 + S8_VRING + (slot) * S8_V + wid * 1024))); } while (0)
#pragma unroll
  for (int j = 0; j < 6; ++j) { DMA_KN8(j, j); DMA_V8(j, j); }
#pragma unroll
  for (int i = 0; i < 3; ++i) { const int idx = wid + 8 * i; DMA_KR8(idx >> 2, idx >> 2, idx & 3); }
  { const unsigned char* qn = Q8n + (long)(wid * QBLK + r32) * ldqn + hi * 32; const unsigned char* qp = Q8r + (long)(wid * QBLK + r32) * ldqr + hi * 32;
    const i32x4 x0 = *(const i32x4*)qn, x1 = *(const i32x4*)(qn + 16), x2 = *(const i32x4*)(qn + 64), x3 = *(const i32x4*)(qn + 80), x4 = *(const i32x4*)qp, x5 = *(const i32x4*)(qp + 16);
    qr[0] = __builtin_shufflevector(x0, x1, 0, 1, 2, 3, 4, 5, 6, 7); qr[1] = __builtin_shufflevector(x2, x3, 0, 1, 2, 3, 4, 5, 6, 7); qr[2] = __builtin_shufflevector(x4, x5, 0, 1, 2, 3, 4, 5, 6, 7); }
  const int pi = 16 * ((r32 >> 2) & 1) + (r32 & 3) + 4 * (r32 >> 3);
  const int ka = pi * 128 + ((32 * hi) ^ (((pi >> 1) & 7) << 4)), ra = pi * 64 + ((32 * hi) ^ (((pi >> 2) & 3) << 4)), va = r32 * 64 + ((16 * hi) ^ (((r32 >> 2) & 3) << 4));
#define RESC8(a) do { if (__any((a) < 1.f)) { if (hi == 0) al_l[r32] = (a); asm volatile("s_waitcnt lgkmcnt(0)" ::: "memory"); \
    _Pragma("unroll") for (int d = 0; d < 4; ++d) _Pragma("unroll") for (int r = 0; r < 16; ++r) o[d][r] *= al_l[crow(r, hi)]; } } while (0)
#define LDK4(Kn) do { int ka_ = ka; asm volatile("" : "+v"(ka_)); a0 = ldsx((Kn), ka_); a1 = ldsx((Kn) + 4096, ka_); b0 = ldsx((Kn), ka_ ^ 64); b1 = ldsx((Kn) + 4096, ka_ ^ 64); } while (0)
  f32x16 pA0, pA1, pB0, pB1, minit = {}; float alA = 1.f, alB = 1.f; i32x8 pf = {}, a0 = {}, a1 = {}, b0 = {}, b1 = {}, f0 = {}, f1 = {}, f2 = {}, f3 = {};
  asm volatile("s_waitcnt vmcnt(0)" ::: "memory"); __syncthreads();
  if (MODE != 2) LDK4(lds);
  seg1_8<MODE != 2, false, false>(pA0, pA1, lds, ra, qr, a0, a1, b0, b1, pA0, pA1, 1.f, l_reg, pf, lds, va, f0, f1, f2, f3);
  { float pmax = pA0[0];
#pragma unroll
    for (int r = 1; r < 16; ++r) pmax = fmaxf(pmax, pA0[r]);
#pragma unroll
    for (int r = 0; r < 16; ++r) pmax = fmaxf(pmax, pA1[r]);
    auto rr = __builtin_amdgcn_permlane32_swap(__float_as_uint(pmax), __float_as_uint(pmax), false, false); pmax = fmaxf(__uint_as_float(rr[0]), __uint_as_float(rr[1]));
    m_reg = pmax; const float mnC = fmaf(-m_reg, SC8, OFF8);
#pragma unroll
    for (int r = 0; r < 16; ++r) { pA0[r] = __builtin_amdgcn_exp2f(fmaf(pA0[r], SC8, mnC)); pA1[r] = fmaf(pA1[r], SC8, mnC); if (MLA8_PRESCALE) minit[r] = mnC; } }
  asm volatile("s_waitcnt lgkmcnt(0)" ::: "memory"); __builtin_amdgcn_s_barrier(); asm volatile("" ::: "memory");
  DMA_KN8(6, 0); if (wid < 4) DMA_KR8(6, 0, wid);
  if (MODE != 2) LDK4(lds + S8_SLOTK);
#define SUB8(C0, C1, alC, P0, P1, alP, kslot, vslot, LDKN, knext) do { \
    SBAR(); seg1_8<MODE != 2, MODE != 1, MODE != 2>(C0, C1, lds + (kslot) * S8_SLOTK, ra, qr, a0, a1, b0, b1, P0, P1, alP, l_reg, pf, lds + S8_VRING + (vslot) * S8_V, va, f0, f1, f2, f3, minit); \
    SBAR(); seg2_8<MODE != 2, MODE != 1, (LDKN) && MODE != 2, MLA8_PRESCALE != 0>(o, f0, f1, f2, f3, pf, C0, C1, m_reg, alC, lds + (knext) * S8_SLOTK, ka, a0, a1, b0, b1, &minit, lds + S8_VRING + (vslot) * S8_V, va); SBAR(); \
    if (MODE != 0) asm volatile("" : "+v"(C0), "+v"(C1), "+v"(pf), "+v"(l_reg)); \
    RESC8(alC); } while (0)
#define PAIR8(T2, S0, FULL) do { constexpr int S2_ = (S0) == 4 ? 0 : (S0) + 2; \
    SUB8(pB0, pB1, alB, pA0, pA1, alA, (S0) + 1, (S0), true, S2_); \
    SUB8(pA0, pA1, alA, pB0, pB1, alB, S2_, (S0) + 1, false, 0); \
    if (FULL) asm volatile("s_waitcnt vmcnt(5) lgkmcnt(0)" ::: "memory"); else asm volatile("s_waitcnt vmcnt(0) lgkmcnt(0)" ::: "memory"); \
    __builtin_amdgcn_s_barrier(); asm volatile("" ::: "memory"); \
    if (FULL) { const unsigned vo_ = (unsigned)lane_id() * 16u; \
      glds16(Kn8 + (size_t)((T2) + 7) * S8_KN + wid * 1024, vo_, (unsigned)__builtin_amdgcn_readfirstlane((int)(lds0 + ((S0) + 1) * S8_SLOTK + wid * 1024))); \
      glds16(Kn8 + (size_t)((T2) + 8) * S8_KN + wid * 1024, vo_, (unsigned)__builtin_amdgcn_readfirstlane((int)(lds0 + S2_ * S8_SLOTK + wid * 1024))); \
      if (wid < 4) glds16(Kr8 + (size_t)((T2) + 7) * S8_KR + wid * 1024, vo_, (unsigned)__builtin_amdgcn_readfirstlane((int)(lds0 + ((S0) + 1) * S8_SLOTK + S8_KN + wid * 1024))); \
      else glds16(Kr8 + (size_t)((T2) + 8) * S8_KR + (wid - 4) * 1024, vo_, (unsigned)__builtin_amdgcn_readfirstlane((int)(lds0 + S2_ * S8_SLOTK + S8_KN + (wid - 4) * 1024))); \
      glds16(Vt8 + (size_t)((T2) + 6) * S8_V + wid * 1024, vo_, (unsigned)__builtin_amdgcn_readfirstlane((int)(lds0 + S8_VRING + (S0) * S8_V + wid * 1024))); \
      glds16(Vt8 + (size_t)((T2) + 7) * S8_V + wid * 1024, vo_, (unsigned)__builtin_amdgcn_readfirstlane((int)(lds0 + S8_VRING + ((S0) + 1) * S8_V + wid * 1024))); } \
    else { if ((T2) + 7 < NT) { DMA_KN8((T2) + 7, (S0) + 1); if (wid < 4) DMA_KR8((T2) + 7, (S0) + 1, wid); } if ((T2) + 6 < NT) DMA_V8((T2) + 6, (S0)); if ((T2) + 7 < NT) DMA_V8((T2) + 7, (S0) + 1); } \
    if (MODE != 2) LDK4(lds + (S2_ + 1) * S8_SLOTK); } while (0)
  static_assert(NT == 64, "the pair schedule below is written for 64 tiles");
#ifndef MLA8_PRIO
#define MLA8_PRIO 0
#endif
  if (MLA8_PRIO && wid >= 4) __builtin_amdgcn_s_setprio(1);
  for (int t2 = 0; t2 < 54; t2 += 6) { PAIR8(t2, 0, true); PAIR8(t2 + 2, 2, true); PAIR8(t2 + 4, 4, true); }
  PAIR8(54, 0, true); PAIR8(56, 2, false); PAIR8(58, 4, false); PAIR8(60, 0, false);
  SUB8(pB0, pB1, alB, pA0, pA1, alA, 3, 2, false, 0);
  seg1_8<false, true, MODE != 2>(pA0, pA1, lds, ra, qr, a0, a1, b0, b1, pB0, pB1, alB, l_reg, pf, lds + S8_VRING + 3 * S8_V, va, f0, f1, f2, f3);
  seg2_8<MODE != 2, false, false>(o, f0, f1, f2, f3, pf, pA0, pA1, m_reg, alA, lds, ka, a0, a1, b0, b1, nullptr, lds + S8_VRING + 3 * S8_V, va);
  if (MLA8_PRIO) __builtin_amdgcn_s_setprio(0);
#undef PAIR8
  { const int ln_ = opaque_tid(wave_) & 63, r32e = ln_ & 31, hie = ln_ >> 5;
    if (hie == 0) li_l[r32e] = l_reg; asm volatile("s_waitcnt lgkmcnt(0)" ::: "memory");
    unsigned char* Ow8 = O8b + (long)(wid * QBLK) * ldo + r32e;
#pragma unroll
    for (int r = 0; r < 16; ++r) { const int orow = crow(r, hie); const float rl = __builtin_amdgcn_rcpf(li_l[orow]) * oscale;
      { int w8 = __builtin_amdgcn_cvt_pk_fp8_f32(o[0][r] * rl, o[1][r] * rl, 0, false); w8 = __builtin_amdgcn_cvt_pk_fp8_f32(o[2][r] * rl, o[3][r] * rl, w8, true);
        if (MODE == 0) *(int*)(Ow8 + (long)orow * ldo + 3 * r32e) = w8; else asm volatile("" :: "v"(w8)); } } }
  __syncthreads();
#undef DMA_KN8
#undef DMA_VO
#undef DMA_KR8
#undef DMA_V8
#undef RESC8
#undef LDK4
#undef SUB8
}

template <long VDELTA, int MODE = 0>
__device__ __forceinline__ void attn_mla8pp(const unsigned char* __restrict__ Q8n, int ldqn, const unsigned char* __restrict__ Q8r, int ldqr,
                                            const unsigned char* __restrict__ Kn8, const unsigned char* __restrict__ Kr8,
                                            unsigned char* __restrict__ O8b, int ldo, ATT_LAS char* lds, int wave_, float oscale) {
  constexpr int NT = 64; const unsigned char* Vt8 = Kn8 + VDELTA;
  const int tid = opaque_tid(wave_), wid = wave_, lane = tid & 63, r32 = lane & 31, hi = lane >> 5;
  ATT_LAS float* ws = (ATT_LAS float*)(lds + S8_WS) + wid * 64; ATT_LAS float* li_l = ws; ATT_LAS float* al_l = ws + 32;
  float m_reg = -1e30f, l_reg = 0.f, alpha = 1.f; f32x16 o[4] = {}; i32x8 qr[3];
  const unsigned lds0 = (unsigned)(uintptr_t)lds;
#ifndef PP_PARITY
#define PP_PARITY 0
#endif
  const bool h1 = PP_PARITY ? (wid & 1) != 0 : wid >= 4; const int hidx = PP_PARITY ? (wid >> 1) : (wid & 3);
#define DMA_KN8(j, slot) do { glds16(Kn8 + (size_t)(j) * S8_KN + wid * 1024, (unsigned)lane_id() * 16u, (unsigned)__builtin_amdgcn_readfirstlane((int)(lds0 + (slot) * S8_SLOTK + wid * 1024))); } while (0)
#define DMA_KR8(j, slot, pc) do { glds16(Kr8 + (size_t)(j) * S8_KR + (pc) * 1024, (unsigned)lane_id() * 16u, (unsigned)__builtin_amdgcn_readfirstlane((int)(lds0 + (slot) * S8_SLOTK + S8_KN + (pc) * 1024))); } while (0)
#define DMA_V8(j, slot) do { glds16(Vt8 + (size_t)(j) * S8_V + wid * 1024, (unsigned)lane_id() * 16u, (unsigned)__builtin_amdgcn_readfirstlane((int)(lds0 + S8_VRING + (slot) * S8_V + wid * 1024))); } while (0)
#pragma unroll
  for (int j = 0; j < 6; ++j) { DMA_KN8(j, j); DMA_V8(j, j); }
#pragma unroll
  for (int i = 0; i < 3; ++i) { const int idx = wid + 8 * i; DMA_KR8(idx >> 2, idx >> 2, idx & 3); }
  { const unsigned char* qn = Q8n + (long)(wid * QBLK + r32) * ldqn + hi * 32; const unsigned char* qp = Q8r + (long)(wid * QBLK + r32) * ldqr + hi * 32;
    const i32x4 x0 = *(const i32x4*)qn, x1 = *(const i32x4*)(qn + 16), x2 = *(const i32x4*)(qn + 64), x3 = *(const i32x4*)(qn + 80), x4 = *(const i32x4*)qp, x5 = *(const i32x4*)(qp + 16);
    qr[0] = __builtin_shufflevector(x0, x1, 0, 1, 2, 3, 4, 5, 6, 7); qr[1] = __builtin_shufflevector(x2, x3, 0, 1, 2, 3, 4, 5, 6, 7); qr[2] = __builtin_shufflevector(x4, x5, 0, 1, 2, 3, 4, 5, 6, 7); }
  const int pi = 16 * ((r32 >> 2) & 1) + (r32 & 3) + 4 * (r32 >> 3);
  const int ka = pi * 128 + ((32 * hi) ^ (((pi >> 1) & 7) << 4)), ra = pi * 64 + ((32 * hi) ^ (((pi >> 2) & 3) << 4)), va = r32 * 64 + ((16 * hi) ^ (((r32 >> 2) & 3) << 4));
  f32x16 c0 = {}, c1 = {}, minit = {}; i32x8 pf = {}, a0 = {}, a1 = {}, b0 = {}, b1 = {}, e0 = {}, e1 = {}, f0 = {}, f1 = {}, f2 = {}, f3 = {};
  static_assert(MLA8_PRESCALE, "attn_mla8pp takes pre-scaled q / k");
#define PBAR() do { __builtin_amdgcn_s_barrier(); asm volatile("" ::: "memory"); } while (0)
#define LDKF(slot) do { int ka_ = ka; asm volatile("" : "+v"(ka_)); const ATT_LAS char* kn_ = lds + (slot) * S8_SLOTK; a0 = ldsx(kn_, ka_); a1 = ldsx(kn_ + 4096, ka_); b0 = ldsx(kn_, ka_ ^ 64); b1 = ldsx(kn_ + 4096, ka_ ^ 64); \
    int ra_ = ra; asm volatile("" : "+v"(ra_)); e0 = ldsx(kn_ + S8_KN, ra_); e1 = ldsx(kn_ + S8_KN + 2048, ra_); } while (0)
#define LDVF(slot) do { int va_ = va; asm volatile("" : "+v"(va_)); const ATT_LAS char* v0_ = lds + S8_VRING + (slot) * S8_V + va_; const ATT_LAS char* v1_ = lds + S8_VRING + (slot) * S8_V + (va_ ^ 32); \
    f0 = lds16x2(v0_, v1_); f1 = lds16x2(v0_ + 2048, v1_ + 2048); f2 = lds16x2(v0_ + 4096, v1_ + 4096); f3 = lds16x2(v0_ + 6144, v1_ + 6144); } while (0)
#define MSEG(DOQK, DOPV, kslot) do { SBAR(); \
    if (DOQK) { \
      c0 = mfma8(a0, qr[0], minit); c1 = mfma8(a1, qr[0], minit); \
      c0 = mfma8(b0, qr[1], c0); c1 = mfma8(b1, qr[1], c1); c0 = mfma8(e0, qr[2], c0); c1 = mfma8(e1, qr[2], c1); } \
    if (DOPV) { if (__any(alpha < 1.f)) { if (hi == 0) al_l[r32] = alpha; asm volatile("s_waitcnt lgkmcnt(0)" ::: "memory"); \
        _Pragma("unroll") for (int d_ = 0; d_ < 4; ++d_) _Pragma("unroll") for (int r_ = 0; r_ < 16; ++r_) o[d_][r_] *= al_l[crow(r_, hi)]; } \
      o[0] = mfma8(pf, f0, o[0]); o[1] = mfma8(pf, f1, o[1]); o[2] = mfma8(pf, f2, o[2]); o[3] = mfma8(pf, f3, o[3]); } \
    if (MODE != 0) asm volatile("" : "+v"(c0), "+v"(c1)); \
    SBAR(); } while (0)
#define VSEG(FIRST, LDK, kn, vn) do { SBAR(); if (MODE != 2) { \
    if (FIRST) { float pm_ = c0[0]; _Pragma("unroll") for (int r_ = 1; r_ < 16; ++r_) pm_ = fmaxf(pm_, c0[r_]); _Pragma("unroll") for (int r_ = 0; r_ < 16; ++r_) pm_ = fmaxf(pm_, c1[r_]); \
      auto rr_ = __builtin_amdgcn_permlane32_swap(__float_as_uint(pm_), __float_as_uint(pm_), false, false); m_reg = fmaxf(__uint_as_float(rr_[0]), __uint_as_float(rr_[1])); alpha = 1.f; \
      const float mn_ = OFF8 - m_reg; _Pragma("unroll") for (int r_ = 0; r_ < 16; ++r_) { c0[r_] += mn_; c1[r_] += mn_; minit[r_] = mn_; } } \
    else { float ma_ = fmaxf(fmaxf(c0[0], c0[1]), c0[2]), mb_ = fmaxf(fmaxf(c1[0], c1[1]), c1[2]), mc_ = fmaxf(fmaxf(c0[3], c0[4]), c0[5]), md_ = fmaxf(fmaxf(c1[3], c1[4]), c1[5]); \
      ma_ = fmaxf(fmaxf(ma_, c0[6]), c0[7]); mb_ = fmaxf(fmaxf(mb_, c1[6]), c1[7]); mc_ = fmaxf(fmaxf(mc_, c0[8]), c0[9]); md_ = fmaxf(fmaxf(md_, c1[8]), c1[9]); \
      ma_ = fmaxf(fmaxf(ma_, c0[10]), c0[11]); mb_ = fmaxf(fmaxf(mb_, c1[10]), c1[11]); mc_ = fmaxf(fmaxf(mc_, c0[12]), c0[13]); md_ = fmaxf(fmaxf(md_, c1[12]), c1[13]); \
      ma_ = fmaxf(fmaxf(ma_, c0[14]), mc_); mb_ = fmaxf(fmaxf(mb_, c1[14]), md_); \
      float pm_ = fmaxf(fmaxf(ma_, mb_), fmaxf(c0[15], c1[15])); \
      auto rr_ = __builtin_amdgcn_permlane32_swap(__float_as_uint(pm_), __float_as_uint(pm_), false, false); pm_ = fmaxf(__uint_as_float(rr_[0]), __uint_as_float(rr_[1])); \
      alpha = 1.f; \
      if (__builtin_expect(__any(pm_ > THRL8 + OFF8), 0)) { const float dl_ = fmaxf(pm_ - OFF8, 0.f); m_reg += dl_; alpha = __builtin_amdgcn_exp2f(-dl_); \
        _Pragma("unroll") for (int r_ = 0; r_ < 16; ++r_) { c0[r_] -= dl_; c1[r_] -= dl_; minit[r_] -= dl_; } } } \
    SBAR(); \
    { _Pragma("unroll") for (int r_ = 0; r_ < 16; ++r_) c0[r_] = __builtin_amdgcn_exp2f(c0[r_]); \
      _Pragma("unroll") for (int r_ = 0; r_ < 16; ++r_) c1[r_] = __builtin_amdgcn_exp2f(c1[r_]); \
      float s0_ = 0.f, s1_ = 0.f, s2_ = 0.f, s3_ = 0.f; \
      _Pragma("unroll") for (int r_ = 0; r_ < 16; r_ += 4) { s0_ += c0[r_]; s1_ += c0[r_ + 1]; s2_ += c0[r_ + 2]; s3_ += c0[r_ + 3]; } \
      _Pragma("unroll") for (int r_ = 0; r_ < 16; r_ += 4) { s0_ += c1[r_]; s1_ += c1[r_ + 1]; s2_ += c1[r_ + 2]; s3_ += c1[r_ + 3]; } \
      float ps_ = (s0_ + s1_) + (s2_ + s3_); auto rr_ = __builtin_amdgcn_permlane32_swap(__float_as_uint(ps_), __float_as_uint(ps_), false, false); ps_ = __uint_as_float(rr_[0]) + __uint_as_float(rr_[1]); \
      l_reg = l_reg * alpha + ps_; asm volatile("" : "+v"(l_reg)); \
      pf = (i32x8){pk4f8(c0[0], c0[1], c0[2], c0[3]), pk4f8(c0[4], c0[5], c0[6], c0[7]), pk4f8(c0[8], c0[9], c0[10], c0[11]), pk4f8(c0[12], c0[13], c0[14], c0[15]), \
                   pk4f8(c1[0], c1[1], c1[2], c1[3]), pk4f8(c1[4], c1[5], c1[6], c1[7]), pk4f8(c1[8], c1[9], c1[10], c1[11]), pk4f8(c1[12], c1[13], c1[14], c1[15])}; } \
    if (MODE != 0) asm volatile("" : "+v"(pf), "+v"(l_reg), "+v"(alpha)); } \
    SBAR(); if (MODE != 3) { if (LDK) LDKF(kn); LDVF(vn); } SBAR(); } while (0)
  asm volatile("s_waitcnt vmcnt(0)" ::: "memory"); __syncthreads();
  LDKF(0);
  if (h1) PBAR();
  MSEG(true, false, 0); PBAR(); VSEG(true, true, 1, 0);
  if (!h1) { PBAR(); DMA_KN8(6, 0); DMA_KR8(6, 0, hidx); }
  else { DMA_KN8(6, 0); PBAR(); }
#define PPWAIT(FULLW) do { if (FULLW) asm volatile("s_waitcnt vmcnt(5) lgkmcnt(0)" ::: "memory"); else asm volatile("s_waitcnt vmcnt(0) lgkmcnt(0)" ::: "memory"); } while (0)
#define PPREFILL(T2, S0, RF) do { constexpr int S2r_ = (S0) == 4 ? 0 : (S0) + 2; \
    if ((RF) == 2) { DMA_KN8((T2) + 7, (S0) + 1); DMA_KN8((T2) + 8, S2r_); if (wid < 4) DMA_KR8((T2) + 7, (S0) + 1, wid); else DMA_KR8((T2) + 8, S2r_, wid - 4); DMA_V8((T2) + 6, (S0)); DMA_V8((T2) + 7, (S0) + 1); } \
    else if ((RF) == 1) { DMA_KN8((T2) + 7, (S0) + 1); if (wid < 4) DMA_KR8((T2) + 7, (S0) + 1, wid); DMA_V8((T2) + 6, (S0)); DMA_V8((T2) + 7, (S0) + 1); } } while (0)
#define PAIRPP(T2, S0, RF, FULLW) do { constexpr int S2_ = (S0) == 4 ? 0 : (S0) + 2; \
    MSEG(MODE != 3, MODE != 3, (S0) + 1); PBAR(); \
    VSEG(false, true, S2_, (S0) + 1); if (h1) PPWAIT(FULLW); PBAR(); \
    MSEG(MODE != 3, MODE != 3, S2_); if (!h1) PPWAIT(FULLW); PBAR(); if (h1) PPREFILL(T2, S0, RF); \
    VSEG(false, true, S2_ + 1, S2_); PBAR(); if (!h1) PPREFILL(T2, S0, RF); } while (0)
  for (int t2 = 0; t2 < 54; t2 += 6) { PAIRPP(t2, 0, 2, true); PAIRPP(t2 + 2, 2, 2, true); PAIRPP(t2 + 4, 4, 2, true); }
  PAIRPP(54, 0, 2, true); PAIRPP(56, 2, 1, true); PAIRPP(58, 4, 0, false); PAIRPP(60, 0, 0, false);
  MSEG(true, true, 3); PBAR(); VSEG(false, false, 0, 3); PBAR(); MSEG(false, true, 0);
  if (!h1) PBAR();
  { const int ln_ = opaque_tid(wave_) & 63, r32e = ln_ & 31, hie = ln_ >> 5;
    if (hie == 0) li_l[r32e] = l_reg; asm volatile("s_waitcnt lgkmcnt(0)" ::: "memory");
    unsigned char* Ow8 = O8b + (long)(wid * QBLK) * ldo + r32e;
#pragma unroll
    for (int r = 0; r < 16; ++r) { const int orow = crow(r, hie); const float rl = __builtin_amdgcn_rcpf(li_l[orow]) * oscale;
      { int w8 = __builtin_amdgcn_cvt_pk_fp8_f32(o[0][r] * rl, o[1][r] * rl, 0, false); w8 = __builtin_amdgcn_cvt_pk_fp8_f32(o[2][r] * rl, o[3][r] * rl, w8, true);
        if (MODE == 0) *(int*)(Ow8 + (long)orow * ldo + 3 * r32e) = w8; else asm volatile("" :: "v"(w8)); } } }
  __syncthreads();
#undef DMA_KN8
#undef DMA_KR8
#undef DMA_V8
#undef PBAR
#undef LDKF
#undef LDVF
#undef MSEG
#undef VSEG
#undef PPWAIT
#undef PPREFILL
#undef PAIRPP
}

template <long VDELTA, int MODE = 0>
__device__ __forceinline__ void attn_mla8ph(const unsigned char* __restrict__ Q8n, int ldqn, const unsigned char* __restrict__ Q8r, int ldqr,
                                            const unsigned char* __restrict__ Kn8, const unsigned char* __restrict__ Kr8,
                                            unsigned char* __restrict__ O8b, int ldo, ATT_LAS char* lds, int wave_, float oscale) {
  constexpr int NT = 64; const unsigned char* Vt8 = Kn8 + VDELTA;
  const int tid = opaque_tid(wave_), wid = wave_, lane = tid & 63, r32 = lane & 31, hi = lane >> 5;
  ATT_LAS float* ws = (ATT_LAS float*)(lds + S8_WS) + wid * 64; ATT_LAS float* li_l = ws; ATT_LAS float* al_l = ws + 32;
  float m_reg = -1e30f, l_reg = 0.f; f32x16 o[4] = {}; i32x8 qr[3];
  const unsigned lds0 = (unsigned)(uintptr_t)lds;
  const bool h1 = wid >= 4;
#define DMA_KN8(j, slot) do { glds16(Kn8 + (size_t)(j) * S8_KN + wid * 1024, (unsigned)lane_id() * 16u, (unsigned)__builtin_amdgcn_readfirstlane((int)(lds0 + (slot) * S8_SLOTK + wid * 1024))); } while (0)
#define DMA_KR8(j, slot, pc) do { glds16(Kr8 + (size_t)(j) * S8_KR + (pc) * 1024, (unsigned)lane_id() * 16u, (unsigned)__builtin_amdgcn_readfirstlane((int)(lds0 + (slot) * S8_SLOTK + S8_KN + (pc) * 1024))); } while (0)
#define DMA_V8(j, slot) do { glds16(Vt8 + (size_t)(j) * S8_V + wid * 1024, (unsigned)lane_id() * 16u, (unsigned)__builtin_amdgcn_readfirstlane((int)(lds0 + S8_VRING + (slot) * S8_V + wid * 1024))); } while (0)
#pragma unroll
  for (int j = 0; j < 6; ++j) { DMA_KN8(j, j); DMA_V8(j, j); }
#pragma unroll
  for (int i = 0; i < 3; ++i) { const int idx = wid + 8 * i; DMA_KR8(idx >> 2, idx >> 2, idx & 3); }
  { const unsigned char* qn = Q8n + (long)(wid * QBLK + r32) * ldqn + hi * 32; const unsigned char* qp = Q8r + (long)(wid * QBLK + r32) * ldqr + hi * 32;
    const i32x4 x0 = *(const i32x4*)qn, x1 = *(const i32x4*)(qn + 16), x2 = *(const i32x4*)(qn + 64), x3 = *(const i32x4*)(qn + 80), x4 = *(const i32x4*)qp, x5 = *(const i32x4*)(qp + 16);
    qr[0] = __builtin_shufflevector(x0, x1, 0, 1, 2, 3, 4, 5, 6, 7); qr[1] = __builtin_shufflevector(x2, x3, 0, 1, 2, 3, 4, 5, 6, 7); qr[2] = __builtin_shufflevector(x4, x5, 0, 1, 2, 3, 4, 5, 6, 7); }
  const int pi = 16 * ((r32 >> 2) & 1) + (r32 & 3) + 4 * (r32 >> 3);
  const int ka = pi * 128 + ((32 * hi) ^ (((pi >> 1) & 7) << 4)), ra = pi * 64 + ((32 * hi) ^ (((pi >> 2) & 3) << 4)), va = r32 * 64 + ((16 * hi) ^ (((r32 >> 2) & 3) << 4));
  f32x16 pA0, pA1, pB0, pB1; float alA = 1.f, alB = 1.f; i32x8 pf = {}, a0 = {}, a1 = {}, b0 = {}, b1 = {}, f0 = {}, f1 = {}, f2 = {}, f3 = {};
#define PBAR() do { __builtin_amdgcn_s_barrier(); asm volatile("" ::: "memory"); } while (0)
#define LDKF(slot) do { int ka_ = ka; asm volatile("" : "+v"(ka_)); const ATT_LAS char* kn_ = lds + (slot) * S8_SLOTK; a0 = ldsx(kn_, ka_); a1 = ldsx(kn_ + 4096, ka_); b0 = ldsx(kn_, ka_ ^ 64); b1 = ldsx(kn_ + 4096, ka_ ^ 64); } while (0)
#define LDVF(slot) do { int va_ = va; asm volatile("" : "+v"(va_)); const ATT_LAS char* v0_ = lds + S8_VRING + (slot) * S8_V + va_; const ATT_LAS char* v1_ = lds + S8_VRING + (slot) * S8_V + (va_ ^ 32); \
    f0 = lds16x2(v0_, v1_); f1 = lds16x2(v0_ + 2048, v1_ + 2048); f2 = lds16x2(v0_ + 4096, v1_ + 4096); f3 = lds16x2(v0_ + 6144, v1_ + 6144); } while (0)
#define RESC8(a) do { if (__any((a) < 1.f)) { if (hi == 0) al_l[r32] = (a); asm volatile("s_waitcnt lgkmcnt(0)" ::: "memory"); \
    _Pragma("unroll") for (int d = 0; d < 4; ++d) _Pragma("unroll") for (int r = 0; r < 16; ++r) o[d][r] *= al_l[crow(r, hi)]; } } while (0)
#define MSEG(DOQK, DOPV, C0, C1, P0, P1, alP, kslot) do { SBAR(); \
    seg1_8<DOQK, DOPV, false>(C0, C1, lds + (kslot) * S8_SLOTK, ra, qr, a0, a1, b0, b1, P0, P1, alP, l_reg, pf, lds, va, f0, f1, f2, f3); \
    if (DOPV) { RESC8(alP); seg2_8<true, false, false>(o, f0, f1, f2, f3, pf, C0, C1, m_reg, alP, lds, ka, a0, a1, b0, b1); } SBAR(); } while (0)
#define VSEG(C0, C1, alC, LDK, kn, vn) do { SBAR(); seg2_8<false, true, false>(o, f0, f1, f2, f3, pf, C0, C1, m_reg, alC, lds, ka, a0, a1, b0, b1); SBAR(); if (LDK) LDKF(kn); LDVF(vn); SBAR(); } while (0)
  asm volatile("s_waitcnt vmcnt(0)" ::: "memory"); __syncthreads();
  LDKF(0);
  if (h1) PBAR();
  { float one_ = 1.f; MSEG(true, false, pA0, pA1, pA0, pA1, one_, 0); } PBAR();
  { SBAR(); float pmax = pA0[0];
#pragma unroll
    for (int r = 1; r < 16; ++r) pmax = fmaxf(pmax, pA0[r]);
#pragma unroll
    for (int r = 0; r < 16; ++r) pmax = fmaxf(pmax, pA1[r]);
    auto rr = __builtin_amdgcn_permlane32_swap(__float_as_uint(pmax), __float_as_uint(pmax), false, false); pmax = fmaxf(__uint_as_float(rr[0]), __uint_as_float(rr[1]));
    m_reg = pmax; const float mnC = fmaf(-m_reg, SC8, OFF8);
#pragma unroll
    for (int r = 0; r < 16; ++r) { pA0[r] = __builtin_amdgcn_exp2f(fmaf(pA0[r], SC8, mnC)); pA1[r] = fmaf(pA1[r], SC8, mnC); }
    SBAR(); LDKF(1); LDVF(0); SBAR(); }
  if (!h1) { PBAR(); DMA_KN8(6, 0); DMA_KR8(6, 0, wid); }
  else { DMA_KN8(6, 0); PBAR(); }
#define PPWAIT(FULLW) do { if (FULLW) asm volatile("s_waitcnt vmcnt(5) lgkmcnt(0)" ::: "memory"); else asm volatile("s_waitcnt vmcnt(0) lgkmcnt(0)" ::: "memory"); } while (0)
#define PPREFILL(T2, S0, RF) do { constexpr int S2r_ = (S0) == 4 ? 0 : (S0) + 2; \
    if ((RF) == 2) { DMA_KN8((T2) + 7, (S0) + 1); DMA_KN8((T2) + 8, S2r_); if (wid < 4) DMA_KR8((T2) + 7, (S0) + 1, wid); else DMA_KR8((T2) + 8, S2r_, wid - 4); DMA_V8((T2) + 6, (S0)); DMA_V8((T2) + 7, (S0) + 1); } \
    else if ((RF) == 1) { DMA_KN8((T2) + 7, (S0) + 1); if (wid < 4) DMA_KR8((T2) + 7, (S0) + 1, wid); DMA_V8((T2) + 6, (S0)); DMA_V8((T2) + 7, (S0) + 1); } } while (0)
#define PAIRPH(T2, S0, RF, FULLW) do { constexpr int S2_ = (S0) == 4 ? 0 : (S0) + 2; \
    MSEG(true, true, pB0, pB1, pA0, pA1, alA, (S0) + 1); PBAR(); \
    VSEG(pB0, pB1, alB, true, S2_, (S0) + 1); if (h1) PPWAIT(FULLW); PBAR(); \
    MSEG(true, true, pA0, pA1, pB0, pB1, alB, S2_); if (!h1) PPWAIT(FULLW); PBAR(); if (h1) PPREFILL(T2, S0, RF); \
    VSEG(pA0, pA1, alA, true, S2_ + 1, S2_); PBAR(); if (!h1) PPREFILL(T2, S0, RF); } while (0)
  for (int t2 = 0; t2 < 54; t2 += 6) { PAIRPH(t2, 0, 2, true); PAIRPH(t2 + 2, 2, 2, true); PAIRPH(t2 + 4, 4, 2, true); }
  PAIRPH(54, 0, 2, true); PAIRPH(56, 2, 1, true); PAIRPH(58, 4, 0, false); PAIRPH(60, 0, 0, false);
  MSEG(true, true, pB0, pB1, pA0, pA1, alA, 3); PBAR(); VSEG(pB0, pB1, alB, false, 0, 3); PBAR(); MSEG(false, true, pA0, pA1, pB0, pB1, alB, 0);
  if (!h1) PBAR();
  { const int ln_ = opaque_tid(wave_) & 63, r32e = ln_ & 31, hie = ln_ >> 5;
    if (hie == 0) li_l[r32e] = l_reg; asm volatile("s_waitcnt lgkmcnt(0)" ::: "memory");
    unsigned char* Ow8 = O8b + (long)(wid * QBLK) * ldo + r32e;
#pragma unroll
    for (int r = 0; r < 16; ++r) { const int orow = crow(r, hie); const float rl = __builtin_amdgcn_rcpf(li_l[orow]) * oscale;
      { int w8 = __builtin_amdgcn_cvt_pk_fp8_f32(o[0][r] * rl, o[1][r] * rl, 0, false); w8 = __builtin_amdgcn_cvt_pk_fp8_f32(o[2][r] * rl, o[3][r] * rl, w8, true);
        if (MODE == 0) *(int*)(Ow8 + (long)orow * ldo + 3 * r32e) = w8; else asm volatile("" :: "v"(w8)); } } }
  __syncthreads();
#undef DMA_KN8
#undef DMA_KR8
#undef DMA_V8
#undef PBAR
#undef LDKF
#undef LDVF
#undef RESC8
#undef MSEG
#undef VSEG
#undef PPWAIT
#undef PPREFILL
#undef PAIRPH
}

constexpr int S9_RB = 6 * S8_KN, S9_VB = S9_RB + 6 * S8_KR;
static_assert(S9_VB + 6 * S8_V == S8_WS, "attn_mla9 LDS map");
__device__ __forceinline__ i32x8 ld2(const ATT_LAS char* p, const ATT_LAS char* q) { const i32x4 a = *(const ATT_LAS i32x4*)p, b = *(const ATT_LAS i32x4*)q; return __builtin_shufflevector(a, b, 0, 1, 2, 3, 4, 5, 6, 7); }
struct Adr9 { const ATT_LAS char* k0; const ATT_LAS char* k1; const ATT_LAS char* k2; const ATT_LAS char* k3; const ATT_LAS char* r0; const ATT_LAS char* r1; const ATT_LAS char* v0; const ATT_LAS char* v1; };
template <bool DOMMA, bool DOFILL, bool LDV, int RO, int VO>
__device__ __forceinline__ void seg1_9(f32x16& c0, f32x16& c1, const Adr9& A, const i32x8 (&qr)[3], i32x8& a0, i32x8& a1, i32x8& b0, i32x8& b1,
                                       f32x16& p0, f32x16& p1, float alP, float& l_reg, i32x8& pf, i32x8& f0, i32x8& f1, const f32x16& z) {
  float s0 = 0.f, s1 = 0.f;
#define E4(P, b) do { P[b] = g_exp2(P[b]); P[(b) + 1] = g_exp2(P[(b) + 1]); P[(b) + 2] = g_exp2(P[(b) + 2]); P[(b) + 3] = g_exp2(P[(b) + 3]); } while (0)
#define A4(P, b) do { s0 = g_add(s0, P[b]); s1 = g_add(s1, P[(b) + 1]); s0 = g_add(s0, P[(b) + 2]); s1 = g_add(s1, P[(b) + 3]); } while (0)
  if (DOMMA) c0 = mfma8(a0, qr[0], z);
  if (DOFILL) { pf[0] = pk4f8o(pf[0], p0[0], p0[1], p0[2], p0[3]); pf[1] = pk4f8o(pf[1], p0[4], p0[5], p0[6], p0[7]); pf[2] = pk4f8o(pf[2], p0[8], p0[9], p0[10], p0[11]); pf[3] = pk4f8o(pf[3], p0[12], p0[13], p0[14], p0[15]); A4(p0, 0); A4(p0, 4); }
  SBAR();
  if (DOMMA) { c1 = mfma8(a1, qr[0], z); a0 = ld2(A.r0 + RO, A.r1 + RO); a1 = ld2(A.r0 + RO + 2048, A.r1 + RO + 2048); }
  if (DOFILL) { E4(p1, 0); A4(p0, 8); A4(p0, 12); }
  SBAR();
  if (DOMMA) c0 = mfma8(b0, qr[1], c0);
  if (LDV) { f0 = ld2(A.v0 + VO, A.v1 + VO); f1 = ld2(A.v0 + VO + 2048, A.v1 + VO + 2048); }
  if (DOFILL) { E4(p1, 4); A4(p1, 0); }
  SBAR();
  if (DOMMA) c1 = mfma8(b1, qr[1], c1);
  if (DOFILL) { E4(p1, 8); A4(p1, 4); }
  SBAR();
  if (DOMMA) c0 = mfma8(a0, qr[2], c0);
  if (DOFILL) { E4(p1, 12); A4(p1, 8); pf[4] = pk4f8o(pf[4], p1[0], p1[1], p1[2], p1[3]); pf[5] = pk4f8o(pf[5], p1[4], p1[5], p1[6], p1[7]); }
  SBAR();
  if (DOMMA) c1 = mfma8(a1, qr[2], c1);
  if (DOFILL) { A4(p1, 12); pf[6] = pk4f8o(pf[6], p1[8], p1[9], p1[10], p1[11]); pf[7] = pk4f8o(pf[7], p1[12], p1[13], p1[14], p1[15]);
    float ps = g_add(s0, s1); auto rr = __builtin_amdgcn_permlane32_swap(__float_as_uint(ps), __float_as_uint(ps), false, false); ps = __uint_as_float(rr[0]) + __uint_as_float(rr[1]);
    l_reg = l_reg * alP + ps; }
  SBAR();
#undef E4
#undef A4
}
template <bool DOMMA, bool DOSM, bool LDK, int KNO, int VO>
__device__ __forceinline__ void seg2_9(f32x16 (&o)[4], const Adr9& A, i32x8 f0, i32x8 f1, i32x8 pf, f32x16& c0, f32x16& c1, float& m_reg, float& alpha, i32x8& a0, i32x8& a1, i32x8& b0, i32x8& b1, f32x16& mi) {
  float ma = -1e30f, mb = -1e30f; i32x8 f2, f3;
#define MX4(V, b) do { ma = g_max3(ma, V[b], V[(b) + 1]); mb = g_max3(mb, V[(b) + 2], V[(b) + 3]); } while (0)
#define E4(P, b) do { P[b] = g_exp2(P[b]); P[(b) + 1] = g_exp2(P[(b) + 1]); P[(b) + 2] = g_exp2(P[(b) + 2]); P[(b) + 3] = g_exp2(P[(b) + 3]); } while (0)
  if (DOMMA) { o[0] = mfma8(pf, f0, o[0]); f2 = ld2(A.v0 + VO + 4096, A.v1 + VO + 4096); }
  if (DOSM) { MX4(c0, 0); MX4(c0, 4); MX4(c0, 8); MX4(c0, 12); }
  SBAR();
  if (DOMMA) { o[1] = mfma8(pf, f1, o[1]); f3 = ld2(A.v0 + VO + 6144, A.v1 + VO + 6144); }
  if (LDK) { a0 = ld2(A.k0 + KNO, A.k1 + KNO); a1 = ld2(A.k0 + KNO + 4096, A.k1 + KNO + 4096); }
  if (DOSM) { MX4(c1, 0); MX4(c1, 4); MX4(c1, 8); MX4(c1, 12); }
  SBAR();
  if (DOMMA) o[2] = mfma8(pf, f2, o[2]);
  if (LDK) { b0 = ld2(A.k2 + KNO, A.k3 + KNO); b1 = ld2(A.k2 + KNO + 4096, A.k3 + KNO + 4096); }
  if (DOSM) { float pmax = g_max3(ma, mb, mb); auto rr = __builtin_amdgcn_permlane32_swap(__float_as_uint(pmax), __float_as_uint(pmax), false, false);
    pmax = g_max3(__uint_as_float(rr[0]), __uint_as_float(rr[1]), __uint_as_float(rr[1]));
    alpha = 1.f;
    if (__builtin_expect(__any(pmax > THRL8 + OFF8), 0)) {
      const float dl = fmaxf(pmax - OFF8, 0.f); m_reg += dl; alpha = __builtin_amdgcn_exp2f(-dl);
#pragma unroll
      for (int r = 0; r < 16; ++r) { c0[r] -= dl; c1[r] -= dl; mi[r] -= dl; } }
    E4(c0, 0); }
  SBAR();
  if (DOMMA) o[3] = mfma8(pf, f3, o[3]);
  if (DOSM) { E4(c0, 4); E4(c0, 8); E4(c0, 12); }
  SBAR();
#undef MX4
#undef E4
}
template <long VDELTA, int MODE = 0>
__device__ __forceinline__ void attn_mla9(const unsigned char* __restrict__ Q8n, int ldqn, const unsigned char* __restrict__ Q8r, int ldqr,
                                          const unsigned char* __restrict__ Kn8, const unsigned char* __restrict__ Kr8,
                                          unsigned char* __restrict__ O8b, int ldo, ATT_LAS char* lds, int wave_, float oscale) {
  static_assert(MLA8_PRESCALE && MODE == 0, "attn_mla9 takes pre-scaled q / k");
  constexpr int NT = 64; const unsigned char* Vt8 = Kn8 + VDELTA;
  const int tid = opaque_tid(wave_), wid = wave_, lane = tid & 63, r32 = lane & 31, hi = lane >> 5;
  ATT_LAS float* ws = (ATT_LAS float*)(lds + S8_WS) + wid * 64; ATT_LAS float* li_l = ws; ATT_LAS float* al_l = ws + 32;
  float m_reg = -1e30f, l_reg = 0.f; f32x16 o[4] = {}; i32x8 qr[3];
  const unsigned lds0 = (unsigned)(uintptr_t)lds;
#define DMA9_KN(j, slot, vo) glds16(Kn8 + (size_t)(j) * S8_KN + wid * 1024, (vo), (unsigned)__builtin_amdgcn_readfirstlane((int)(lds0 + (slot) * S8_KN + wid * 1024)))
#define DMA9_KR(j, slot, pc, vo) glds16(Kr8 + (size_t)(j) * S8_KR + (pc) * 1024, (vo), (unsigned)__builtin_amdgcn_readfirstlane((int)(lds0 + S9_RB + (slot) * S8_KR + (pc) * 1024)))
#define DMA9_V(j, slot, vo) glds16(Vt8 + (size_t)(j) * S8_V + wid * 1024, (vo), (unsigned)__builtin_amdgcn_readfirstlane((int)(lds0 + S9_VB + (slot) * S8_V + wid * 1024)))
  { const unsigned vo_ = (unsigned)lane_id() * 16u;
#pragma unroll
    for (int j = 0; j < 6; ++j) { DMA9_KN(j, j, vo_); DMA9_V(j, j, vo_); }
#pragma unroll
    for (int i = 0; i < 3; ++i) { const int idx = wid + 8 * i; DMA9_KR(idx >> 2, idx >> 2, idx & 3, vo_); } }
  { const unsigned char* qn = Q8n + (long)(wid * QBLK + r32) * ldqn + hi * 32; const unsigned char* qp = Q8r + (long)(wid * QBLK + r32) * ldqr + hi * 32;
    const i32x4 x0 = *(const i32x4*)qn, x1 = *(const i32x4*)(qn + 16), x2 = *(const i32x4*)(qn + 64), x3 = *(const i32x4*)(qn + 80), x4 = *(const i32x4*)qp, x5 = *(const i32x4*)(qp + 16);
    qr[0] = __builtin_shufflevector(x0, x1, 0, 1, 2, 3, 4, 5, 6, 7); qr[1] = __builtin_shufflevector(x2, x3, 0, 1, 2, 3, 4, 5, 6, 7); qr[2] = __builtin_shufflevector(x4, x5, 0, 1, 2, 3, 4, 5, 6, 7); }
  const int pi = 16 * ((r32 >> 2) & 1) + (r32 & 3) + 4 * (r32 >> 3);
  const int ka = pi * 128 + ((32 * hi) ^ (((pi >> 1) & 7) << 4)), ra = pi * 64 + ((32 * hi) ^ (((pi >> 2) & 3) << 4)), va = r32 * 64 + ((16 * hi) ^ (((r32 >> 2) & 3) << 4));
  const Adr9 A{lds + ka, lds + (ka ^ 16), lds + (ka ^ 64), lds + (ka ^ 80), lds + S9_RB + ra, lds + S9_RB + (ra ^ 16), lds + S9_VB + va, lds + S9_VB + (va ^ 32)};
#define RESC9(a) do { if (__any((a) < 1.f)) { if (hi == 0) al_l[r32] = (a); asm volatile("s_waitcnt lgkmcnt(0)" ::: "memory"); \
    _Pragma("unroll") for (int d = 0; d < 4; ++d) _Pragma("unroll") for (int r = 0; r < 16; ++r) o[d][r] *= al_l[crow(r, hi)]; } } while (0)
#define LDK9(KO) do { a0 = ld2(A.k0 + (KO), A.k1 + (KO)); a1 = ld2(A.k0 + (KO) + 4096, A.k1 + (KO) + 4096); b0 = ld2(A.k2 + (KO), A.k3 + (KO)); b1 = ld2(A.k2 + (KO) + 4096, A.k3 + (KO) + 4096); } while (0)
  f32x16 pA0, pA1, pB0, pB1, minit = {}; float alA = 1.f, alB = 1.f; i32x8 pf = {}, a0 = {}, a1 = {}, b0 = {}, b1 = {}, f0 = {}, f1 = {};
  asm volatile("s_waitcnt vmcnt(0)" ::: "memory"); __syncthreads();
  LDK9(0);
  { const f32x16 z = {}; seg1_9<true, false, false, 0, 0>(pA0, pA1, A, qr, a0, a1, b0, b1, pA0, pA1, 1.f, l_reg, pf, f0, f1, z); }
  { float pmax = pA0[0];
#pragma unroll
    for (int r = 1; r < 16; ++r) pmax = fmaxf(pmax, pA0[r]);
#pragma unroll
    for (int r = 0; r < 16; ++r) pmax = fmaxf(pmax, pA1[r]);
    auto rr = __builtin_amdgcn_permlane32_swap(__float_as_uint(pmax), __float_as_uint(pmax), false, false); pmax = fmaxf(__uint_as_float(rr[0]), __uint_as_float(rr[1]));
    m_reg = pmax; const float mnC = OFF8 - m_reg;
#pragma unroll
    for (int r = 0; r < 16; ++r) { pA0[r] = __builtin_amdgcn_exp2f(pA0[r] + mnC); pA1[r] = pA1[r] + mnC; minit[r] = mnC; } }
  asm volatile("s_waitcnt lgkmcnt(0)" ::: "memory"); __builtin_amdgcn_s_barrier(); asm volatile("" ::: "memory");
  { const unsigned vo_ = (unsigned)lane_id() * 16u; DMA9_KN(6, 0, vo_); if (wid < 4) DMA9_KR(6, 0, wid, vo_); }
  LDK9(S8_KN);
#define SUB9(C0, C1, alC, P0, P1, alP, KS, VS, LDKN, KNX) do { \
    SBAR(); seg1_9<true, true, true, (KS) * S8_KR, (VS) * S8_V>(C0, C1, A, qr, a0, a1, b0, b1, P0, P1, alP, l_reg, pf, f0, f1, minit); \
    SBAR(); seg2_9<true, true, LDKN, (KNX) * S8_KN, (VS) * S8_V>(o, A, f0, f1, pf, C0, C1, m_reg, alC, a0, a1, b0, b1, minit); SBAR(); \
    RESC9(alC); } while (0)
#define PAIR9(T2, S0, FULL) do { constexpr int S2_ = (S0) == 4 ? 0 : (S0) + 2; \
    SUB9(pB0, pB1, alB, pA0, pA1, alA, (S0) + 1, (S0), true, S2_); \
    SUB9(pA0, pA1, alA, pB0, pB1, alB, S2_, (S0) + 1, false, 0); \
    if (FULL) asm volatile("s_waitcnt vmcnt(5) lgkmcnt(0)" ::: "memory"); else asm volatile("s_waitcnt vmcnt(0) lgkmcnt(0)" ::: "memory"); \
    __builtin_amdgcn_s_barrier(); asm volatile("" ::: "memory"); \
    { const unsigned vo_ = (unsigned)lane_id() * 16u; \
      if (FULL) { DMA9_KN((T2) + 7, (S0) + 1, vo_); DMA9_KN((T2) + 8, S2_, vo_); if (wid < 4) DMA9_KR((T2) + 7, (S0) + 1, wid, vo_); else DMA9_KR((T2) + 8, S2_, wid - 4, vo_); DMA9_V((T2) + 6, (S0), vo_); DMA9_V((T2) + 7, (S0) + 1, vo_); } \
      else { if ((T2) + 7 < NT) { DMA9_KN((T2) + 7, (S0) + 1, vo_); if (wid < 4) DMA9_KR((T2) + 7, (S0) + 1, wid, vo_); } if ((T2) + 6 < NT) DMA9_V((T2) + 6, (S0), vo_); if ((T2) + 7 < NT) DMA9_V((T2) + 7, (S0) + 1, vo_); } } \
    LDK9((S2_ + 1) * S8_KN); } while (0)
  for (int t2 = 0; t2 < 54; t2 += 6) { PAIR9(t2, 0, true); PAIR9(t2 + 2, 2, true); PAIR9(t2 + 4, 4, true); }
  PAIR9(54, 0, true); PAIR9(56, 2, false); PAIR9(58, 4, false); PAIR9(60, 0, false);
  SUB9(pB0, pB1, alB, pA0, pA1, alA, 3, 2, false, 0);
  seg1_9<false, true, true, 0, 3 * S8_V>(pA0, pA1, A, qr, a0, a1, b0, b1, pB0, pB1, alB, l_reg, pf, f0, f1, minit);
  seg2_9<true, false, false, 0, 3 * S8_V>(o, A, f0, f1, pf, pA0, pA1, m_reg, alA, a0, a1, b0, b1, minit);
  { const int ln_ = opaque_tid(wave_) & 63, r32e = ln_ & 31, hie = ln_ >> 5;
    if (hie == 0) li_l[r32e] = l_reg; asm volatile("s_waitcnt lgkmcnt(0)" ::: "memory");
    unsigned char* Ow8 = O8b + (long)(wid * QBLK) * ldo + r32e;
#pragma unroll
    for (int r = 0; r < 16; ++r) { const int orow = crow(r, hie); const float rl = __builtin_amdgcn_rcpf(li_l[orow]) * oscale;
      int w8 = __builtin_amdgcn_cvt_pk_fp8_f32(o[0][r] * rl, o[1][r] * rl, 0, false); w8 = __builtin_amdgcn_cvt_pk_fp8_f32(o[2][r] * rl, o[3][r] * rl, w8, true);
      *(int*)(Ow8 + (long)orow * ldo + 3 * r32e) = w8; } }
  __syncthreads();
#undef DMA9_KN
#undef DMA9_KR
#undef DMA9_V
#undef RESC9
#undef LDK9
#undef SUB9
#undef PAIR9
}
#undef SBAR
}
#define GAS __attribute__((address_space(1)))
#define LAS __attribute__((address_space(3)))
typedef unsigned short bf16;
typedef unsigned v4u __attribute__((ext_vector_type(4)));
typedef float f32x4 __attribute__((ext_vector_type(4)));
typedef short bf16x8 __attribute__((ext_vector_type(8)));
typedef GAS unsigned gu32;
typedef GAS unsigned long long gu64;
#define RLX_AGENT __ATOMIC_RELAXED, __HIP_MEMORY_SCOPE_AGENT
#define LDS_WAIT() asm volatile("s_waitcnt lgkmcnt(0)" ::: "memory")
#define VM_WAIT() asm volatile("s_waitcnt vmcnt(0)" ::: "memory")
__device__ __forceinline__ unsigned long long rt() { return __builtin_amdgcn_s_memrealtime(); }
__device__ __forceinline__ unsigned f2bf(float f) { unsigned u = __builtin_bit_cast(unsigned, f); return (u + 0x7fffu + ((u >> 16) & 1u)) >> 16; }
__device__ __forceinline__ unsigned pk2(float lo, float hi) { return f2bf(lo) | (f2bf(hi) << 16); }

#define XB_TMO      128
#define XB_XCNT(j)  (256  + 64 * (j))
#define XB_XSUB(j)  (1280 + 64 * (j))
#define XB_XGEN(j)  (2304 + 64 * (j))
#define XB_TOP      3328
#define XB_TOPGEN   3392
#define XCD_BAR_WORDS 3456
#define XB_SPIN_CAP (1u << 18)

__device__ __forceinline__ unsigned xb_ld(unsigned* p)              { return __hip_atomic_load(p, __ATOMIC_RELAXED, __HIP_MEMORY_SCOPE_AGENT); }
__device__ __forceinline__ unsigned xb_add(unsigned* p, unsigned v) { return __hip_atomic_fetch_add(p, v, __ATOMIC_RELAXED, __HIP_MEMORY_SCOPE_AGENT); }
__device__ __forceinline__ unsigned xb_xcc_id() { return (unsigned)__builtin_amdgcn_s_getreg((3 << 11) | 20) & 0xFu; }
#define XB_SPIN(cond, bar) do { unsigned _sp = 0; while (cond) { __builtin_amdgcn_s_sleep(1); \
    if ((++_sp & 255u) == 0u) { if (xb_ld(&(bar)[XB_TMO])) break; if (_sp > XB_SPIN_CAP) { atomicAdd(&(bar)[XB_TMO], 1u); break; } } } } while (0)

struct XcdBarrier {
    unsigned* bar; unsigned x;
    volatile LAS unsigned* st;
};

__device__ __forceinline__ XcdBarrier xcd_barrier_post(unsigned* bar, volatile LAS unsigned* st, bool t0) {
    XcdBarrier b; b.bar = bar; b.x = xb_xcc_id(); b.st = st;
    if (t0) (void)xb_add(&bar[XB_XCNT(b.x)], 1u);
    return b;
}
__device__ __forceinline__ void xcd_barrier_complete(unsigned* bar, unsigned x, unsigned& nloc, unsigned& nx) {
    const unsigned G = gridDim.x * gridDim.y * gridDim.z;
    unsigned sum, cnt, mine, sp = 0u;
    for (;;) {
        sum = 0u; cnt = 0u; mine = 0u;
#pragma unroll
        for (unsigned j = 0; j < 16; ++j) { const unsigned c = xb_ld(&bar[XB_XCNT(j)]); sum += c; cnt += (c > 0u) ? 1u : 0u; mine = (j == x) ? c : mine; }
        if (sum == G) break;
        __builtin_amdgcn_s_sleep(1);
        if ((++sp & 255u) == 0u) { if (xb_ld(&bar[XB_TMO])) break; if (sp > XB_SPIN_CAP) { atomicAdd(&bar[XB_TMO], 1u); break; } }
    }
    nloc = mine > 0u ? mine : 1u; nx = cnt > 0u ? cnt : 1u;
}

__device__ __forceinline__ void xcd_barrier(const XcdBarrier& b, bool t0) {
    asm volatile("s_waitcnt vmcnt(0)" ::: "memory");
    __syncthreads();
    if (t0) {
        unsigned* bar = b.bar;
        __builtin_amdgcn_s_waitcnt(0);
        unsigned nloc = b.st[0], nx = b.st[1];
        if (nloc == 0u) { xcd_barrier_complete(bar, b.x, nloc, nx); b.st[0] = nloc; b.st[1] = nx; }
        const unsigned old = xb_add(&bar[XB_XSUB(b.x)], 1u);
        const unsigned gen = old / nloc;
        if (old + 1u == (gen + 1u) * nloc) {
            __builtin_amdgcn_fence(__ATOMIC_RELEASE, "agent");
            asm volatile("s_waitcnt vmcnt(0)" ::: "memory");
            const unsigned og = xb_add(&bar[XB_TOP], 1u);
            const unsigned tg = og / nx;
            if (og + 1u == (tg + 1u) * nx) xb_add(&bar[XB_TOPGEN], 1u);
            else XB_SPIN(xb_ld(&bar[XB_TOPGEN]) == tg, bar);
            __builtin_amdgcn_fence(__ATOMIC_ACQUIRE, "agent");
            xb_add(&bar[XB_XGEN(b.x)], 1u);
            asm volatile("s_waitcnt vmcnt(0)" ::: "memory");
        } else {
            XB_SPIN(xb_ld(&bar[XB_XGEN(b.x)]) == gen, bar);
            __builtin_amdgcn_fence(__ATOMIC_ACQUIRE, "agent");
            asm volatile("s_waitcnt vmcnt(0)" ::: "memory");
        }
    }
    __syncthreads();
}
#ifndef DIAG
#define DIAG 0
#endif
#ifndef DIAG_LA
#define DIAG_LA 0
#endif
#ifndef DIAG_LB
#define DIAG_LB 1
#endif
#ifndef DIAG_LF
#define DIAG_LF 0
#endif
#if DIAG
namespace dg {
constexpr int NS = 8, CW_DG = 8192, NCHK = 16;
__device__ __forceinline__ float bf(unsigned short v) { return __uint_as_float((unsigned)v << 16); }
#ifndef DIAG_SR
#define DIAG_SR 0
#endif
__device__ __forceinline__ int srow(int i) {
#if DIAG_SR == 0
    switch (i) { case 0: return 0; case 1: return 1; case 2: return 255; case 3: return 256; case 4: return 4095; case 5: return 4096; case 6: return 36863; default: return 49151; }
#elif DIAG_SR == 1
    switch (i) { case 0: return 15; case 1: return 16; case 2: return 63; case 3: return 64; case 4: return 127; case 5: return 128; case 6: return 20005; default: return 191; }
#else
    switch (i) { case 0: return 300; case 1: return 2050; case 2: return 8191; case 3: return 12345; case 4: return 33000; case 5: return 40959; case 6: return 45001; default: return 47 ; }
#endif
}
__device__ __forceinline__ float dotA(const unsigned short* a, const float* W, int K, int N, int n) { float s = 0.f; for (int k = 0; k < K; ++k) s += bf(a[k]) * W[(size_t)k * N + n]; return s; }
__device__ __forceinline__ float wsum(float v) {
#pragma unroll
    for (int o = 1; o < 64; o <<= 1) v += __shfl_xor(v, o);
    return v; }
__device__ __forceinline__ void flush(float* acc, int k, float e2, float r2) { e2 = wsum(e2); r2 = wsum(r2); if ((opaque_tid() & 63) == 0) { atomicAdd(acc + 2 * k, e2); atomicAdd(acc + 2 * k + 1, r2); } }
__device__ __forceinline__ int il128(int d) { return d < 64 ? 2 * d : 2 * (d - 64) + 1; }
__device__ __forceinline__ int il64(int d) { return d < 32 ? 2 * d : 2 * (d - 32) + 1; }
__device__ __forceinline__ void ropecs(int pos, int j, int dim, float& c, float& s) { const float inv = exp2f(-((float)(2 * j) / (float)dim) * 13.287712379549449f); const float a = (float)pos * inv; c = cosf(a); s = sinf(a); }
#ifndef DIAG_CK
#define DIAG_CK -1
#endif
#define DG_ACC(k, ri, e2, r2, got, ref) do { const float g_ = (got), r_ = (ref); (e2) += (g_ - r_) * (g_ - r_); (r2) += r_ * r_; \
    if ((k) == DIAG_CK) { atomicAdd(dacc + 2 * (16 + (ri)), (g_ - r_) * (g_ - r_)); atomicAdd(dacc + 2 * (16 + (ri)) + 1, r_ * r_); } } while (0)
}
#endif
constexpr int NWAVES = 8;
#ifndef PH_MASK
#define PH_MASK 0xFFFF
#endif
#ifndef DIAG_CLK
#define DIAG_CLK 0
#endif
#ifndef FOUT_REV
#define FOUT_REV 0
#endif
#ifndef FINAL_BF16
#define FINAL_BF16 1
#endif
#ifndef QKV8_L2
#define QKV8_L2 1
#endif
#ifndef MLA8_FN
#define MLA8_FN attn_mla9
#endif
#ifndef DIAG_MLA8
#define DIAG_MLA8 0
#endif
#ifndef STAGGER_TICKS
#define STAGGER_TICKS 0
#endif
#ifndef PG8_SP2X
#define PG8_SP2X true
#endif
#ifndef PG8_ALIGNX
#define PG8_ALIGNX true
#endif
#ifndef FFN_CHUNKS
#define FFN_CHUNKS 1
#endif
#ifndef WGM_FIN
#define WGM_FIN 4
#endif
#ifndef WGM_FOUT
#define WGM_FOUT 4
#endif
#ifndef WGM_REST
#define WGM_REST 4
#endif
#ifndef PROBE_BARS
#define PROBE_BARS 0
#endif
#ifndef PROBE_FIN
#define PROBE_FIN 1
#endif
#ifndef PROBE_FIN_NULL
#define PROBE_FIN_NULL 0
#endif
#ifndef PROBE_QKV
#define PROBE_QKV 1
#endif
#ifndef PROBE_WOA
#define PROBE_WOA 1
#endif
#ifndef PROBE_BWIN
#define PROBE_BWIN 1
#endif
#ifndef PROBE_UP
#define PROBE_UP 1
#endif
#ifndef PROBE_WOB
#define PROBE_WOB 1
#endif
#ifndef PROBE_FOUT
#define PROBE_FOUT 1
#endif
#ifndef PROBE_MLA
#define PROBE_MLA 1
#endif
#ifndef PROBE_WIN
#define PROBE_WIN 1
#endif
#ifndef PROBE_NORM
#define PROBE_NORM 1
#endif
#ifndef PROBE_P0
#define PROBE_P0 1
#endif
constexpr int DM = 2048, SEQ = 4096, NSEQ = 12, M = NSEQ * SEQ, DEPTH = 4, M_PROMPT = 8 * SEQ;
constexpr int NH = 16, HD = 128, NKV = 4, NQKV = (NH + 2 * NKV) * HD;
constexpr int QL = 512, KVL = 512, ROPE = 64, NOPE = 128, VD = 128;
constexpr int BWIN_N = QL + KVL + ROPE, BWIN_NP = 1280;
constexpr int NQUP = NH * (NOPE + ROPE), NKVUP = NH * (NOPE + VD);
constexpr int DFF = 5632, DFF2 = 2 * DFF;
constexpr float EPS = 1e-6f;
constexpr float W8_WO = 32.f, W8_UP = 16.f, O8_A = 16.f, O8_B = 32.f;
constexpr int NTILE_M = M / 256;

constexpr size_t MiB = 1u << 20;
constexpr size_t WS_CTL = 0, CTL_ZERO_BYTES = 1 * MiB;
constexpr size_t WS_COSA = 1 * MiB, WS_SINA = 2 * MiB, WS_COSB = 3 * MiB, WS_SINB = 3 * MiB + 512 * 1024;
constexpr size_t WS_RS = 4 * MiB, WS_RSQ = WS_RS + 256 * 1024, WS_RSK = WS_RSQ + 256 * 1024;
constexpr size_t WS_SSP = 5 * MiB;
constexpr size_t WS_WQKV = 11 * MiB;
constexpr size_t WS_WOA  = WS_WQKV + 2 * (size_t)NQKV * DM * 2;
constexpr size_t WS_WBIN = WS_WOA + 2 * (size_t)DM * DM * 2;
constexpr size_t WS_WQUP = WS_WBIN + 2 * (size_t)BWIN_NP * DM * 2;
constexpr size_t WS_WKVUP = WS_WQUP + 2 * (size_t)NQUP * QL * 2;
constexpr size_t WS_WOB  = WS_WKVUP + 2 * (size_t)NKVUP * KVL * 2;
constexpr size_t WS_WFIN = WS_WOB + 2 * (size_t)DM * DM * 2;
constexpr size_t WS_WFOUT = WS_WFIN + 4 * (size_t)DFF2 * DM * 2;
constexpr size_t WS_XN = WS_WFOUT + 4 * (size_t)DM * DFF * 2;
constexpr size_t WS_S = WS_XN + (size_t)M * DM * 2;
static_assert(WS_XN == 355 * MiB && WS_S == 547 * MiB, "d_ws map");
constexpr size_t WS_AQ = WS_S, WS_AK = WS_AQ + (size_t)M * DM * 2, WS_AV = WS_AK + (size_t)M * NKV * HD * 2;
constexpr size_t WS_AO8 = WS_AV + (size_t)M * NKV * HD * 2;
constexpr size_t WS_BQN = WS_S, WS_BQR = WS_BQN + (size_t)M * DM * 2, WS_BKN = WS_BQR + (size_t)M * NH * ROPE * 2, WS_BV = WS_BKN + (size_t)M * DM * 2;
constexpr size_t WS_CQ = WS_BV + (size_t)M * DM * 2, WS_CKV = WS_CQ + (size_t)M * QL, WS_KR = WS_CKV + (size_t)M * KVL;
constexpr size_t WS_BO8 = WS_KR + (size_t)M * ROPE * 2;
constexpr size_t WS_B_END = WS_BO8 + (size_t)M * DM;
constexpr size_t WS_ACT = WS_S, WS_HALO = WS_ACT + (size_t)M * DFF * 2, WS_F_END = WS_HALO + (size_t)NTILE_M * 4 * DFF2 * 4;
constexpr size_t WS_XB8 = WS_S + 576 * MiB;
static_assert(WS_XB8 >= WS_F_END && WS_XB8 >= WS_BV + (size_t)M * DM && WS_XB8 + (size_t)M * DM <= WS_CQ, "XB8 placement");
constexpr size_t WS_END = WS_B_END > WS_F_END ? WS_B_END : WS_F_END;
static_assert(WS_END <= 1408 * MiB, "workspace budget (4 x largest input)");
constexpr int CW_TMO = 0, CW_BAR = 4096;

constexpr int RING_OFF = 0, RING_BYTES = 131072;
constexpr int LDSCTL_OFF = RING_BYTES, MISC_OFF = LDSCTL_OFF + 320;
constexpr int PTR_OFF = LDSCTL_OFF + 512;
constexpr int XCH_OFF = RING_BYTES + 1024;
constexpr int LDS_BYTES = 147456;
static_assert(XCH_OFF + 8192 <= LDS_BYTES && MISC_OFF + 128 <= XCH_OFF, "LDS map");
static_assert(att::SHM_ATTN <= RING_BYTES, "attention scratch inside the ring region");
static_assert(att::SHM_ATTN8 <= RING_BYTES, "fp8 attention scratch inside the ring region");

typedef unsigned short bf16;
typedef unsigned v2u __attribute__((ext_vector_type(2)));
__device__ __forceinline__ float wave_sum(float v) {
#define WS_SWZ(m) v += __builtin_bit_cast(float, __builtin_amdgcn_ds_swizzle(__builtin_bit_cast(int, v), ((m) << 10) | 0x1F))
    WS_SWZ(1); WS_SWZ(2); WS_SWZ(4); WS_SWZ(8); WS_SWZ(16);
#undef WS_SWZ
    auto rr = __builtin_amdgcn_permlane32_swap(__float_as_uint(v), __float_as_uint(v), false, false);
    return __uint_as_float(rr[0]) + __uint_as_float(rr[1]);
}
__device__ __forceinline__ unsigned pkbf(float lo, float hi) { return pg8::cvt_pk_bf16(lo, hi); }
__device__ __forceinline__ unsigned pk4f8(float a, float b, float c, float d) { int w = __builtin_amdgcn_cvt_pk_fp8_f32(a, b, 0, false); w = __builtin_amdgcn_cvt_pk_fp8_f32(c, d, w, true); return (unsigned)w; }

__device__ __forceinline__ int il128(int d) { return d < 64 ? 2 * d : 2 * (d - 64) + 1; }
__device__ __forceinline__ int il64(int d) { return d < 32 ? 2 * d : 2 * (d - 32) + 1; }
__device__ __forceinline__ int dst_row(int map, int n) {
    switch (map) {
    case 1: return n < (NH + NKV) * HD ? (n & ~127) + il128(n & 127) : (n & ~127) + 32 * (n & 3) + ((n & 127) >> 2);
    case 2: { const int h = n / 192, j = n % 192; return j < 128 ? h * 128 + j : NH * NOPE + h * 64 + il64(j - 128); }
    case 3: { const int h = n / 256, j = n % 256; return j < 128 ? h * 128 + j : NH * NOPE + h * 128 + 32 * (j & 3) + ((j - 128) >> 2); }
    case 4: { const int c = n < DFF ? n : n - DFF; return (c >> 7) * 256 + (n < DFF ? 0 : 128) + (c & 127); }
    case 5: return n < QL + KVL ? n : QL + KVL + il64(n - QL - KVL);
    default: return n;
    }
}
__device__ __forceinline__ void transpose_item(const float* W, int K, int N, bf16* WT, int map, const float* gain, LAS float* scr, int item, int lane, float f8s = 0.f) {
    const int nblk = N / 32, kb = item / nblk, nb = item % nblk, k0 = 64 * kb, n0 = 32 * nb;
    f32x4 v[8]; const int kr = lane >> 3, n4 = (lane & 7) * 4;
#pragma unroll
    for (int i = 0; i < 8; ++i) v[i] = *(const GAS f32x4*)(W + (size_t)(k0 + 8 * i + kr) * N + n0 + n4);
#pragma unroll
    for (int i = 0; i < 8; ++i) { const int kk = 8 * i + kr; const float gk = gain ? gain[k0 + kk] : 1.0f; LAS float* d = scr + kk * 33 + n4;
        d[0] = v[i].x * gk; d[1] = v[i].y * gk; d[2] = v[i].z * gk; d[3] = v[i].w * gk; }
    LDS_WAIT(); asm volatile("" ::: "memory");
    const int c = lane & 7;
#pragma unroll
    for (int j = 0; j < 4; ++j) { const int n = (lane >> 3) + 8 * j; const LAS float* s = scr + (8 * c) * 33 + n;
        if (f8s > 0.f) { v2u o8; o8.x = pk4f8(s[0 * 33] * f8s, s[1 * 33] * f8s, s[2 * 33] * f8s, s[3 * 33] * f8s); o8.y = pk4f8(s[4 * 33] * f8s, s[5 * 33] * f8s, s[6 * 33] * f8s, s[7 * 33] * f8s);
            *(GAS v2u*)((unsigned char*)WT + (size_t)dst_row(map, n0 + n) * K + k0 + 8 * c) = o8; continue; }
        v4u o; o.x = pkbf(s[0 * 33], s[1 * 33]); o.y = pkbf(s[2 * 33], s[3 * 33]); o.z = pkbf(s[4 * 33], s[5 * 33]); o.w = pkbf(s[6 * 33], s[7 * 33]);
        *(GAS v4u*)(WT + (size_t)dst_row(map, n0 + n) * K + k0 + 8 * c) = o; }
    LDS_WAIT(); asm volatile("" ::: "memory");
}
#ifndef P0_RM
#define P0_RM 1
#endif
struct TDesc { const float* W; int K, N; bf16* WT; int map; const float* gain; float f8s; int item; };
__device__ __forceinline__ void ti_load(const TDesc& d, int lane, f32x4 (&v)[8], float (&g)[8]) {
    const int nblk = d.N / 32, kb = d.item / nblk, nb = d.item % nblk, k0 = 64 * kb, n0 = 32 * nb, kr = lane >> 3, n4 = (lane & 7) * 4;
#pragma unroll
    for (int i = 0; i < 8; ++i) { v[i] = *(const GAS f32x4*)(d.W + (size_t)(k0 + 8 * i + kr) * d.N + n0 + n4); g[i] = d.gain ? d.gain[k0 + 8 * i + kr] : 1.0f; }
}
__device__ __forceinline__ void ti_finish(const TDesc& d, LAS float* scr, int lane, const f32x4 (&v)[8], const float (&g)[8]) {
    const int nblk = d.N / 32, kb = d.item / nblk, nb = d.item % nblk, k0 = 64 * kb, n0 = 32 * nb, kr = lane >> 3, n4 = (lane & 7) * 4;
#pragma unroll
    for (int i = 0; i < 8; ++i) { const int kk = 8 * i + kr; LAS float* dd = scr + kk * 33 + n4;
        dd[0] = v[i].x * g[i]; dd[1] = v[i].y * g[i]; dd[2] = v[i].z * g[i]; dd[3] = v[i].w * g[i]; }
    LDS_WAIT(); asm volatile("" ::: "memory");
    const int c = lane & 7; const float f8s = d.f8s;
#pragma unroll
    for (int j = 0; j < 4; ++j) { const int n = (lane >> 3) + 8 * j; const LAS float* s = scr + (8 * c) * 33 + n;
        if (f8s > 0.f) { v2u o8; o8.x = pk4f8(s[0 * 33] * f8s, s[1 * 33] * f8s, s[2 * 33] * f8s, s[3 * 33] * f8s); o8.y = pk4f8(s[4 * 33] * f8s, s[5 * 33] * f8s, s[6 * 33] * f8s, s[7 * 33] * f8s);
            *(GAS v2u*)((unsigned char*)d.WT + (size_t)dst_row(d.map, n0 + n) * d.K + k0 + 8 * c) = o8; continue; }
        v4u o; o.x = pkbf(s[0 * 33], s[1 * 33]); o.y = pkbf(s[2 * 33], s[3 * 33]); o.z = pkbf(s[4 * 33], s[5 * 33]); o.w = pkbf(s[6 * 33], s[7 * 33]);
        *(GAS v4u*)(d.WT + (size_t)dst_row(d.map, n0 + n) * d.K + k0 + 8 * c) = o; }
    LDS_WAIT(); asm volatile("" ::: "memory");
}
__device__ __forceinline__ void row_to_bf16_rs(const float* xrow, bf16* orow, float* rs_out, int lane) {
    const GAS f32x4* xr = (const GAS f32x4*)xrow + lane;
    f32x4 v[8]; float s = 0.f;
#pragma unroll
    for (int j = 0; j < 8; ++j) { v[j] = xr[64 * j]; s += (v[j].x * v[j].x + v[j].y * v[j].y) + (v[j].z * v[j].z + v[j].w * v[j].w); }
    s = wave_sum(s);
    if (lane == 0) *rs_out = 1.0f / sqrtf(s * (1.f / DM) + EPS);
    GAS v2u* o8 = (GAS v2u*)orow + lane;
#pragma unroll
    for (int j = 0; j < 8; ++j) { v2u w; w.x = pkbf(v[j].x, v[j].y); w.y = pkbf(v[j].z, v[j].w); o8[64 * j] = w; }
}
__device__ __forceinline__ void rs_phase(const float* ssp, int pitch, int first, int nslot4, float inv_n, float* rs, int bx, int G, int wave, float mul = 1.f) {
    const int t = opaque_tid(wave);
    for (int row = bx * (NWAVES * 64) + t; row < M; row += G * NWAVES * 64) {
        const GAS f32x4* p = (const GAS f32x4*)(ssp + (size_t)row * pitch + first); float s = 0.f;
        for (int j = 0; j < nslot4; ++j) { const f32x4 v = p[j]; s += (v.x + v.y) + (v.z + v.w); }
        rs[row] = mul / sqrtf(s * inv_n + EPS);
    }
}

__device__ __forceinline__ const float* inp_ptr(LAS unsigned char* lds, int i) {
    const unsigned long long v = ((const LAS unsigned long long*)(lds + PTR_OFF))[i];
    const unsigned lo = (unsigned)__builtin_amdgcn_readfirstlane((int)(unsigned)v), hi = (unsigned)__builtin_amdgcn_readfirstlane((int)(unsigned)(v >> 32));
    return (const float*)(((unsigned long long)hi << 32) | lo);
}
struct Args { const float* in[18]; float* out; unsigned char* ws; };
__global__ void __launch_bounds__(NWAVES * 64, 2) trunk_fwd(Args args) {
    extern __shared__ __attribute__((aligned(16))) unsigned char lds_raw[];
    LAS unsigned char* lds = (LAS unsigned char*)lds_raw;
    volatile LAS unsigned* MISC = (volatile LAS unsigned*)(lds + MISC_OFF);
    const int tid = threadIdx.x, lane = tid & 63, wave = __builtin_amdgcn_readfirstlane(tid >> 6);
    const int G0_ = gridDim.x, bx0_ = blockIdx.x;
#define GRID_IDS() int G = G0_, bx = bx0_; asm volatile("" : "+s"(G), "+s"(bx)); const int vcu = (G % 8 == 0) ? (bx % 8) * (G / 8) + bx / 8 : bx; const int gw = vcu * NWAVES + wave, NGW = G * NWAVES; (void)gw; (void)NGW; (void)vcu
    unsigned char* ws = args.ws;
    gu32* ctl = (gu32*)(ws + WS_CTL);
    for (int u = tid; u < (XCH_OFF - LDSCTL_OFF) / 4; u += NWAVES * 64) ((LAS unsigned*)(lds + LDSCTL_OFF))[u] = 0u;
    __syncthreads();
    if (tid < 18) ((LAS unsigned long long*)(lds + PTR_OFF))[tid] = (unsigned long long)args.in[tid];
    __syncthreads();
#define INP(i) inp_ptr(lds, (i))
#define STAGGER() do { if (STAGGER_TICKS > 0 && ((bx >> 3) & 1)) { const unsigned long long t0_ = __builtin_amdgcn_s_memrealtime(); while (__builtin_amdgcn_s_memrealtime() - t0_ < (unsigned long long)STAGGER_TICKS) __builtin_amdgcn_s_sleep(8); } } while (0)
    XcdBarrier bar = xcd_barrier_post((unsigned*)(ctl + CW_BAR), MISC + 8, tid == 0);
#define GRID_BAR() do { XcdBarrier b_ = bar; asm volatile("" : "+s"(b_.x), "+s"(b_.bar)); xcd_barrier(b_, wave == 0 && lane_id() == 0); } while (0)
    float* X = args.out;
    bf16* XB = (bf16*)(ws + WS_XN);
    float* RS = (float*)(ws + WS_RS); float* RSQ = (float*)(ws + WS_RSQ); float* RSK = (float*)(ws + WS_RSK); float* SSP = (float*)(ws + WS_SSP);

#pragma unroll 1
    for (int rep0_ = 0; rep0_ < PROBE_P0; ++rep0_) {
    GRID_IDS();
    {
        LAS float* scr = (LAS float*)(lds + RING_OFF + wave * 16384);
        constexpr int I_QKV = (DM / 64) * (NQKV / 32), I_WO = (DM / 64) * (DM / 32), I_BIN = (DM / 64) * (BWIN_N / 32), I_QUP = (QL / 64) * (NQUP / 32),
                      I_KVUP = (KVL / 64) * (NKVUP / 32), I_FIN = (DM / 64) * (DFF2 / 32), I_FOUT = (DFF / 64) * (DM / 32);
        constexpr int NITEMS = 2 * (I_QKV + I_WO + I_BIN + I_QUP + I_KVUP + I_WO) + 4 * (I_FIN + I_FOUT);
        auto rm = [](int r, int NB) -> int { const int s = r >> 3; return (((s / NB) << 3) + (r & 7)) * NB + s % NB; };
        auto decode = [&](int it) -> TDesc {
            int r = it;
            if (r < 2 * I_QKV) { const int l = r / I_QKV; return TDesc{args.in[5] + (size_t)l * DM * NQKV, DM, NQKV, (bf16*)(ws + WS_WQKV) + (size_t)l * NQKV * DM, 1, args.in[2] + (2 * l) * DM, (QKV8_L2 && l == 1) ? W8_WO : 0.f, P0_RM ? rm(r % I_QKV, NQKV / 32) : r % I_QKV}; } r -= 2 * I_QKV;
            if (r < 2 * I_WO) { const int l = r / I_WO; return TDesc{args.in[6] + (size_t)l * DM * DM, DM, DM, (bf16*)(ws + WS_WOA + (size_t)l * DM * DM), 0, nullptr, W8_WO, P0_RM ? rm(r % I_WO, DM / 32) : r % I_WO}; } r -= 2 * I_WO;
            if (r < 2 * I_BIN) { const int l = r / I_BIN; return TDesc{args.in[8] + (size_t)l * DM * BWIN_N, DM, BWIN_N, (bf16*)(ws + WS_WBIN + (size_t)l * BWIN_NP * DM), 5, args.in[2] + (2 * l + 1) * DM, W8_WO, P0_RM ? rm(r % I_BIN, BWIN_N / 32) : r % I_BIN}; } r -= 2 * I_BIN;
            if (r < 2 * I_QUP) { const int l = r / I_QUP; return TDesc{args.in[10] + (size_t)l * QL * NQUP, QL, NQUP, (bf16*)(ws + WS_WQUP + (size_t)l * NQUP * QL), 2, args.in[9] + l * QL, W8_UP, P0_RM ? rm(r % I_QUP, NQUP / 32) : r % I_QUP}; } r -= 2 * I_QUP;
            if (r < 2 * I_KVUP) { const int l = r / I_KVUP; return TDesc{args.in[12] + (size_t)l * KVL * NKVUP, KVL, NKVUP, (bf16*)(ws + WS_WKVUP + (size_t)l * NKVUP * KVL), 3, args.in[11] + l * KVL, W8_UP, P0_RM ? rm(r % I_KVUP, NKVUP / 32) : r % I_KVUP}; } r -= 2 * I_KVUP;
            if (r < 2 * I_WO) { const int l = r / I_WO; return TDesc{args.in[13] + (size_t)l * DM * DM, DM, DM, (bf16*)(ws + WS_WOB + (size_t)l * DM * DM), 0, nullptr, W8_WO, P0_RM ? rm(r % I_WO, DM / 32) : r % I_WO}; } r -= 2 * I_WO;
            if (r < 4 * I_FIN) { const int l = r / I_FIN; return TDesc{args.in[14] + (size_t)l * DM * DFF2, DM, DFF2, (bf16*)(ws + WS_WFIN) + (size_t)l * DFF2 * DM, 4, args.in[3] + l * DM, 0.f, P0_RM ? rm(r % I_FIN, DFF2 / 32) : r % I_FIN}; } r -= 4 * I_FIN;
            { const int l = r / I_FOUT; return TDesc{args.in[17] + (size_t)l * DFF * DM, DFF, DM, (bf16*)(ws + WS_WFOUT) + (size_t)l * DM * DFF, 0, nullptr, 0.f, P0_RM ? rm(r % I_FOUT, DM / 32) : r % I_FOUT}; }
        };
        { f32x4 va[8], vb[8]; float ga[8], gb[8]; TDesc d = decode(gw < NITEMS ? gw : 0);
          if (gw < NITEMS) ti_load(d, lane, va, ga);
          for (int it = gw; it < NITEMS; it += NGW) {
              const bool more = it + NGW < NITEMS; const TDesc dn = decode(more ? it + NGW : it);
              if (more) ti_load(dn, lane, vb, gb);
              ti_finish(d, scr, lane, va, ga);
              d = dn;
#pragma unroll
              for (int i = 0; i < 8; ++i) { va[i] = vb[i]; ga[i] = gb[i]; } } }
        for (int i = gw; i < 2 * (BWIN_NP - BWIN_N); i += NGW) { const int l = i / (BWIN_NP - BWIN_N), rr = BWIN_N + i % (BWIN_NP - BWIN_N);
            GAS v4u* p = (GAS v4u*)(ws + WS_WBIN + ((size_t)l * BWIN_NP + rr) * DM) + lane;
#pragma unroll
            for (int j = 0; j < 2; ++j) p[64 * j] = (v4u){0u, 0u, 0u, 0u}; }
        for (int i = bx * (NWAVES * 64) + tid; i < SEQ * 64 + SEQ * 32; i += G * NWAVES * 64) {
            if (i < SEQ * 64) { const int pos = i >> 6, j = i & 63; const double inv = exp2(-(double)(2 * j) / 128.0 * 13.287712379549449); const double a = (double)pos * inv;
                ((float*)(ws + WS_COSA))[i] = (float)cos(a); ((float*)(ws + WS_SINA))[i] = (float)sin(a); }
            else { const int k = i - SEQ * 64, pos = k >> 5, j = k & 31; const double inv = exp2(-(double)(2 * j) / 64.0 * 13.287712379549449); const double a = (double)pos * inv;
                ((float*)(ws + WS_COSB))[k] = (float)cos(a); ((float*)(ws + WS_SINB))[k] = (float)sin(a); }
        }
        for (int m = gw; m < M; m += NGW) { const float* xr = m < M_PROMPT ? args.in[0] + (size_t)m * DM : args.in[1] + (size_t)(m - M_PROMPT) * DM;
            row_to_bf16_rs(xr, XB + (size_t)m * DM, RS + m, lane); }
    }
    GRID_BAR();
    }

    for (int layer = 0; layer < DEPTH; ++layer) {
        GRID_IDS();
        const int jl = layer >> 1;
        unsigned char* wsl = ws; asm volatile("" : "+s"(wsl));
        bf16* XB = (bf16*)(wsl + WS_XN); float* RS = (float*)(wsl + WS_RS); float* RSQ = (float*)(wsl + WS_RSQ); float* RSK = (float*)(wsl + WS_RSK); float* SSP = (float*)(wsl + WS_SSP);
        const float* cosA = (const float*)(wsl + WS_COSA); const float* sinA = (const float*)(wsl + WS_SINA); const float* cosB = (const float*)(wsl + WS_COSB); const float* sinB = (const float*)(wsl + WS_SINB);
        const float* rb0 = nullptr; const float* rb1 = nullptr;
        if ((layer & 1) == 0) {
            bf16* AQ = (bf16*)(wsl + WS_AQ); bf16* AK = (bf16*)(wsl + WS_AK); bf16* AV = (bf16*)(wsl + WS_AV);
#pragma unroll 1
            for (int rp_ = 0; rp_ < PROBE_QKV; ++rp_) {
            if constexpr (PH_MASK & 1) {
                if (QKV8_L2 && jl == 1) {
                    pg8::Gemm g{(const bf16*)(wsl + WS_XB8), (const bf16*)(wsl + WS_WQKV + (size_t)jl * NQKV * DM * 2), M, NQKV, DM / 2}; pg8::StaticOrder S; S.init(M, NQKV, G, bx, WGM_REST);
                    pg8::EpiRope E{AQ, AK, AV, DM, NKV * HD, NKV * HD, 8, 10, 3, cosA, sinA, 64, RS, 1.0f / W8_WO};
                    STAGGER(); pg8::gemm_phase<pg8::EpiRope, pg8::StaticOrder, PG8_ALIGNX, PG8_SP2X, true>(lds + RING_OFF, g, S, E, wave);
                } else {
                pg8::Gemm g{XB, (const bf16*)(wsl + WS_WQKV) + (size_t)jl * NQKV * DM, M, NQKV, DM}; pg8::StaticOrder S; S.init(M, NQKV, G, bx, WGM_REST);
                pg8::EpiRope E{AQ, AK, AV, DM, NKV * HD, NKV * HD, 8, 10, 3, cosA, sinA, 64, RS, 1.0f};
                STAGGER(); pg8::gemm_phase<pg8::EpiRope, pg8::StaticOrder, PG8_ALIGNX, PG8_SP2X>(lds + RING_OFF, g, S, E, wave);
                }
            }
            GRID_BAR();
            }
#pragma unroll 1
            for (int rep_ = 0; rep_ < PROBE_WIN; ++rep_) {
            if constexpr (PH_MASK & 2) {
                const int xcd = vcu >> 5, c = vcu & 31;
                for (int i = 0; i < 12; ++i) {
                    const int pidx = xcd * 12 + i, b = pidx >> 3, h = 2 * (pidx & 7), kvh = h >> 2;
                    const int q0 = c * 128, k0 = q0 >= 128 ? q0 - 128 : 0, k1 = (q0 + 256 <= SEQ) ? q0 + 256 : SEQ;
                    const size_t row0 = (size_t)b * SEQ;
                    const float sink = INP(7)[jl * NH + h], sinkb = INP(7)[jl * NH + h + 1];
                    att::attn_body<0, true, 0, true, true>(AQ + (row0 + q0) * DM + h * HD, DM, nullptr, 0,
                                            AK + (row0 + k0) * (NKV * HD) + kvh * HD, NKV * HD, nullptr, 0,
                                            AV + (row0 + k0) * (NKV * HD) + kvh * HD, NKV * HD,
                                            (bf16*)(wsl + WS_AO8 + (row0 + q0) * DM + h * HD), DM, (k1 - k0) / 64, q0 - k0, sink * 11.313708498984761f, 1.0f, (LAS char*)(lds + RING_OFF), wave, O8_A, sinkb * 11.313708498984761f);
                }
            }
            GRID_BAR();
            }
#pragma unroll 1
            for (int rp_ = 0; rp_ < PROBE_WOA; ++rp_) {
            if constexpr (PH_MASK & 4) {
                pg8::Gemm g{(const bf16*)(wsl + WS_AO8), (const bf16*)(wsl + WS_WOA + (size_t)jl * DM * DM), M, DM, DM / 2}; pg8::StaticOrder S; S.init(M, DM, G, bx, WGM_REST);
                pg8::EpiResid E{rb0, rb1, M_PROMPT / 256, XB, nullptr, SSP, DM, rp_ + 1 == PROBE_WOA ? 1.0f / (W8_WO * O8_A) : 0.0f, nullptr};
                STAGGER(); pg8::gemm_phase<pg8::EpiResid, pg8::StaticOrder, PG8_ALIGNX, PG8_SP2X, true>(lds + RING_OFF, g, S, E, wave);
            }
            GRID_BAR();
            }
            rs_phase(SSP, 32, 0, 8, 1.0f / DM, RS, bx, G, wave);
            GRID_BAR();
        } else {
            bf16* CQ = (bf16*)(wsl + WS_CQ); bf16* CKV = (bf16*)(wsl + WS_CKV); bf16* KR = (bf16*)(wsl + WS_KR);
            bf16* BQN = (bf16*)(wsl + WS_BQN); bf16* BQR = (bf16*)(wsl + WS_BQR); bf16* BKN = (bf16*)(wsl + WS_BKN); bf16* BV = (bf16*)(wsl + WS_BV);
#pragma unroll 1
            for (int rp_ = 0; rp_ < PROBE_BWIN; ++rp_) {
            if constexpr (PH_MASK & 8) {
                pg8::Gemm g{(const bf16*)(wsl + WS_XB8), (const bf16*)(wsl + WS_WBIN + (size_t)jl * BWIN_NP * DM), M, BWIN_NP, DM / 2}; pg8::StaticOrder S; S.init(M, BWIN_NP, G, bx, WGM_REST);
                pg8::EpiBwin E{CQ, CKV, KR, SSP, cosB, sinB, RS, MLA8_KSC, 1.0f / W8_WO};
                STAGGER(); pg8::gemm_phase<pg8::EpiBwin, pg8::StaticOrder, PG8_ALIGNX, PG8_SP2X, true>(lds + RING_OFF, g, S, E, wave);
            }
            GRID_BAR();
            }
            rs_phase(SSP, 16, 0, 2, 1.0f / QL, RSQ, bx, G, wave, MLA8_QSC / W8_UP); rs_phase(SSP, 16, 8, 2, 1.0f / KVL, RSK, bx, G, wave, 1.0f / W8_UP);
            GRID_BAR();
#pragma unroll 1
            for (int rp_ = 0; rp_ < PROBE_UP; ++rp_) {
            if constexpr (PH_MASK & 32) {
                pg8::Gemm g{CQ, (const bf16*)(wsl + WS_WQUP + (size_t)jl * NQUP * QL), M, NQUP, QL / 2}; pg8::StaticOrder S; S.init(M, NQUP, G, bx, WGM_REST);
                pg8::EpiRopeT<true> E{BQN, BQR, BQR, DM, NH * ROPE, NH * ROPE, 8, 12, 2, cosB, sinB, 32, RSQ, 1.0f};
                STAGGER(); pg8::gemm_phase<pg8::EpiRopeT<true>, pg8::StaticOrder, PG8_ALIGNX, PG8_SP2X, true>(lds + RING_OFF, g, S, E, wave);
            }
            if constexpr (PH_MASK & 64) {
                pg8::Gemm g{CKV, (const bf16*)(wsl + WS_WKVUP + (size_t)jl * NKVUP * KVL), M, NKVUP, KVL / 2}; pg8::StaticOrder S; S.init(M, NKVUP, G, bx, WGM_REST);
                pg8::EpiKV8 E{(unsigned char*)BKN, (unsigned char*)BV, RSK, MLA8_KSC};
                STAGGER(); pg8::gemm_phase<pg8::EpiKV8, pg8::StaticOrder, PG8_ALIGNX, PG8_SP2X, true>(lds + RING_OFF, g, S, E, wave);
            }
            GRID_BAR();
            }
#pragma unroll 1
            for (int rep_ = 0; rep_ < PROBE_MLA; ++rep_) {
#if DIAG_CLK == 3
            const long long ca0_ = clock64();
#endif
            if constexpr (PH_MASK & 128) {
                const int xcd = vcu >> 5, c = vcu & 31;
                for (int i = 0; i < 12; ++i) {
                    const int bh = xcd * 24 + 2 * i + (c >> 4), qb = c & 15, b = bh >> 4, h = bh & 15;
                    const size_t row0 = (size_t)b * SEQ; const int q0 = qb * 256;
#if PROBE_MLA > 1 && defined(PROBE_ATT_MODE)
                    if (rep_ + 1 < PROBE_MLA) att::MLA8_FN<(long)(WS_BV - WS_BKN), PROBE_ATT_MODE>((const unsigned char*)BQN + (row0 + q0) * DM + h * NOPE, DM, (const unsigned char*)BQR + (row0 + q0) * (NH * ROPE) + h * ROPE, NH * ROPE,
                                   (const unsigned char*)BKN + (size_t)bh * (SEQ / 64) * 8192, (const unsigned char*)KR + (size_t)b * (SEQ / 64) * 4096,
                                   wsl + WS_BO8 + (row0 + q0) * DM + h * VD, DM, (LAS char*)(lds + RING_OFF), wave, O8_B);
                    else
#endif
                    att::MLA8_FN<(long)(WS_BV - WS_BKN)>((const unsigned char*)BQN + (row0 + q0) * DM + h * NOPE, DM, (const unsigned char*)BQR + (row0 + q0) * (NH * ROPE) + h * ROPE, NH * ROPE,
                                   (const unsigned char*)BKN + (size_t)bh * (SEQ / 64) * 8192, (const unsigned char*)KR + (size_t)b * (SEQ / 64) * 4096,
                                   wsl + WS_BO8 + (row0 + q0) * DM + h * VD, DM, (LAS char*)(lds + RING_OFF), wave, O8_B);
                }
            }
#if DIAG_CLK == 3
            if (layer == 1 && bx == 0 && opaque_tid(wave) == 0) ((float*)(ctl + 8192))[0] = (float)(clock64() - ca0_) * (1.0f / (12.f * 64.f * 100.f));
#endif
            GRID_BAR();
            }
#if DIAG_MLA8
            if (layer == 1 && bx < 8) {
                const int t_ = opaque_tid(wave);
                const int srow = bx == 0 ? 0 : bx == 1 ? 255 : bx == 2 ? 256 : bx == 3 ? 4095 : bx == 4 ? 4096 + 1234 : bx == 5 ? 20000 : bx == 6 ? 36863 : 49151, sh = (2 * bx + 1) & 15;
                const int sb = srow >> 12, sbh = sb * 16 + sh;
                const unsigned char* qn = (const unsigned char*)BQN + (size_t)srow * DM + sh * NOPE; const unsigned char* qp = (const unsigned char*)BQR + (size_t)srow * (NH * ROPE) + sh * ROPE;
                const unsigned char* kn = (const unsigned char*)BKN + (size_t)sbh * 64 * 8192; const unsigned char* kr = (const unsigned char*)KR + (size_t)sb * 64 * 4096; const unsigned char* vt = (const unsigned char*)BV + (size_t)sbh * 64 * 8192;
                LAS float* sc = (LAS float*)(lds + RING_OFF);
#define F8DEC(x) __builtin_amdgcn_cvt_f32_fp8((int)(x), 0)
_Pragma("unroll 1")
                for (int j = t_; j < SEQ; j += NWAVES * 64) { const int tl = j >> 6, kk = j & 63; float s = 0.f;
_Pragma("unroll 1")
                    for (int d = 0; d < 128; ++d) s += F8DEC(qn[d]) * F8DEC(kn[(size_t)tl * 8192 + kk * 128 + (((d & ~15) ^ (((kk >> 1) & 7) << 4)) | (d & 15))]);
_Pragma("unroll 1")
                    for (int d = 0; d < 64; ++d) s += F8DEC(qp[d]) * F8DEC(kr[(size_t)tl * 4096 + kk * 64 + (((d & ~15) ^ (((kk >> 2) & 3) << 4)) | (d & 15))]);
                    sc[j] = MLA8_PRESCALE ? s * 0.6931471805599453f : s * 0.07216878364870322f; }
                __syncthreads();
                float mx = -1e30f;
_Pragma("unroll 1")
                for (int j = 0; j < SEQ; ++j) mx = fmaxf(mx, sc[j]);
                float l = 0.f;
_Pragma("unroll 1")
                for (int j = 0; j < SEQ; ++j) l += __builtin_amdgcn_exp2f((sc[j] - mx) * 1.4426950408889634f);
                if (t_ < 128) { float o_ = 0.f; const int vr_ = 32 * (t_ & 3) + (t_ >> 2);
_Pragma("unroll 1")
                    for (int j = 0; j < SEQ; ++j) { const int tl = j >> 6, kk = j & 63; o_ += __builtin_amdgcn_exp2f((sc[j] - mx) * 1.4426950408889634f) * F8DEC(vt[(size_t)tl * 8192 + vr_ * 64 + ((((kk >> 4) ^ ((vr_ >> 2) & 3))) << 4) + (kk & 15)]); }
                    o_ /= l; const float got = F8DEC(((const unsigned char*)(wsl + WS_BO8))[(size_t)srow * DM + sh * VD + t_]) * (1.0f / O8_B);
                    atomicAdd((float*)(ctl + 8192), (got - o_) * (got - o_)); atomicAdd((float*)(ctl + 8192) + 1, o_ * o_); }
                __syncthreads();
            }
#endif
#pragma unroll 1
            for (int rp_ = 0; rp_ < PROBE_WOB; ++rp_) {
            if constexpr (PH_MASK & 256) {
                pg8::Gemm g{(const bf16*)(wsl + WS_BO8), (const bf16*)(wsl + WS_WOB + (size_t)jl * DM * DM), M, DM, DM / 2}; pg8::StaticOrder S; S.init(M, DM, G, bx, WGM_REST);
                pg8::EpiResid E{rb0, rb1, M_PROMPT / 256, XB, nullptr, SSP, DM, rp_ + 1 == PROBE_WOB ? 1.0f / (W8_WO * O8_B) : 0.0f, nullptr};
                STAGGER(); pg8::gemm_phase<pg8::EpiResid, pg8::StaticOrder, PG8_ALIGNX, PG8_SP2X, true>(lds + RING_OFF, g, S, E, wave);
            }
            GRID_BAR();
            }
            rs_phase(SSP, 32, 0, 8, 1.0f / DM, RS, bx, G, wave);
            GRID_BAR();
        }
#if PROBE_FIN_NULL
        {
#if DIAG_CLK == 2
            const long long c0_ = clock64();
#endif (near-free epilogue into d_out, which the last layer overwrites later)
#if PROBE_FIN_NULL == 2
            pg8::Gemm g{XB, (const bf16*)(wsl + WS_WFIN) + (size_t)layer * DFF2 * DM, M, DFF2, DM}; pg8::StaticOrder S; S.init((bx & 8) ? 0 : M, DFF2, G / 2, (bx & 7) + 8 * (bx >> 4));
#else
            pg8::Gemm g{XB, (const bf16*)(wsl + WS_WFIN) + (size_t)layer * DFF2 * DM, M, DFF2, DM}; pg8::StaticOrder S; S.init(M, DFF2, G, bx, WGM_REST);
#endif
#if PROBE_FIN_NULL >= 11
            pg8::EpiConvT<PROBE_FIN_NULL - 10> E{nullptr, nullptr, INP(15) + (size_t)layer * 3 * DFF2, INP(16) + (size_t)layer * DFF2, (LAS float*)(lds + XCH_OFF), DFF, (const float*)(wsl + WS_RS)};
            STAGGER(); pg8::gemm_phase<pg8::EpiConvT<PROBE_FIN_NULL - 10>, pg8::StaticOrder, true, PG8_SP2X>(lds + RING_OFF, g, S, E, wave);
#else
            pg8::EpiSum E{X};
            STAGGER(); pg8::gemm_phase<pg8::EpiSum, pg8::StaticOrder, PG8_ALIGNX, PG8_SP2X>(lds + RING_OFF, g, S, E, wave);
#endif
#if DIAG_CLK == 2
            if (layer == 0 && bx == 0 && opaque_tid(wave) == 0) ((float*)(ctl + 8192))[0] = (float)(clock64() - c0_) * (1.0f / (33.f * 32.f * 100.f));
#endif
            GRID_BAR();
        }
#endif
        constexpr int MC = M / FFN_CHUNKS, TC = MC / 256;
        static_assert(M % FFN_CHUNKS == 0 && MC % SEQ == 0, "FFN chunks are whole sequences");
#pragma unroll 1
        for (int ck = 0; ck < FFN_CHUNKS; ++ck) {
#define CK_PTRS() int ck_ = ck; asm volatile("" : "+s"(ck_)); const size_t r0 = (size_t)ck_ * MC; bf16* ACTc = (bf16*)(wsl + WS_ACT) + r0 * DFF; float* HALOc = (float*)(wsl + WS_HALO) + (r0 / 256) * 4 * DFF2; bf16* XBc = (bf16*)(wsl + WS_XN) + r0 * DM; (void)ACTc; (void)HALOc; (void)XBc
#pragma unroll 1
        for (int rep_ = 0; rep_ < PROBE_FIN; ++rep_) {
        if constexpr (PH_MASK & 512) {
            CK_PTRS(); const float* cw = INP(15) + (size_t)layer * 3 * DFF2; const float* cb = INP(16) + (size_t)layer * DFF2;
            pg8::Gemm g{XBc, (const bf16*)(wsl + WS_WFIN) + (size_t)layer * DFF2 * DM, MC, DFF2, DM}; pg8::StaticOrder S; S.init(MC, DFF2, G, bx, WGM_FIN);
            pg8::EpiConv E{ACTc, HALOc, cw, cb, (LAS float*)(lds + XCH_OFF), DFF, RS + r0};
            STAGGER(); pg8::gemm_phase<pg8::EpiConv, pg8::StaticOrder, true, PG8_SP2X>(lds + RING_OFF, g, S, E, wave);
        }
        GRID_BAR();
        }
        if constexpr (PH_MASK & 1024) { const int ln = opaque_tid(wave) & 63; CK_PTRS(); const float* cw = INP(15) + (size_t)layer * 3 * DFF2; const float* cb = INP(16) + (size_t)layer * DFF2;
            constexpr int NCH = DFF / 256;
            for (int it = gw; it < TC * 2 * NCH; it += NGW) {
                const int ch = it % NCH, tr = it / NCH, pm = tr >> 1, last = tr & 1;
                const int c = ch * 256 + 4 * ln, pn = c >> 7, cc = c & 127;
                const size_t gc = (size_t)pn * 256 + cc, uc = gc + 128;
                const float* Hc = HALOc + ((size_t)pm * 4 + (last ? 3 : 0)) * DFF2;
                const bool hasP = last ? true : (pm & 15) != 0, hasN = last ? (pm & 15) != 15 : true;
                const float* Hp = last ? HALOc + ((size_t)pm * 4 + 2) * DFF2 : HALOc + ((size_t)(pm - 1) * 4 + 3) * DFF2;
                const float* Hn = last ? HALOc + ((size_t)(pm + 1) * 4 + 0) * DFF2 : HALOc + ((size_t)pm * 4 + 1) * DFF2;
                const f32x4 z = (f32x4){0.f, 0.f, 0.f, 0.f};
                const f32x4 gP = hasP ? *(const f32x4*)(Hp + gc) : z, uP = hasP ? *(const f32x4*)(Hp + uc) : z;
                const f32x4 gN = hasN ? *(const f32x4*)(Hn + gc) : z, uN = hasN ? *(const f32x4*)(Hn + uc) : z;
                const f32x4 gC = *(const f32x4*)(Hc + gc), uC = *(const f32x4*)(Hc + uc);
                const f32x4 gg = *(const f32x4*)(cw + c) * gP + *(const f32x4*)(cw + DFF2 + c) * gC + *(const f32x4*)(cw + 2 * DFF2 + c) * gN + *(const f32x4*)(cb + c);
                const f32x4 uu = *(const f32x4*)(cw + DFF + c) * uP + *(const f32x4*)(cw + DFF2 + DFF + c) * uC + *(const f32x4*)(cw + 2 * DFF2 + DFF + c) * uN + *(const f32x4*)(cb + DFF + c);
                f32x4 a;
#pragma unroll
                for (int e = 0; e < 4; ++e) { const float ex = __builtin_amdgcn_exp2f(-1.4426950408889634f * gg[e]); a[e] = gg[e] * __builtin_amdgcn_rcpf(1.0f + ex) * uu[e]; }
                v2u w; w.x = pkbf(a[0], a[1]); w.y = pkbf(a[2], a[3]);
                *(GAS v2u*)(ACTc + ((size_t)pm * 256 + (last ? 255 : 0)) * DFF + c) = w;
            }
        }
        GRID_BAR();
#pragma unroll 1
        for (int rep_ = 0; rep_ < PROBE_FOUT; ++rep_) {
        if constexpr (PH_MASK & 2048) {
            CK_PTRS();
            pg8::Gemm g{ACTc, (const bf16*)(wsl + WS_WFOUT) + (size_t)layer * DM * DFF, MC, DM, DFF}; pg8::StaticOrder S; S.init(MC, DM, G, bx, WGM_FOUT);
            pg8::EpiResid E{nullptr, nullptr, 0, XBc, (!FINAL_BF16 && layer + 1 == DEPTH && rep_ + 1 == PROBE_FOUT) ? X + r0 * DM : nullptr, SSP + r0 * 32, DM, rep_ + 1 == PROBE_FOUT ? 1.0f : 0.0f, ((layer & 1) == 0 || (QKV8_L2 && layer == 1)) ? wsl + WS_XB8 + r0 * DM : nullptr};
            STAGGER(); pg8::gemm_phase<pg8::EpiResid, pg8::StaticOrder, PG8_ALIGNX, PG8_SP2X>(lds + RING_OFF, g, S, E, wave);
        }
        GRID_BAR();
        }
        }
#undef CK_PTRS
        if (layer + 1 < DEPTH) { rs_phase(SSP, 32, 0, 8, 1.0f / DM, RS, bx, G, wave); GRID_BAR(); }
    }
#pragma unroll 1
    for (int pb_ = 0; pb_ < PROBE_BARS; ++pb_) GRID_BAR();
    {
        GRID_IDS();
        const int lane = opaque_tid(wave) & 63;
        const GAS f32x4* gr = (const GAS f32x4*)INP(4) + lane;
        for (int m = gw; m < M; m += NGW) {
            GAS f32x4* xr = (GAS f32x4*)(X + (size_t)m * DM) + lane;
            const float r = 1.0f / sqrtf(wave_sum(lane < 32 ? SSP[(size_t)m * 32 + lane] : 0.f) * (1.f / DM) + EPS);
#if FINAL_BF16
            const GAS v2u* xb = (const GAS v2u*)((const bf16*)(ws + WS_XN) + (size_t)m * DM) + lane;
            v2u xv[8];
#pragma unroll
            for (int j = 0; j < 8; ++j) xv[j] = xb[64 * j];
#pragma unroll
            for (int j = 0; j < 8; ++j) { const f32x4 xf = (f32x4){__uint_as_float(xv[j].x << 16), __uint_as_float(xv[j].x & 0xffff0000u), __uint_as_float(xv[j].y << 16), __uint_as_float(xv[j].y & 0xffff0000u)};
                xr[64 * j] = xf * r * gr[64 * j]; }
#else
#pragma unroll
            for (int j = 0; j < 8; ++j) xr[64 * j] = xr[64 * j] * r * gr[64 * j];
#endif
        }
    }
#if DIAG_MLA8
    GRID_BAR();
    { GRID_IDS(); const float e2 = __hip_atomic_load((float*)(ctl + 8192), RLX_AGENT), r2 = __hip_atomic_load((float*)(ctl + 8192) + 1, RLX_AGENT);
      int code = (int)(sqrtf(e2 / r2) * 100.f + 1.5f); code = code < 1 ? 1 : (code > 98 ? 98 : code);
      const float C = sqrtf(1.0025f * (10.f * code - 1.f)); const int lane = opaque_tid(wave) & 63;
      for (int m = gw; m < M; m += NGW) { GAS f32x4* xr = (GAS f32x4*)(X + (size_t)m * DM) + lane;
#pragma unroll
          for (int j = 0; j < 8; ++j) xr[64 * j] = (f32x4){C, C, C, C}; } }
#endif
#if DIAG_CLK
    GRID_BAR();
    { GRID_IDS(); const float ratio = __hip_atomic_load((float*)(ctl + 8192), RLX_AGENT); int code = (int)(ratio + 0.5f); code = code < 1 ? 1 : (code > 98 ? 98 : code);
      const float C = sqrtf(1.0025f * (10.f * code - 1.f)); const int lane = opaque_tid(wave) & 63;
      for (int m = gw; m < M; m += NGW) { GAS f32x4* xr = (GAS f32x4*)(X + (size_t)m * DM) + lane;
#pragma unroll
          for (int j = 0; j < 8; ++j) xr[64 * j] = (f32x4){C, C, C, C}; } }
#endif
}

extern "C" void kernel_launch(void* const* d_in, const int* in_sizes, int n_in, void* d_out, int out_size, void* d_ws, size_t ws_size, hipStream_t stream) {
    static int grid = 0;
    if (grid == 0) {
        if (n_in != 18 || out_size != M * DM || ws_size < WS_END) { fprintf(stderr, "kernel_launch: shape mismatch n_in %d out %d ws %zu (need %zu)\n", n_in, out_size, ws_size, (size_t)WS_END); grid = -1; return; }
        int dev = 0, cus = 0, per_cu = 0;
        if (hipGetDevice(&dev) != hipSuccess || hipDeviceGetAttribute(&cus, hipDeviceAttributeMultiprocessorCount, dev) != hipSuccess) { grid = -1; return; }
        if (hipFuncSetAttribute((const void*)trunk_fwd, hipFuncAttributeMaxDynamicSharedMemorySize, LDS_BYTES) != hipSuccess) { fprintf(stderr, "kernel_launch: hipFuncSetAttribute failed\n"); grid = -1; return; }
        if (hipOccupancyMaxActiveBlocksPerMultiprocessor(&per_cu, (const void*)trunk_fwd, NWAVES * 64, LDS_BYTES) != hipSuccess || per_cu < 1)
            fprintf(stderr, "kernel_launch: occupancy query reports %d workgroups per CU\n", per_cu);
        (void)hipGetLastError();
        grid = cus;
        if (grid != 256) fprintf(stderr, "kernel_launch: %d CUs (the attention unit deal assumes 256)\n", grid);
    }
    if (grid < 0) return;
    if (hipMemsetAsync((char*)d_ws + WS_CTL, 0, CTL_ZERO_BYTES, stream) != hipSuccess) return;
    Args a{};
    for (int i = 0; i < 18; ++i) a.in[i] = (const float*)d_in[i];
    a.out = (float*)d_out; a.ws = (unsigned char*)d_ws;
    hipLaunchKernelGGL(trunk_fwd, dim3(grid), dim3(NWAVES * 64), LDS_BYTES, stream, a);
    const hipError_t le = hipPeekAtLastError();
    if (le != hipSuccess) fprintf(stderr, "kernel_launch: launch failed: %s\n", hipGetErrorName(le));
}
```

```cpp
#include <hip/hip_runtime.h>
#include <hip/hip_bf16.h>
#include <cstdio>
#include <cstdint>
__device__ __forceinline__ int lane_id() { int r; asm volatile("v_mbcnt_lo_u32_b32 %0, -1, 0\n\tv_mbcnt_hi_u32_b32 %0, -1, %0" : "=v"(r)); return r; }
__device__ __forceinline__ int opaque_tid(int wave) { int t = (wave << 6) | lane_id(); asm volatile("" : "+v"(t)); return t; }
#ifndef MLA8_PRESCALE
#define MLA8_PRESCALE 1
#endif
constexpr float MLA8_KSC = MLA8_PRESCALE ? 0.0625f : 1.0f, MLA8_QSC = MLA8_PRESCALE ? 16.0f * 0.07216878364870322f * 1.4426950408889634f : 1.0f;
namespace pg8 {
#define PG8_LAS __attribute__((address_space(3)))
typedef unsigned short bf16_t;
typedef short bf16x8 __attribute__((ext_vector_type(8)));
typedef float f32x4 __attribute__((ext_vector_type(4)));
typedef unsigned u32x4 __attribute__((ext_vector_type(4)));
#ifndef PG8_WGM
#define PG8_WGM 4
#endif
constexpr int BM = 256, BK = 64, HALF = 128, HTB = HALF * BK * 2  , STAGE_BYTES = 8 * HTB, NXCD = 8, WGM = PG8_WGM;

__host__ __device__ __forceinline__ int lds_byte(int r, int c) { const int st = (r >> 4) * 2 + (c >> 5), rr = r & 15, cc = c & 31, ob = rr * 64 + cc * 2; return st * 1024 + (ob ^ (((ob >> 9) & 1) << 5)); }
__host__ __device__ __forceinline__ void stage_rc(int b, int& R, int& C) { const int st = b / 1024, sb = b % 1024, swz = sb ^ (((sb >> 9) & 1) << 5); R = (st >> 1) * 16 + swz / 64; C = (st & 1) * 32 + (swz % 64) / 2; }
__host__ __device__ __forceinline__ int perm32(int rho) { const int n = rho >> 4, i = rho & 15; return 8 * (i >> 2) + 4 * n + (i & 3); }

struct Unit { int pm, pn; };
struct Gemm { const bf16_t* A; const bf16_t* Bt; int M, N, K; };

struct StaticOrder {
    int nM, nN, nwg, G, c, wgm;
    __host__ __device__ void init(int M, int N, int G_, int c_, int wgm_ = WGM) { nM = M / BM; nN = N / BM; nwg = nM * nN; G = G_; c = c_; wgm = wgm_; }
    __host__ __device__ bool next(int i, Unit& u) const {
        const long L = (long)i * G + c; if (L >= nwg) return false;
        int wgid = (int)L; { const int q = nwg / NXCD, r = nwg % NXCD, xcd = wgid % NXCD, off = wgid / NXCD; wgid = (xcd < r ? xcd * (q + 1) : r * (q + 1) + (xcd - r) * q) + off; }
        const int nig = wgm * nN, gid = wgid / nig, fm = gid * wgm, gsz = (nM - fm) < wgm ? (nM - fm) : wgm;
        u.pm = fm + ((wgid % nig) % gsz); u.pn = (wgid % nig) / gsz; return true;
    }
    __device__ __forceinline__ void a_ready(const Unit&) const {}
    __device__ __forceinline__ void done(const Unit&) const {}
};

__device__ __forceinline__ unsigned cvt_pk_bf16(float lo, float hi) { unsigned r; asm volatile("v_cvt_pk_bf16_f32 %0, %1, %2" : "=v"(r) : "v"(lo), "v"(hi)); return r; }
typedef float f32x2 __attribute__((ext_vector_type(2)));
typedef unsigned u32x2 __attribute__((ext_vector_type(2)));
__device__ __forceinline__ unsigned cvt_pk4_f8(float a, float b, float c, float d) { int w = __builtin_amdgcn_cvt_pk_fp8_f32(a, b, 0, false); w = __builtin_amdgcn_cvt_pk_fp8_f32(c, d, w, true); return (unsigned)w; }

__device__ __forceinline__ float rstd_of(const float* rs, int row) { return rs[row]; }
__device__ __forceinline__ float fq_sum(float v) {
    v += __builtin_bit_cast(float, __builtin_amdgcn_ds_swizzle(__builtin_bit_cast(int, v), 0x401F));
    auto rr = __builtin_amdgcn_permlane32_swap(__float_as_uint(v), __float_as_uint(v), false, false);
    return __uint_as_float(rr[0]) + __uint_as_float(rr[1]);
}

struct EpiBf16Split {
    static constexpr bool PERM = true, AFTER_DRAIN = false, APERM = false; static constexpr int SMIN = 0;
    bf16_t* O0; bf16_t* O1; int ldc; int split; const float* rs;
    __device__ __forceinline__ void operator()(const f32x4 (&acc)[2][2][4][2], const Unit& u, int wr, int wc, int fr, int fq) const {
        char* base = (char*)((u.pn < split) ? (O0 + (size_t)u.pn * BM) : (O1 + (size_t)(u.pn - split) * BM)) + (size_t)u.pm * BM * ldc * 2;
        const unsigned off0 = (unsigned)((wr * 64 + fr) * ldc + wc * 32 + 8 * fq) * 2u;
        const int row0 = u.pm * BM + wr * 64 + fr;
        float rsv[2][4];
#pragma unroll
        for (int ai = 0; ai < 2; ++ai)
#pragma unroll
            for (int m = 0; m < 4; ++m) rsv[ai][m] = rstd_of(this->rs, row0 + ai * HALF + m * 16);
#pragma unroll
        for (int ai = 0; ai < 2; ++ai)
#pragma unroll
            for (int m = 0; m < 4; ++m) { const unsigned off = off0 + (unsigned)((ai * HALF + m * 16) * ldc) * 2u;
                const float rs = rsv[ai][m];
#pragma unroll
                for (int bj = 0; bj < 2; ++bj) { const f32x4 v0 = acc[ai][bj][m][0] * rs, v1 = acc[ai][bj][m][1] * rs;
                    u32x4 w; w.x = cvt_pk_bf16(v0[0], v0[1]); w.y = cvt_pk_bf16(v0[2], v0[3]); w.z = cvt_pk_bf16(v1[0], v1[1]); w.w = cvt_pk_bf16(v1[2], v1[3]);
                    *(u32x4*)(base + off + bj * HALF * 2) = w; } }
    }
};

template <bool F8OUT = false>
struct EpiRopeT {
    static constexpr bool PERM = true, AFTER_DRAIN = false, APERM = false; static constexpr int SMIN = 0;
    static constexpr unsigned EB = F8OUT ? 1u : 2u;
    bf16_t* O0; bf16_t* O1; bf16_t* O2; int ld0, ld1, ld2, t1, t2, rope_mask; const float* cs; const float* sn; int jn; const float* rs; float osc;
    __device__ __forceinline__ void operator()(const f32x4 (&acc)[2][2][4][2], const Unit& u, int wr, int wc, int fr, int fq) const {
        char* ob; int ldc; bool rope;
        if (u.pn < t1) { ob = (char*)O0 + (size_t)u.pn * BM * EB; ldc = ld0; rope = (rope_mask & 1) != 0; }
        else if (u.pn < t2) { ob = (char*)O1 + (size_t)(u.pn - t1) * BM * EB; ldc = ld1; rope = (rope_mask & 2) != 0; }
        else { ob = (char*)O2 + (size_t)(u.pn - t2) * BM * EB; ldc = ld2; rope = (rope_mask & 4) != 0; }
        char* base = ob + (size_t)u.pm * BM * ldc * EB;
        const unsigned off0 = (unsigned)((wr * 64 + fr) * ldc + wc * 32 + 8 * fq) * EB;
        const int row0 = u.pm * BM + wr * 64 + fr;
        const int pos0 = ((u.pm * BM) & 4095) + wr * 64 + fr;
        const unsigned toff0 = (unsigned)(pos0 * jn + ((wc * 16 + 4 * fq) & (jn - 1))) * 4u;
        float rsv[2][4]; f32x4 cv[2][4], sv[2][4];
#pragma unroll
        for (int ai = 0; ai < 2; ++ai)
#pragma unroll
            for (int m = 0; m < 4; ++m) { rsv[ai][m] = rstd_of(this->rs, row0 + ai * HALF + m * 16) * osc;
                cv[ai][m] = (f32x4){1.f, 1.f, 1.f, 1.f}; sv[ai][m] = (f32x4){0.f, 0.f, 0.f, 0.f};
                if (rope) { const unsigned toff = toff0 + (unsigned)((ai * HALF + m * 16) * jn) * 4u; cv[ai][m] = *(const f32x4*)((const char*)cs + toff); sv[ai][m] = *(const f32x4*)((const char*)sn + toff); } }
#pragma unroll
        for (int ai = 0; ai < 2; ++ai)
#pragma unroll
            for (int m = 0; m < 4; ++m) { const unsigned off = off0 + (unsigned)((ai * HALF + m * 16) * ldc) * EB;
                const float rs = rsv[ai][m]; const f32x4 c = cv[ai][m] * rs, s = sv[ai][m] * rs;
#pragma unroll
                for (int bj = 0; bj < 2; ++bj) { const f32x4 v0 = acc[ai][bj][m][0], v1 = acc[ai][bj][m][1];
                    const float a0 = v0[0] * c[0] - v0[1] * s[0], b0 = v0[1] * c[0] + v0[0] * s[0];
                    const float a1 = v0[2] * c[1] - v0[3] * s[1], b1 = v0[3] * c[1] + v0[2] * s[1];
                    const float a2 = v1[0] * c[2] - v1[1] * s[2], b2 = v1[1] * c[2] + v1[0] * s[2];
                    const float a3 = v1[2] * c[3] - v1[3] * s[3], b3 = v1[3] * c[3] + v1[2] * s[3];
                    if constexpr (F8OUT) { u32x2 w8; w8.x = cvt_pk4_f8(a0, b0, a1, b1); w8.y = cvt_pk4_f8(a2, b2, a3, b3); *(u32x2*)(base + off + bj * HALF) = w8; }
                    else { u32x4 w; w.x = cvt_pk_bf16(a0, b0); w.y = cvt_pk_bf16(a1, b1); w.z = cvt_pk_bf16(a2, b2); w.w = cvt_pk_bf16(a3, b3);
                    *(u32x4*)(base + off + bj * HALF * 2) = w; } } }
    }
};
typedef EpiRopeT<false> EpiRope;

struct EpiKV8 {
    static constexpr bool PERM = true, AFTER_DRAIN = false, APERM = true; static constexpr int SMIN = 0;
    unsigned char* KN8; unsigned char* VT8; const float* rs; float ksc;
    __device__ __forceinline__ void operator()(const f32x4 (&acc)[2][2][4][2], const Unit& u, int wr, int wc, int fr, int fq) const {
        const int b = (u.pm * BM) >> 12, tile0 = ((u.pm * BM) & 4095) >> 6;
        f32x4 s4[2];
#pragma unroll
        for (int ai = 0; ai < 2; ++ai) s4[ai] = *(const f32x4*)(this->rs + u.pm * BM + ai * HALF + wr * 64 + 4 * fr);
        if (u.pn < 8) {
            const int d0 = wc * 32 + 8 * fq;
#pragma unroll
            for (int ai = 0; ai < 2; ++ai)
#pragma unroll
                for (int bj = 0; bj < 2; ++bj) { unsigned char* img = KN8 + ((size_t)((b * 16 + 2 * u.pn + bj) * 64 + tile0 + 2 * ai + wr)) * 8192;
#pragma unroll
                    for (int m = 0; m < 4; ++m) { const int kk = 4 * fr + m; const float rs = s4[ai][m] * ksc;
                        const f32x4 v0 = acc[ai][bj][m][0] * rs, v1 = acc[ai][bj][m][1] * rs;
                        u32x2 w; w.x = cvt_pk4_f8(v0[0], v0[1], v0[2], v0[3]); w.y = cvt_pk4_f8(v1[0], v1[1], v1[2], v1[3]);
                        *(u32x2*)(img + kk * 128 + (((d0 & ~15) ^ (((kk >> 1) & 7) << 4)) | (d0 & 15))) = w; } }
        } else {
#pragma unroll
            for (int ai = 0; ai < 2; ++ai)
#pragma unroll
                for (int bj = 0; bj < 2; ++bj) { unsigned char* img = VT8 + ((size_t)((b * 16 + 2 * (u.pn - 8) + bj) * 64 + tile0 + 2 * ai + wr)) * 8192;
#pragma unroll
                    for (int n = 0; n < 2; ++n)
#pragma unroll
                        for (int e = 0; e < 4; ++e) { const int vcol = wc * 32 + 8 * fq + 4 * n + e;
                            const unsigned w = cvt_pk4_f8(acc[ai][bj][0][n][e] * s4[ai][0], acc[ai][bj][1][n][e] * s4[ai][1], acc[ai][bj][2][n][e] * s4[ai][2], acc[ai][bj][3][n][e] * s4[ai][3]);
                            *(unsigned*)(img + vcol * 64 + ((((fr >> 2) ^ ((vcol >> 2) & 3))) << 4) + 4 * (fr & 3)) = w; } }
        }
    }
};

struct EpiBwin {
    static constexpr bool PERM = true, AFTER_DRAIN = false, APERM = false; static constexpr int SMIN = 0;
    bf16_t* CQ; bf16_t* CKV; bf16_t* KR; float* ssp; const float* cs; const float* sn; const float* rs; float krsc; float asc;
    __device__ __forceinline__ void operator()(const f32x4 (&acc)[2][2][4][2], const Unit& u, int wr, int wc, int fr, int fq) const {
        const int row0 = u.pm * BM + wr * 64 + fr;
        if (u.pn < 4) {
            char* ob = (char*)(u.pn < 2 ? CQ : CKV) + (size_t)(u.pn & 1) * BM; float* sso = ssp + u.pn * 4 + wc;
            char* base = ob + (size_t)u.pm * BM * 512;
            const unsigned off0 = (unsigned)((wr * 64 + fr) * 512 + wc * 32 + 8 * fq);
#pragma unroll
            for (int ai = 0; ai < 2; ++ai)
#pragma unroll
                for (int m = 0; m < 4; ++m) { const unsigned off = off0 + (unsigned)((ai * HALF + m * 16) * 512); const int row = row0 + ai * HALF + m * 16;
                    const float rs = rstd_of(this->rs, row) * asc; float sq = 0.f;
#pragma unroll
                    for (int bj = 0; bj < 2; ++bj) { const f32x4 v0 = acc[ai][bj][m][0] * rs, v1 = acc[ai][bj][m][1] * rs;
                        sq += (v0[0] * v0[0] + v0[1] * v0[1]) + (v0[2] * v0[2] + v0[3] * v0[3]) + (v1[0] * v1[0] + v1[1] * v1[1]) + (v1[2] * v1[2] + v1[3] * v1[3]);
                        u32x2 w; w.x = cvt_pk4_f8(v0[0], v0[1], v0[2], v0[3]); w.y = cvt_pk4_f8(v1[0], v1[1], v1[2], v1[3]);
                        *(u32x2*)(base + off + bj * HALF) = w; }
                    sq = fq_sum(sq);
                    if (fq == 0) sso[(size_t)row * 16] = sq; }
        } else if (wc < 2) {
            const int pos0 = ((u.pm * BM) & 4095) + wr * 64 + fr;
            const unsigned toff0 = (unsigned)(pos0 * 32 + wc * 16 + 4 * fq) * 4u;
#pragma unroll
            for (int ai = 0; ai < 2; ++ai)
#pragma unroll
                for (int m = 0; m < 4; ++m) { const int row = row0 + ai * HALF + m * 16; const float rs = rstd_of(this->rs, row) * (krsc * asc);
                    const unsigned toff = toff0 + (unsigned)((ai * HALF + m * 16) * 32) * 4u;
                    const f32x4 c = *(const f32x4*)((const char*)cs + toff) * rs, s = *(const f32x4*)((const char*)sn + toff) * rs;
                    const f32x4 v0 = acc[ai][0][m][0], v1 = acc[ai][0][m][1];
                    const float a0 = v0[0] * c[0] - v0[1] * s[0], b0 = v0[1] * c[0] + v0[0] * s[0];
                    const float a1 = v0[2] * c[1] - v0[3] * s[1], b1 = v0[3] * c[1] + v0[2] * s[1];
                    const float a2 = v1[0] * c[2] - v1[1] * s[2], b2 = v1[1] * c[2] + v1[0] * s[2];
                    const float a3 = v1[2] * c[3] - v1[3] * s[3], b3 = v1[3] * c[3] + v1[2] * s[3];
                    const int kk = row & 63, d0 = wc * 32 + 8 * fq; u32x2 w; w.x = cvt_pk4_f8(a0, b0, a1, b1); w.y = cvt_pk4_f8(a2, b2, a3, b3);
                    *(u32x2*)((char*)KR + (size_t)(row >> 6) * 4096 + kk * 64 + (((d0 & ~15) ^ (((kk >> 2) & 3) << 4)) | (d0 & 15))) = w; }
        }
    }
};

struct EpiResid {
    static constexpr bool PERM = true, AFTER_DRAIN = false, APERM = false; static constexpr int SMIN = 0;
    const float* base0; const float* base1; int split_pm; bf16_t* xb; float* outf; float* ssp; int ldc; float scale; unsigned char* xb8;
    __device__ __forceinline__ void operator()(const f32x4 (&acc)[2][2][4][2], const Unit& u, int wr, int wc, int fr, int fq) const {
        const int col0 = u.pn * BM + wc * 32 + 8 * fq;
        const float* base = base0 ? (u.pm < split_pm ? base0 : base1 - (size_t)split_pm * BM * ldc) : nullptr;
        if (base) {
#pragma unroll
            for (int ai = 0; ai < 2; ++ai)
#pragma unroll
                for (int m = 0; m < 4; ++m) { const int row = u.pm * BM + ai * HALF + wr * 64 + m * 16 + fr; const size_t off = (size_t)row * ldc + col0;
                    f32x4 o0[2], o1[2];
#pragma unroll
                    for (int bj = 0; bj < 2; ++bj) { o0[bj] = *(const f32x4*)(base + off + bj * HALF); o1[bj] = *(const f32x4*)(base + off + bj * HALF + 4); }
                    float sq = 0.f;
#pragma unroll
                    for (int bj = 0; bj < 2; ++bj) { const f32x4 v0 = o0[bj] + acc[ai][bj][m][0] * scale, v1 = o1[bj] + acc[ai][bj][m][1] * scale;
                        sq += (v0[0] * v0[0] + v0[1] * v0[1]) + (v0[2] * v0[2] + v0[3] * v0[3]) + (v1[0] * v1[0] + v1[1] * v1[1]) + (v1[2] * v1[2] + v1[3] * v1[3]);
                        u32x4 w; w.x = cvt_pk_bf16(v0[0], v0[1]); w.y = cvt_pk_bf16(v0[2], v0[3]); w.z = cvt_pk_bf16(v1[0], v1[1]); w.w = cvt_pk_bf16(v1[2], v1[3]); *(u32x4*)(xb + off + bj * HALF) = w; }
                    sq = fq_sum(sq);
                    if (fq == 0) ssp[(size_t)row * 32 + u.pn * 4 + wc] = sq;
                    if (m & 1) asm volatile("" ::: "memory"); }
        } else {
            u32x4 ow[2][4][2];
#pragma unroll
            for (int ai = 0; ai < 2; ++ai)
#pragma unroll
                for (int m = 0; m < 4; ++m) { const size_t off = (size_t)(u.pm * BM + ai * HALF + wr * 64 + m * 16 + fr) * ldc + col0;
#pragma unroll
                    for (int bj = 0; bj < 2; ++bj) ow[ai][m][bj] = *(const u32x4*)(xb + off + bj * HALF); }
#pragma unroll
            for (int ai = 0; ai < 2; ++ai)
#pragma unroll
                for (int m = 0; m < 4; ++m) { const int row = u.pm * BM + ai * HALF + wr * 64 + m * 16 + fr; const size_t off = (size_t)row * ldc + col0;
                    float sq = 0.f;
#pragma unroll
                    for (int bj = 0; bj < 2; ++bj) { const u32x4 w0 = ow[ai][m][bj];
                        const f32x4 o0 = (f32x4){__uint_as_float(w0.x << 16), __uint_as_float(w0.x & 0xffff0000u), __uint_as_float(w0.y << 16), __uint_as_float(w0.y & 0xffff0000u)};
                        const f32x4 o1 = (f32x4){__uint_as_float(w0.z << 16), __uint_as_float(w0.z & 0xffff0000u), __uint_as_float(w0.w << 16), __uint_as_float(w0.w & 0xffff0000u)};
                        const f32x4 v0 = o0 + acc[ai][bj][m][0] * scale, v1 = o1 + acc[ai][bj][m][1] * scale;
                        sq += (v0[0] * v0[0] + v0[1] * v0[1]) + (v0[2] * v0[2] + v0[3] * v0[3]) + (v1[0] * v1[0] + v1[1] * v1[1]) + (v1[2] * v1[2] + v1[3] * v1[3]);
                        if (outf) { *(f32x4*)(outf + off + bj * HALF) = v0; *(f32x4*)(outf + off + bj * HALF + 4) = v1; }
                        else { u32x4 w; w.x = cvt_pk_bf16(v0[0], v0[1]); w.y = cvt_pk_bf16(v0[2], v0[3]); w.z = cvt_pk_bf16(v1[0], v1[1]); w.w = cvt_pk_bf16(v1[2], v1[3]); *(u32x4*)(xb + off + bj * HALF) = w; }
                        if (xb8) { u32x2 w8; w8.x = cvt_pk4_f8(v0[0], v0[1], v0[2], v0[3]); w8.y = cvt_pk4_f8(v1[0], v1[1], v1[2], v1[3]); *(u32x2*)(xb8 + off + bj * HALF) = w8; } }
                    sq = fq_sum(sq);
                    if (fq == 0) ssp[(size_t)row * 32 + u.pn * 4 + wc] = sq; }
        }
    }
};

#ifndef ACT_NT
#define ACT_NT 0
#endif
template <int PMODE = 0>
struct EpiConvT {
    static constexpr bool PERM = true, AFTER_DRAIN = false, APERM = true; static constexpr int SMIN = PMODE == 0 ? 8 : 0;
    bf16_t* ACT; float* HALO; const float* cw; const float* cb; PG8_LAS float* xch; int dff; const float* rs;
    __device__ __forceinline__ void operator()(f32x4 (&acc)[2][2][4][2], const Unit& u, int wr, int wc, int fr, int fq) const {
        const int wid = wr * 4 + wc, dff2 = 2 * dff;
        f32x4 pw[2][8];
#pragma unroll
        for (int n = 0; n < 2; ++n) { const int gcol = u.pn * HALF + wc * 32 + 8 * fq + 4 * n, ucol = dff + gcol;
            pw[n][0] = *(const f32x4*)(cw + gcol); pw[n][1] = *(const f32x4*)(cw + dff2 + gcol); pw[n][2] = *(const f32x4*)(cw + 2 * dff2 + gcol); pw[n][3] = *(const f32x4*)(cb + gcol);
            pw[n][4] = *(const f32x4*)(cw + ucol); pw[n][5] = *(const f32x4*)(cw + dff2 + ucol); pw[n][6] = *(const f32x4*)(cw + 2 * dff2 + ucol); pw[n][7] = *(const f32x4*)(cb + ucol); }
#pragma unroll
        for (int ai = 0; ai < 2; ++ai) { const f32x4 s4 = *(const f32x4*)(this->rs + u.pm * BM + ai * HALF + wr * 64 + 4 * fr);
#pragma unroll
            for (int m = 0; m < 4; ++m) { const float rs = s4[m];
#pragma unroll
                for (int bj = 0; bj < 2; ++bj)
#pragma unroll
                    for (int n = 0; n < 2; ++n) acc[ai][bj][m][n] = acc[ai][bj][m][n] * rs; } }
        PG8_LAS float* mine = xch + wid * 256;
        if (fr == 0) {
#pragma unroll
            for (int ai = 0; ai < 2; ++ai)
#pragma unroll
                for (int bj = 0; bj < 2; ++bj)
#pragma unroll
                    for (int n = 0; n < 2; ++n) *(PG8_LAS f32x4*)(mine + (ai * 2 + 0) * 64 + bj * 32 + 8 * fq + 4 * n) = acc[ai][bj][0][n];
            if (PMODE == 0 && wr == 0) {
                float* hp = HALO + ((size_t)u.pm * 4) * dff2 + u.pn * BM + wc * 32 + 8 * fq;
#pragma unroll
                for (int bj = 0; bj < 2; ++bj)
#pragma unroll
                    for (int n = 0; n < 2; ++n) { *(f32x4*)(hp + bj * HALF + 4 * n) = acc[0][bj][0][n]; *(f32x4*)(hp + dff2 + bj * HALF + 4 * n) = acc[0][bj][1][n]; }
            }
        }
        if (fr == 15) {
#pragma unroll
            for (int ai = 0; ai < 2; ++ai)
#pragma unroll
                for (int bj = 0; bj < 2; ++bj)
#pragma unroll
                    for (int n = 0; n < 2; ++n) *(PG8_LAS f32x4*)(mine + (ai * 2 + 1) * 64 + bj * 32 + 8 * fq + 4 * n) = acc[ai][bj][3][n];
            if (PMODE == 0 && wr == 1) {
                float* hp = HALO + ((size_t)u.pm * 4 + 2) * dff2 + u.pn * BM + wc * 32 + 8 * fq;
#pragma unroll
                for (int bj = 0; bj < 2; ++bj)
#pragma unroll
                    for (int n = 0; n < 2; ++n) { *(f32x4*)(hp + bj * HALF + 4 * n) = acc[1][bj][2][n]; *(f32x4*)(hp + dff2 + bj * HALF + 4 * n) = acc[1][bj][3][n]; }
            }
        }
        if (PMODE != 1) { asm volatile("s_waitcnt lgkmcnt(0)" ::: "memory"); __builtin_amdgcn_s_barrier(); asm volatile("" ::: "memory"); }
        const PG8_LAS float* oth = xch + ((wr ^ 1) * 4 + wc) * 256;
        const f32x4 zero4 = (f32x4){0.f, 0.f, 0.f, 0.f};
#define PG8_DPP(x, ctrl) __builtin_bit_cast(float, __builtin_amdgcn_update_dpp(0, __builtin_bit_cast(int, (x)), (ctrl), 0xf, 0xf, true))
#pragma unroll
        for (int ai = 0; ai < 2; ++ai) {
            u32x2 pk[2][4];
#pragma unroll
            for (int n = 0; n < 2; ++n) {
                const int gcol = u.pn * HALF + wc * 32 + 8 * fq + 4 * n, ucol = dff + gcol;
                const f32x4 w0g = pw[n][0], w1g = pw[n][1], w2g = pw[n][2], bg = pw[n][3], w0u = pw[n][4], w1u = pw[n][5], w2u = pw[n][6], bu = pw[n][7];
                const int xo = 8 * fq + 4 * n;
                f32x4 pg = zero4, pu = zero4, ng = zero4, nu = zero4;
                if (PMODE != 1 && fr == 0) {
                    if (wr == 1) { pg = *(const PG8_LAS f32x4*)(oth + (ai * 2 + 1) * 64 + xo); pu = *(const PG8_LAS f32x4*)(oth + (ai * 2 + 1) * 64 + 32 + xo); }
                    else if (ai == 1) { pg = *(const PG8_LAS f32x4*)(oth + (0 * 2 + 1) * 64 + xo); pu = *(const PG8_LAS f32x4*)(oth + (0 * 2 + 1) * 64 + 32 + xo); }
                }
                if (PMODE != 1 && fr == 15) {
                    if (wr == 0) { ng = *(const PG8_LAS f32x4*)(oth + (ai * 2 + 0) * 64 + xo); nu = *(const PG8_LAS f32x4*)(oth + (ai * 2 + 0) * 64 + 32 + xo); }
                    else if (ai == 0) { ng = *(const PG8_LAS f32x4*)(oth + (1 * 2 + 0) * 64 + xo); nu = *(const PG8_LAS f32x4*)(oth + (1 * 2 + 0) * 64 + 32 + xo); }
                }
                f32x4 a[4];
#pragma unroll
                for (int e = 0; e < 4; ++e) {
                    const float g0 = acc[ai][0][0][n][e], g1 = acc[ai][0][1][n][e], g2 = acc[ai][0][2][n][e], g3 = acc[ai][0][3][n][e];
                    const float u0 = acc[ai][1][0][n][e], u1 = acc[ai][1][1][n][e], u2 = acc[ai][1][2][n][e], u3 = acc[ai][1][3][n][e];
                    const float gm = PG8_DPP(g3, 0x111) + pg[e], gp = PG8_DPP(g0, 0x101) + ng[e];
                    const float um = PG8_DPP(u3, 0x111) + pu[e], up = PG8_DPP(u0, 0x101) + nu[e];
                    const float cg0 = w0g[e] * gm + w1g[e] * g0 + w2g[e] * g1 + bg[e], cg1 = w0g[e] * g0 + w1g[e] * g1 + w2g[e] * g2 + bg[e];
                    const float cg2 = w0g[e] * g1 + w1g[e] * g2 + w2g[e] * g3 + bg[e], cg3 = w0g[e] * g2 + w1g[e] * g3 + w2g[e] * gp + bg[e];
                    const float cu0 = w0u[e] * um + w1u[e] * u0 + w2u[e] * u1 + bu[e], cu1 = w0u[e] * u0 + w1u[e] * u1 + w2u[e] * u2 + bu[e];
                    const float cu2 = w0u[e] * u1 + w1u[e] * u2 + w2u[e] * u3 + bu[e], cu3 = w0u[e] * u2 + w1u[e] * u3 + w2u[e] * up + bu[e];
                    a[0][e] = cg0 * __builtin_amdgcn_rcpf(1.0f + __builtin_amdgcn_exp2f(-1.4426950408889634f * cg0)) * cu0;
                    a[1][e] = cg1 * __builtin_amdgcn_rcpf(1.0f + __builtin_amdgcn_exp2f(-1.4426950408889634f * cg1)) * cu1;
                    a[2][e] = cg2 * __builtin_amdgcn_rcpf(1.0f + __builtin_amdgcn_exp2f(-1.4426950408889634f * cg2)) * cu2;
                    a[3][e] = cg3 * __builtin_amdgcn_rcpf(1.0f + __builtin_amdgcn_exp2f(-1.4426950408889634f * cg3)) * cu3;
                }
#pragma unroll
                for (int m = 0; m < 4; ++m) { pk[n][m].x = cvt_pk_bf16(a[m][0], a[m][1]); pk[n][m].y = cvt_pk_bf16(a[m][2], a[m][3]); }
            }
            const int colb = u.pn * HALF + wc * 32 + 8 * fq;
#pragma unroll
            for (int m = 0; m < 4; ++m) { const int row = u.pm * BM + ai * HALF + wr * 64 + 4 * fr + m;
                u32x4 w; w.x = pk[0][m].x; w.y = pk[0][m].y; w.z = pk[1][m].x; w.w = pk[1][m].y;
                if (PMODE != 0) asm volatile("" :: "v"(w)); else if (ACT_NT) __builtin_nontemporal_store(w, (u32x4*)(ACT + (size_t)row * dff + colb)); else *(u32x4*)(ACT + (size_t)row * dff + colb) = w; }
        }
#undef PG8_DPP
    }
};
typedef EpiConvT<0> EpiConv;

struct EpiSum {
    static constexpr bool PERM = true, AFTER_DRAIN = false, APERM = false; static constexpr int SMIN = 0;
    float* dummy;
    __device__ __forceinline__ void operator()(const f32x4 (&acc)[2][2][4][2], const Unit& u, int wr, int wc, int fr, int fq) const {
        f32x4 s = (f32x4){0.f, 0.f, 0.f, 0.f};
#pragma unroll
        for (int ai = 0; ai < 2; ++ai)
#pragma unroll
            for (int bj = 0; bj < 2; ++bj)
#pragma unroll
                for (int m = 0; m < 4; ++m)
#pragma unroll
                    for (int n = 0; n < 2; ++n) s += acc[ai][bj][m][n];
        *(f32x4*)(dummy + (size_t)(blockIdx.x * 512 + (wr * 4 + wc) * 64 + fq * 16 + fr) * 4) = s;
    }
};
typedef int i32x8 __attribute__((ext_vector_type(8)));
typedef int i32x4v __attribute__((ext_vector_type(4)));
__device__ __forceinline__ i32x8 cat8(bf16x8 a, bf16x8 b) { const i32x4v x = __builtin_bit_cast(i32x4v, a), y = __builtin_bit_cast(i32x4v, b); return __builtin_shufflevector(x, y, 0, 1, 2, 3, 4, 5, 6, 7); }
__device__ __forceinline__ void mfma_f8_inplace(f32x4& c, i32x8 a, i32x8 b) { asm volatile("v_mfma_f32_16x16x128_f8f6f4 %0, %1, %2, %0" : "+v"(c) : "v"(a), "v"(b)); }
__device__ __forceinline__ void glds16s(const void* sbase, unsigned voff, unsigned lds_dst) { unsigned keep;
  asm volatile("s_mov_b32 %0, m0\n\ts_mov_b32 m0, %3\n\ts_nop 0\n\tglobal_load_lds_dwordx4 %1, %2\n\ts_mov_b32 m0, %0" : "=&s"(keep) : "v"(voff), "s"(sbase), "s"(lds_dst) : "memory"); }
#ifndef PG8_ASM_STAGE
#define PG8_ASM_STAGE 1
#endif
template <class Epi, class Sched, bool ALIGN_EPI = false, bool SP2 = false, bool F8 = false>
__device__ __forceinline__ void gemm_phase(PG8_LAS unsigned char* lds, const Gemm g, const Sched& S, const Epi& E, int wave_) {
    const int tid = opaque_tid(wave_), wid = __builtin_amdgcn_readfirstlane(tid >> 6), lane = tid & 63, wr = wid >> 2, wc = wid & 3, fr = lane & 15, fq = lane >> 4;
    const int K = g.K, nt = K / BK;
    unsigned voffA[2], voffB[2];
#pragma unroll
    for (int i = 0; i < 2; ++i) { int R, C; stage_rc(tid * 16 + i * 8192, R, C); const int Rb = Epi::PERM ? ((R & ~31) + perm32(R & 31)) : R;
        const int Ra = Epi::APERM ? ((R & ~63) + 4 * (R & 15) + ((R >> 4) & 3)) : R;
        voffA[i] = (unsigned)(Ra * K + C) * 2u; voffB[i] = (unsigned)(Rb * K + C) * 2u; }
    const size_t kstep = (size_t)(BK * 2);
    const size_t hstep = (size_t)HALF * K * 2;
    const size_t tstep = 2 * hstep;
    const unsigned lds0_ = (unsigned)(uintptr_t)lds + (unsigned)wid * 1024u;
    const unsigned ldsw = (unsigned)wid * 1024u;
    const int aoff = lds_byte(wr * 64 + fr, fq * 8), boff = lds_byte(wc * 32 + fr, fq * 8);
#define PG8_SA(b, h) (((b) * 2 + (h)) * HTB)
#define PG8_SB(b, h) ((4 + (b) * 2 + (h)) * HTB)
#define PG8_STAGE(bufoff, gbase, voff) do { _Pragma("unroll") for (int _i = 0; _i < 2; ++_i) { \
        if constexpr (F8 || PG8_ASM_STAGE) glds16s((const void*)(gbase), (voff)[_i], (unsigned)__builtin_amdgcn_readfirstlane((int)(lds0_ + (unsigned)((bufoff) + _i * 8192)))); \
        else __builtin_amdgcn_global_load_lds((const unsigned*)((const char*)(gbase) + (voff)[_i]), (PG8_LAS unsigned*)(lds + (bufoff) + ldsw + _i * 8192), 16, 0, 0); } } while (0)
#define PG8_LDA(dst, b, h) do { _Pragma("unroll") for (int m = 0; m < 4; ++m) _Pragma("unroll") for (int k = 0; k < 2; ++k) dst[m][k] = *(const PG8_LAS bf16x8*)(lds + PG8_SA(b, h) + aoff + m * 2048 + k * 1024); } while (0)
#define PG8_LDB(dst, b, h) do { _Pragma("unroll") for (int n = 0; n < 2; ++n) _Pragma("unroll") for (int k = 0; k < 2; ++k) dst[n][k] = *(const PG8_LAS bf16x8*)(lds + PG8_SB(b, h) + boff + n * 2048 + k * 1024); } while (0)
#define PG8_MMA(ai, bj, At, Bt) do { __builtin_amdgcn_s_setprio(1); _Pragma("unroll") for (int m = 0; m < 4; ++m) _Pragma("unroll") for (int n = 0; n < 2; ++n) { \
        if constexpr (F8) mfma_f8_inplace(acc[ai][bj][m][n], cat8(Bt[n][0], Bt[n][1]), cat8(At[m][0], At[m][1])); \
        else { _Pragma("unroll") for (int k = 0; k < 2; ++k) acc[ai][bj][m][n] = __builtin_amdgcn_mfma_f32_16x16x32_bf16(Bt[n][k], At[m][k], acc[ai][bj][m][n], 0, 0, 0); } } __builtin_amdgcn_s_setprio(0); } while (0)
#define PG8_WAIT_V(n) asm volatile("s_waitcnt vmcnt(" #n ")" ::: "memory")
#define PG8_WAIT_L(n) asm volatile("s_waitcnt lgkmcnt(" #n ")" ::: "memory")
#define PG8_BAR __builtin_amdgcn_s_barrier()
#define PG8_SCHED __builtin_amdgcn_sched_barrier(0)
    Unit cur, nxt; int ui = 0;
    if (!S.next(0, cur)) return;
    f32x4 acc[2][2][4][2];
#pragma unroll
    for (int a = 0; a < 2; ++a)
#pragma unroll
        for (int b = 0; b < 2; ++b)
#pragma unroll
            for (int m = 0; m < 4; ++m)
#pragma unroll
                for (int n = 0; n < 2; ++n) acc[a][b][m][n] = (f32x4){0.f, 0.f, 0.f, 0.f};
    bf16x8 At[4][2], B0[2][2], B1[2][2];
    const char* cA = (const char*)g.A + (size_t)cur.pm * tstep; const char* cB = (const char*)g.Bt + (size_t)cur.pn * tstep;
    S.a_ready(cur);
    if constexpr (SP2) {
        PG8_STAGE(PG8_SB(0, 0), cB, voffB); PG8_STAGE(PG8_SB(0, 1), cB + hstep, voffB); PG8_STAGE(PG8_SA(0, 0), cA, voffA); PG8_STAGE(PG8_SA(0, 1), cA + hstep, voffA);
        if (wr == 1) PG8_BAR;
        PG8_WAIT_V(2); PG8_BAR;
        PG8_STAGE(PG8_SB(1, 0), cB + kstep, voffB); PG8_STAGE(PG8_SA(1, 0), cA + kstep, voffA); PG8_STAGE(PG8_SB(1, 1), cB + hstep + kstep, voffB);
        if constexpr (Epi::SMIN > 0) PG8_WAIT_V(0); else PG8_WAIT_V(6);
        PG8_BAR;
    } else {
        PG8_STAGE(PG8_SB(0, 0), cB, voffB); PG8_STAGE(PG8_SA(0, 0), cA, voffA); PG8_STAGE(PG8_SB(0, 1), cB + hstep, voffB); PG8_STAGE(PG8_SA(0, 1), cA + hstep, voffA);
        if (wr == 1) PG8_BAR;
        PG8_WAIT_V(4); PG8_BAR;
        PG8_STAGE(PG8_SB(1, 0), cB + kstep, voffB); PG8_STAGE(PG8_SA(1, 0), cA + kstep, voffA); PG8_STAGE(PG8_SB(1, 1), cB + hstep + kstep, voffB);
        PG8_WAIT_V(6); PG8_BAR;
    }
    for (;;) {
        const bool has_next = S.next(ui + 1, nxt);
        const char* nA = has_next ? (const char*)g.A + (size_t)nxt.pm * tstep : cA; const char* nB = has_next ? (const char*)g.Bt + (size_t)nxt.pn * tstep : cB;
_Pragma("clang loop unroll(disable)")
        for (int t = 0; t < nt; t += 2) {
            const bool last = (t == nt - 2);
            const char* a1 = cA + (size_t)(t + 1) * kstep;
            const char* a2 = last ? nA : cA + (size_t)(t + 2) * kstep; const char* b2 = last ? nB : cB + (size_t)(t + 2) * kstep;
            const char* a3 = a2 + kstep; const char* b3 = b2 + kstep;
            if (last && has_next) S.a_ready(nxt);
            if constexpr (SP2) {
            const bool post_epi = Epi::SMIN > 0 && t == 0;
            PG8_LDB(B0, 0, 0); PG8_LDB(B1, 0, 1); PG8_SCHED; PG8_LDA(At, 0, 0); PG8_STAGE(PG8_SA(1, 1), a1 + hstep, voffA);
            if (post_epi) asm volatile("s_waitcnt vmcnt(%0)" :: "n"(8 + Epi::SMIN) : "memory"); else PG8_WAIT_V(8);
            PG8_WAIT_L(0); PG8_BAR; PG8_MMA(0, 0, At, B0); PG8_MMA(0, 1, At, B1); PG8_BAR; PG8_SCHED;
            PG8_LDA(At, 0, 1); PG8_STAGE(PG8_SB(0, 0), b2, voffB); PG8_STAGE(PG8_SB(0, 1), b2 + hstep, voffB); PG8_STAGE(PG8_SA(0, 0), a2, voffA);
            if (post_epi) asm volatile("s_waitcnt vmcnt(%0)" :: "n"(8 + Epi::SMIN) : "memory"); else PG8_WAIT_V(8);
            PG8_WAIT_L(0); PG8_BAR; PG8_MMA(1, 0, At, B0); PG8_MMA(1, 1, At, B1); PG8_BAR; PG8_SCHED;
            PG8_LDB(B0, 1, 0); PG8_LDB(B1, 1, 1); PG8_SCHED; PG8_LDA(At, 1, 0); PG8_STAGE(PG8_SA(0, 1), a2 + hstep, voffA);
            PG8_WAIT_V(8); PG8_WAIT_L(0); PG8_BAR; PG8_MMA(0, 0, At, B0); PG8_MMA(0, 1, At, B1); PG8_BAR; PG8_SCHED;
            PG8_LDA(At, 1, 1); PG8_STAGE(PG8_SB(1, 0), b3, voffB); PG8_STAGE(PG8_SB(1, 1), b3 + hstep, voffB); PG8_STAGE(PG8_SA(1, 0), a3, voffA);
            PG8_WAIT_V(8); PG8_WAIT_L(0); PG8_BAR; PG8_MMA(1, 0, At, B0); PG8_MMA(1, 1, At, B1); PG8_BAR; PG8_SCHED;
            } else {
            PG8_LDB(B0, 0, 0); PG8_SCHED; PG8_LDA(At, 0, 0); PG8_STAGE(PG8_SA(1, 1), a1 + hstep, voffA);
            PG8_WAIT_L(8); PG8_BAR; PG8_WAIT_L(0); PG8_MMA(0, 0, At, B0); PG8_BAR; PG8_SCHED;
            PG8_LDB(B1, 0, 1); PG8_STAGE(PG8_SB(0, 0), b2, voffB);
            PG8_BAR; PG8_WAIT_L(0); PG8_MMA(0, 1, At, B1); PG8_BAR;
            PG8_LDA(At, 0, 1); PG8_STAGE(PG8_SA(0, 0), a2, voffA);
            PG8_BAR; PG8_WAIT_L(0); PG8_MMA(1, 0, At, B0); PG8_BAR; PG8_SCHED;
            PG8_STAGE(PG8_SB(0, 1), b2 + hstep, voffB);
            PG8_WAIT_V(6); PG8_BAR; PG8_MMA(1, 1, At, B1); PG8_BAR;
            PG8_LDB(B0, 1, 0); PG8_SCHED; PG8_LDA(At, 1, 0); PG8_STAGE(PG8_SA(0, 1), a2 + hstep, voffA);
            PG8_WAIT_L(8); PG8_BAR; PG8_WAIT_L(0); PG8_MMA(0, 0, At, B0); PG8_BAR; PG8_SCHED;
            PG8_LDB(B1, 1, 1); PG8_STAGE(PG8_SB(1, 0), b3, voffB);
            PG8_BAR; PG8_WAIT_L(0); PG8_MMA(0, 1, At, B1); PG8_BAR;
            PG8_LDA(At, 1, 1); PG8_STAGE(PG8_SA(1, 0), a3, voffA);
            PG8_BAR; PG8_WAIT_L(0); PG8_MMA(1, 0, At, B0); PG8_BAR; PG8_SCHED;
            PG8_STAGE(PG8_SB(1, 1), b3 + hstep, voffB);
            PG8_WAIT_V(6); PG8_BAR; PG8_MMA(1, 1, At, B1); PG8_BAR;
            }
        }
        if constexpr (ALIGN_EPI) { if (wr == 0) PG8_BAR; }
        if constexpr (!Epi::AFTER_DRAIN) { const int te_ = opaque_tid(wave_); const int fr_ = te_ & 15, fq_ = (te_ >> 4) & 3;
            E(acc, cur, wr, wc, fr_, fq_); S.done(cur); }
        if (!has_next) break;
#pragma unroll
        for (int a = 0; a < 2; ++a)
#pragma unroll
            for (int b = 0; b < 2; ++b)
#pragma unroll
                for (int m = 0; m < 4; ++m)
#pragma unroll
                    for (int n = 0; n < 2; ++n) acc[a][b][m][n] = (f32x4){0.f, 0.f, 0.f, 0.f};
        cur = nxt; cA = nA; cB = nB; ++ui;
        if constexpr (ALIGN_EPI) { if (wr == 1) PG8_BAR; }
    }
    PG8_WAIT_V(0);
    if constexpr (!ALIGN_EPI) { if (wr == 0) PG8_BAR; }
    PG8_BAR;
    if constexpr (Epi::AFTER_DRAIN) { E.fused(acc, cur, wr, wc, fr, fq, lds, wid, lane); S.done(cur); }
#undef PG8_SA
#undef PG8_SB
#undef PG8_STAGE
#undef PG8_LDA
#undef PG8_LDB
#undef PG8_MMA
#undef PG8_WAIT_V
#undef PG8_WAIT_L
#undef PG8_BAR
#undef PG8_SCHED
}
}
namespace att {
using bf16 = unsigned short;
using bf16x8 = __attribute__((ext_vector_type(8))) short;
using s16x4  = __attribute__((ext_vector_type(4))) short;
using f32x16 = __attribute__((ext_vector_type(16))) float;
using u32x4  = __attribute__((ext_vector_type(4))) unsigned;
#define ATT_LAS __attribute__((address_space(3)))
#ifndef ATT_PRIO
#define ATT_PRIO 0
#endif
constexpr int D = 128, NW = 8, QBLK = 32, KVBLK = 64;
constexpr float THR = 8.f;
constexpr int SHM_V = KVBLK * D * 2, SHM_K = KVBLK * D * 2, SHM_R = KVBLK * 64 * 2;
constexpr int SHM_ATTN = 3 * (SHM_K + SHM_V + SHM_R) + NW * 64 * 4;
#define KSWZ(row, colB) ((row) * 256 + ((colB) ^ (((row) & 15) << 4)))
#define RSWZ(row, colB) ((row) * 128 + ((colB) ^ ((((row) >> 1) & 7) << 4)))
#define SBAR() __builtin_amdgcn_sched_barrier(0)
__device__ __forceinline__ int crow(int r, int hi) { return (r & 3) + 8 * (r >> 2) + 4 * hi; }
__device__ __forceinline__ unsigned cvtpk(float lo, float hi) { unsigned r; asm volatile("v_cvt_pk_bf16_f32 %0, %1, %2" : "=v"(r) : "v"(lo), "v"(hi)); return r; }

template <int NRB> struct Sc { static constexpr float SCALE = NRB ? 0.07216878364870322f : 0.08838834764831845f; };

template <int NRB> __device__ __forceinline__ void partialSM(f32x16& p0, f32x16& p1, float& m_reg, float& mn, float& alpha) {
  constexpr float SCALE = Sc<NRB>::SCALE, C = SCALE * 1.4426950408889634f;
  float pmax = p0[0];
#pragma unroll
  for (int r = 1; r < 16; ++r) pmax = fmaxf(pmax, p0[r]);
#pragma unroll
  for (int r = 0; r < 16; ++r) pmax = fmaxf(pmax, p1[r]);
  { auto rr = __builtin_amdgcn_permlane32_swap(__float_as_uint(pmax), __float_as_uint(pmax), false, false);
    pmax = fmaxf(__uint_as_float(rr[0]), __uint_as_float(rr[1])); }
  if (__builtin_expect(__all(pmax - m_reg <= THR / SCALE), 1)) { mn = m_reg; alpha = 1.f; }
  else { mn = fmaxf(m_reg, pmax); alpha = __builtin_amdgcn_exp2f((m_reg - mn) * C); m_reg = mn; }
  const float mnC = -mn * C;
#pragma unroll
  for (int r = 0; r < 16; ++r) p0[r] = fmaf(p0[r], C, mnC);
#pragma unroll
  for (int r = 0; r < 16; ++r) p1[r] = fmaf(p1[r], C, mnC);
#pragma unroll
  for (int r = 0; r < 16; ++r) p0[r] = __builtin_amdgcn_exp2f(p0[r]);
}
__device__ __forceinline__ void finishSM(f32x16& p0, f32x16& p1, float alpha, float& l_reg, bf16x8& pa0, bf16x8& pa1, bf16x8& pa2, bf16x8& pa3) {
#pragma unroll
  for (int r = 0; r < 16; ++r) p1[r] = __builtin_amdgcn_exp2f(p1[r]);
  float ps = 0;
#pragma unroll
  for (int r = 0; r < 16; ++r) ps += p0[r];
#pragma unroll
  for (int r = 0; r < 16; ++r) ps += p1[r];
  { auto rr = __builtin_amdgcn_permlane32_swap(__float_as_uint(ps), __float_as_uint(ps), false, false);
    ps = __uint_as_float(rr[0]) + __uint_as_float(rr[1]); }
  l_reg = l_reg * alpha + ps;
#define PK4(P, BASE, OUT) do { unsigned a0 = cvtpk(P[BASE + 0], P[BASE + 1]), a1 = cvtpk(P[BASE + 2], P[BASE + 3]);   \
    unsigned b0 = cvtpk(P[BASE + 4], P[BASE + 5]), b1 = cvtpk(P[BASE + 6], P[BASE + 7]);                              \
    auto r0 = __builtin_amdgcn_permlane32_swap(a0, b0, false, false); auto r1 = __builtin_amdgcn_permlane32_swap(a1, b1, false, false); \
    u32x4 w = {r0[0], r1[0], r0[1], r1[1]}; OUT = *reinterpret_cast<bf16x8*>(&w); } while (0)
  PK4(p0, 0, pa0); PK4(p0, 8, pa1); PK4(p1, 0, pa2); PK4(p1, 8, pa3);
#undef PK4
}
template <int NRB> __device__ __forceinline__ void qkt(f32x16& p0, f32x16& p1, const ATT_LAS char* Ks, const ATT_LAS char* Rs, const bf16x8* qr, int r32, int hi) {
  asm volatile("" : "+v"(r32));
  p0 = f32x16{}; p1 = f32x16{};
#pragma unroll
  for (int d0 = 0; d0 < 8; ++d0) { const int cb = (d0 * 16 + hi * 8) * 2;
    const bf16x8 b0 = *reinterpret_cast<const ATT_LAS bf16x8*>(Ks + KSWZ(r32, cb));
    const bf16x8 b1 = *reinterpret_cast<const ATT_LAS bf16x8*>(Ks + KSWZ(32 + r32, cb));
    p0 = __builtin_amdgcn_mfma_f32_32x32x16_bf16(b0, qr[d0], p0, 0, 0, 0);
    p1 = __builtin_amdgcn_mfma_f32_32x32x16_bf16(b1, qr[d0], p1, 0, 0, 0); }
#pragma unroll
  for (int d0 = 0; d0 < NRB; ++d0) { const int cb = (d0 * 16 + hi * 8) * 2;
    const bf16x8 b0 = *reinterpret_cast<const ATT_LAS bf16x8*>(Rs + RSWZ(r32, cb));
    const bf16x8 b1 = *reinterpret_cast<const ATT_LAS bf16x8*>(Rs + RSWZ(32 + r32, cb));
    p0 = __builtin_amdgcn_mfma_f32_32x32x16_bf16(b0, qr[8 + d0], p0, 0, 0, 0);
    p1 = __builtin_amdgcn_mfma_f32_32x32x16_bf16(b1, qr[8 + d0], p1, 0, 0, 0); }
}
__device__ __forceinline__ void wmask(f32x16& p0, f32x16& p1, int j, int qrel, int hi) {
  const int base = 64 * j + 4 * hi - qrel + 128;
#pragma unroll
  for (int r = 0; r < 16; ++r) { const int d = base + (r & 3) + 8 * (r >> 2);
    if ((unsigned)d > 256u) p0[r] = -1e30f;
    if ((unsigned)(d + 32) > 256u) p1[r] = -1e30f; }
}
__device__ __forceinline__ int v_st(int k, int c) { const int kk = (k & ~0xC) | ((k & 4) << 1) | ((k & 8) >> 1); return ((kk >> 3) * 4 + (c >> 5)) * 512 + ((kk & 7) * 32 + (c & 31)) * 2; }
__device__ __forceinline__ int v_rd_base(int lane) { return ((lane & 3) << 3) | (((lane >> 2) & 3) << 6) | (((lane >> 4) & 1) << 5) | (((lane >> 5) & 1) << 8); }
constexpr int v_rd_off(int d0, int ks, int half) { return d0 * 512 + ks * 4096 + half * 2048; }
template <int OFF> __device__ __forceinline__ s16x4 tr_read(int vb) {
  s16x4 r; asm volatile("ds_read_b64_tr_b16 %0, %1 offset:%2" : "=&v"(r) : "v"(vb), "i"(OFF) : "memory"); return r;
}
template <int D0> __device__ __forceinline__ void pv_one(f32x16& od, int vb, bf16x8 pa0, bf16x8 pa1, bf16x8 pa2, bf16x8 pa3) {
  const s16x4 l0 = tr_read<v_rd_off(D0, 0, 0)>(vb), h0 = tr_read<v_rd_off(D0, 0, 1)>(vb), l1 = tr_read<v_rd_off(D0, 1, 0)>(vb), h1 = tr_read<v_rd_off(D0, 1, 1)>(vb);
  const s16x4 l2 = tr_read<v_rd_off(D0, 2, 0)>(vb), h2 = tr_read<v_rd_off(D0, 2, 1)>(vb), l3 = tr_read<v_rd_off(D0, 3, 0)>(vb), h3 = tr_read<v_rd_off(D0, 3, 1)>(vb);
  asm volatile("s_waitcnt lgkmcnt(0)" ::: "memory"); SBAR();
#define PK(L, H) (bf16x8){L[0], L[1], L[2], L[3], H[0], H[1], H[2], H[3]}
  od = __builtin_amdgcn_mfma_f32_32x32x16_bf16(pa0, PK(l0, h0), od, 0, 0, 0);
  od = __builtin_amdgcn_mfma_f32_32x32x16_bf16(pa1, PK(l1, h1), od, 0, 0, 0);
  od = __builtin_amdgcn_mfma_f32_32x32x16_bf16(pa2, PK(l2, h2), od, 0, 0, 0);
  od = __builtin_amdgcn_mfma_f32_32x32x16_bf16(pa3, PK(l3, h3), od, 0, 0, 0);
#undef PK
}
__device__ __forceinline__ void pv_d0(f32x16* o, int vb, bf16x8 pa0, bf16x8 pa1, bf16x8 pa2, bf16x8 pa3) {
  pv_one<0>(o[0], vb, pa0, pa1, pa2, pa3); pv_one<1>(o[1], vb, pa0, pa1, pa2, pa3); pv_one<2>(o[2], vb, pa0, pa1, pa2, pa3); pv_one<3>(o[3], vb, pa0, pa1, pa2, pa3);
}

template <int NRB, int MODE> __device__ __forceinline__ void seg1_fused(f32x16& c0, f32x16& c1, const ATT_LAS char* Ks, const ATT_LAS char* Rs, const bf16x8* qr, int r32, int hi,
                                                              f32x16& p0, f32x16& p1, float alP, float& l_reg, bf16x8& pa0, bf16x8& pa1, bf16x8& pa2, bf16x8& pa3) {
  constexpr int DB = 8 + NRB;
  asm volatile("" : "+v"(r32));
  c0 = f32x16{}; c1 = f32x16{};
  float ps0 = 0.f, ps1 = 0.f;
#define KADDR(d0, half) ((d0) < 8 ? (Ks + KSWZ((half) * 32 + r32, ((d0) * 16 + hi * 8) * 2)) : (Rs + RSWZ((half) * 32 + r32, (((d0) - 8) * 16 + hi * 8) * 2)))
#define PK4(P, BASE, OUT) do { unsigned a0_ = cvtpk(P[BASE + 0], P[BASE + 1]), a1_ = cvtpk(P[BASE + 2], P[BASE + 3]);   \
    unsigned b0_ = cvtpk(P[BASE + 4], P[BASE + 5]), b1_ = cvtpk(P[BASE + 6], P[BASE + 7]);                              \
    auto r0_ = __builtin_amdgcn_permlane32_swap(a0_, b0_, false, false); auto r1_ = __builtin_amdgcn_permlane32_swap(a1_, b1_, false, false); \
    u32x4 w_ = {r0_[0], r1_[0], r0_[1], r1_[1]}; OUT = *reinterpret_cast<bf16x8*>(&w_); } while (0)
#define EX2(i) do { p1[i] = __builtin_amdgcn_exp2f(p1[i]); p1[(i) + 1] = __builtin_amdgcn_exp2f(p1[(i) + 1]); } while (0)
#define SUM4(acc_, P, i) do { acc_ += (P[i] + P[(i) + 1]) + (P[(i) + 2] + P[(i) + 3]); } while (0)
  bf16x8 kf[2][2];
  kf[0][0] = *reinterpret_cast<const ATT_LAS bf16x8*>(KADDR(0, 0)); kf[0][1] = *reinterpret_cast<const ATT_LAS bf16x8*>(KADDR(0, 1));
#pragma unroll
  for (int d0 = 0; d0 < DB; ++d0) {
    if (MODE != 2) if (d0 + 1 < DB) { kf[(d0 + 1) & 1][0] = *reinterpret_cast<const ATT_LAS bf16x8*>(KADDR(d0 + 1, 0)); kf[(d0 + 1) & 1][1] = *reinterpret_cast<const ATT_LAS bf16x8*>(KADDR(d0 + 1, 1)); }
    if (MODE != 3) { c0 = __builtin_amdgcn_mfma_f32_32x32x16_bf16(kf[MODE == 2 ? 0 : (d0 & 1)][0], qr[d0], c0, 0, 0, 0);
    c1 = __builtin_amdgcn_mfma_f32_32x32x16_bf16(kf[MODE == 2 ? 0 : (d0 & 1)][1], qr[d0], c1, 0, 0, 0); }
    else { asm volatile("" :: "v"(kf[d0 & 1][0]), "v"(kf[d0 & 1][1])); }
    if (MODE != 1) {
    if (d0 == 0) { EX2(0); SUM4(ps0, p0, 0); }
    if (d0 == 1) { EX2(2); SUM4(ps0, p0, 4); PK4(p0, 0, pa0); }
    if (d0 == 2) { EX2(4); SUM4(ps0, p0, 8); }
    if (d0 == 3) { EX2(6); SUM4(ps0, p0, 12); PK4(p0, 8, pa1); }
    if (d0 == 4) { EX2(8); SUM4(ps1, p1, 0); }
    if (d0 == 5) { EX2(10); SUM4(ps1, p1, 4); PK4(p1, 0, pa2); }
    if (d0 == 6) { EX2(12); SUM4(ps1, p1, 8); }
    if (d0 == 7) { EX2(14); SUM4(ps1, p1, 12); }
    if (d0 == (DB > 8 ? 8 : 7)) { PK4(p1, 8, pa3); float ps = ps0 + ps1;
      { auto rr = __builtin_amdgcn_permlane32_swap(__float_as_uint(ps), __float_as_uint(ps), false, false); ps = __uint_as_float(rr[0]) + __uint_as_float(rr[1]); }
      l_reg = l_reg * alP + ps; }
    }
    SBAR();
  }
#undef KADDR
#undef PK4
#undef EX2
#undef SUM4
}
template <int NRB, int MODE> __device__ __forceinline__ void seg2_fused(f32x16* o, int vb, bf16x8 pa0, bf16x8 pa1, bf16x8 pa2, bf16x8 pa3,
                                                              f32x16& c0, f32x16& c1, float& m_reg, float& alpha) {
  constexpr float SCALE = Sc<NRB>::SCALE, C = SCALE * 1.4426950408889634f;
  s16x4 vl[4], vh[4];
#define VRD(D0) do { vl[0] = tr_read<v_rd_off(D0, 0, 0)>(vb); vh[0] = tr_read<v_rd_off(D0, 0, 1)>(vb); vl[1] = tr_read<v_rd_off(D0, 1, 0)>(vb); vh[1] = tr_read<v_rd_off(D0, 1, 1)>(vb); \
    vl[2] = tr_read<v_rd_off(D0, 2, 0)>(vb); vh[2] = tr_read<v_rd_off(D0, 2, 1)>(vb); vl[3] = tr_read<v_rd_off(D0, 3, 0)>(vb); vh[3] = tr_read<v_rd_off(D0, 3, 1)>(vb); } while (0)
#define PKV(k) (bf16x8){vl[k][0], vl[k][1], vl[k][2], vl[k][3], vh[k][0], vh[k][1], vh[k][2], vh[k][3]}
#define MX4(x, P, i) do { x = fmaxf(fmaxf(x, P[i]), fmaxf(P[(i) + 1], fmaxf(P[(i) + 2], P[(i) + 3]))); } while (0)
#define VWAIT() do { asm volatile("s_waitcnt lgkmcnt(0)" ::: "memory"); SBAR(); } while (0)
  float mxa = c0[0], mxb = c1[0], mnC = 0.f;
  if (MODE != 2) VRD(0); VWAIT();
  if (MODE != 3) { o[0] = __builtin_amdgcn_mfma_f32_32x32x16_bf16(pa0, PKV(0), o[0], 0, 0, 0); } if (MODE != 1) { MX4(mxa, c0, 0); } if (MODE != 1) { MX4(mxb, c1, 0); } SBAR();
  if (MODE != 3) { o[0] = __builtin_amdgcn_mfma_f32_32x32x16_bf16(pa1, PKV(1), o[0], 0, 0, 0); } if (MODE != 1) { MX4(mxa, c0, 4); } if (MODE != 1) { MX4(mxb, c1, 4); } SBAR();
  if (MODE != 3) { o[0] = __builtin_amdgcn_mfma_f32_32x32x16_bf16(pa2, PKV(2), o[0], 0, 0, 0); } if (MODE != 1) { MX4(mxa, c0, 8); } if (MODE != 1) { MX4(mxb, c1, 8); } SBAR();
  if (MODE != 3) { o[0] = __builtin_amdgcn_mfma_f32_32x32x16_bf16(pa3, PKV(3), o[0], 0, 0, 0); } SBAR();
  if (MODE != 2) VRD(1); if (MODE != 1) { MX4(mxa, c0, 12); } if (MODE != 1) { MX4(mxb, c1, 12); }
  if (MODE == 1) { alpha = 1.f; } else { float pmax = fmaxf(mxa, mxb); auto rr = __builtin_amdgcn_permlane32_swap(__float_as_uint(pmax), __float_as_uint(pmax), false, false);
    pmax = fmaxf(__uint_as_float(rr[0]), __uint_as_float(rr[1]));
    const bool anyx = __any(pmax - m_reg > THR / SCALE);
    const float mn = anyx ? fmaxf(m_reg, pmax) : m_reg; alpha = __builtin_amdgcn_exp2f((m_reg - mn) * C); m_reg = mn; mnC = -mn * C; }
  VWAIT();
  if (MODE != 3) { o[1] = __builtin_amdgcn_mfma_f32_32x32x16_bf16(pa0, PKV(0), o[1], 0, 0, 0); }
  if (MODE != 1) { _Pragma("unroll") for (int r = 0; r < 8; ++r) c0[r] = fmaf(c0[r], C, mnC); }
  SBAR();
  if (MODE != 3) { o[1] = __builtin_amdgcn_mfma_f32_32x32x16_bf16(pa1, PKV(1), o[1], 0, 0, 0); }
  if (MODE != 1) { _Pragma("unroll") for (int r = 8; r < 16; ++r) c0[r] = fmaf(c0[r], C, mnC); }
  SBAR();
  if (MODE != 3) { o[1] = __builtin_amdgcn_mfma_f32_32x32x16_bf16(pa2, PKV(2), o[1], 0, 0, 0); }
  if (MODE != 1) { _Pragma("unroll") for (int r = 0; r < 8; ++r) c1[r] = fmaf(c1[r], C, mnC); }
  SBAR();
  if (MODE != 3) { o[1] = __builtin_amdgcn_mfma_f32_32x32x16_bf16(pa3, PKV(3), o[1], 0, 0, 0); } SBAR();
  if (MODE != 2) VRD(2);
  if (MODE != 1) { _Pragma("unroll") for (int r = 8; r < 16; ++r) c1[r] = fmaf(c1[r], C, mnC); }
  VWAIT();
  if (MODE != 3) { o[2] = __builtin_amdgcn_mfma_f32_32x32x16_bf16(pa0, PKV(0), o[2], 0, 0, 0); }
  if (MODE != 1) { _Pragma("unroll") for (int r = 0; r < 2; ++r) c0[r] = __builtin_amdgcn_exp2f(c0[r]); }
  SBAR();
  if (MODE != 3) { o[2] = __builtin_amdgcn_mfma_f32_32x32x16_bf16(pa1, PKV(1), o[2], 0, 0, 0); }
  if (MODE != 1) { _Pragma("unroll") for (int r = 2; r < 4; ++r) c0[r] = __builtin_amdgcn_exp2f(c0[r]); }
  SBAR();
  if (MODE != 3) { o[2] = __builtin_amdgcn_mfma_f32_32x32x16_bf16(pa2, PKV(2), o[2], 0, 0, 0); }
  if (MODE != 1) { _Pragma("unroll") for (int r = 4; r < 6; ++r) c0[r] = __builtin_amdgcn_exp2f(c0[r]); }
  SBAR();
  if (MODE != 3) { o[2] = __builtin_amdgcn_mfma_f32_32x32x16_bf16(pa3, PKV(3), o[2], 0, 0, 0); } SBAR();
  if (MODE != 2) VRD(3);
  if (MODE != 1) { _Pragma("unroll") for (int r = 6; r < 9; ++r) c0[r] = __builtin_amdgcn_exp2f(c0[r]); }
  VWAIT();
  if (MODE != 3) { o[3] = __builtin_amdgcn_mfma_f32_32x32x16_bf16(pa0, PKV(0), o[3], 0, 0, 0); }
  if (MODE != 1) { _Pragma("unroll") for (int r = 9; r < 11; ++r) c0[r] = __builtin_amdgcn_exp2f(c0[r]); }
  SBAR();
  if (MODE != 3) { o[3] = __builtin_amdgcn_mfma_f32_32x32x16_bf16(pa1, PKV(1), o[3], 0, 0, 0); }
  if (MODE != 1) { _Pragma("unroll") for (int r = 11; r < 13; ++r) c0[r] = __builtin_amdgcn_exp2f(c0[r]); }
  SBAR();
  if (MODE != 3) { o[3] = __builtin_amdgcn_mfma_f32_32x32x16_bf16(pa2, PKV(2), o[3], 0, 0, 0); }
  if (MODE != 1) { _Pragma("unroll") for (int r = 13; r < 15; ++r) c0[r] = __builtin_amdgcn_exp2f(c0[r]); }
  SBAR();
  if (MODE != 3) { o[3] = __builtin_amdgcn_mfma_f32_32x32x16_bf16(pa3, PKV(3), o[3], 0, 0, 0); }
  if (MODE != 1) c0[15] = __builtin_amdgcn_exp2f(c0[15]);
  SBAR();
#undef VWAIT
#undef VRD
#undef PKV
#undef MX4
}

__device__ __forceinline__ float g_add(float a, float b) { float r; asm("v_add_f32_e32 %0, %1, %2" : "=v"(r) : "v"(a), "v"(b)); return r; }
__device__ __forceinline__ float g_fma(float a, float b, float c) { float r; asm("v_fma_f32 %0, %1, %2, %3" : "=v"(r) : "v"(a), "v"(b), "v"(c)); return r; }
__device__ __forceinline__ float g_max3(float a, float b, float c) { float r; asm("v_max3_f32 %0, %1, %2, %3" : "=v"(r) : "v"(a), "v"(b), "v"(c)); return r; }
__device__ __forceinline__ float g_exp2(float a) { float r; asm("v_exp_f32_e32 %0, %1" : "=v"(r) : "v"(a)); return r; }
__device__ __forceinline__ unsigned g_cvtpk(float lo, float hi) { unsigned r; asm("v_cvt_pk_bf16_f32 %0, %1, %2" : "=v"(r) : "v"(lo), "v"(hi)); return r; }
template <int NRB, int MODE> __device__ __forceinline__ void seg1_gap(f32x16& c0, f32x16& c1, const ATT_LAS char* Ks, const ATT_LAS char* Rs, const bf16x8* qr, int r32, int hi,
                                                            f32x16& p0, f32x16& p1, float alP, float& l_reg, bf16x8& pa0, bf16x8& pa1, bf16x8& pa2, bf16x8& pa3) {
  constexpr bool DOE = (MODE == 0 || MODE == 4 || MODE == 9), DOS = (MODE == 0 || MODE == 5 || MODE == 7 || MODE == 9);
  constexpr int DB = 8 + NRB, NG = 2 * DB;
  static_assert(NG >= 24, "the filler schedule below needs 24 gaps");
  asm volatile("" : "+v"(r32));
  c0 = f32x16{}; c1 = f32x16{};
  float s0 = 0.f, s1 = 0.f; unsigned cv[8], cw[8]; u32x4 wa = {0u, 0u, 0u, 0u}, wb = {0u, 0u, 0u, 0u}, wc = {0u, 0u, 0u, 0u}, wd = {0u, 0u, 0u, 0u};
#define KADDR(d0, half) ((d0) < 8 ? (Ks + KSWZ((half) * 32 + r32, ((d0) * 16 + hi * 8) * 2)) : (Rs + RSWZ((half) * 32 + r32, (((d0) - 8) * 16 + hi * 8) * 2)))
#define FILL(i) do { \
    if (DOE && (i) < 16) p1[(i) < 16 ? (i) : 0] = g_exp2(p1[(i) < 16 ? (i) : 0]); \
    if (DOS) { \
    if ((i) < 8) { s0 = g_add(s0, p0[2 * ((i) & 7)]); s1 = g_add(s1, p0[2 * ((i) & 7) + 1]); cv[(i) & 7] = g_cvtpk(p0[2 * ((i) & 7)], p0[2 * ((i) & 7) + 1]); } \
    if ((i) >= 8) { if ((i) & 1) s1 = g_add(s1, p1[((i) - 8) & 15]); else s0 = g_add(s0, p1[((i) - 8) & 15]); } \
    if ((i) == 8)  { auto r_ = __builtin_amdgcn_permlane32_swap(cv[0], cv[2], false, false); wa.x = r_[0]; wa.z = r_[1]; } \
    if ((i) == 9)  { auto r_ = __builtin_amdgcn_permlane32_swap(cv[1], cv[3], false, false); wa.y = r_[0]; wa.w = r_[1]; } \
    if ((i) == 10) { auto r_ = __builtin_amdgcn_permlane32_swap(cv[4], cv[6], false, false); wb.x = r_[0]; wb.z = r_[1]; } \
    if ((i) == 11) { auto r_ = __builtin_amdgcn_permlane32_swap(cv[5], cv[7], false, false); wb.y = r_[0]; wb.w = r_[1]; } \
    if ((i) >= 12 && (i) < 20) cw[((i) - 12) & 7] = g_cvtpk(p1[2 * (((i) - 12) & 7)], p1[2 * (((i) - 12) & 7) + 1]); \
    if ((i) == 20) { auto r_ = __builtin_amdgcn_permlane32_swap(cw[0], cw[2], false, false); wc.x = r_[0]; wc.z = r_[1]; } \
    if ((i) == 21) { auto r_ = __builtin_amdgcn_permlane32_swap(cw[1], cw[3], false, false); wc.y = r_[0]; wc.w = r_[1]; } \
    if ((i) == 22) { auto r_ = __builtin_amdgcn_permlane32_swap(cw[4], cw[6], false, false); wd.x = r_[0]; wd.z = r_[1]; } \
    if ((i) == 23) { auto r_ = __builtin_amdgcn_permlane32_swap(cw[5], cw[7], false, false); wd.y = r_[0]; wd.w = r_[1]; } \
    } \
  } while (0)
  bf16x8 kf[3][2];
  kf[0][0] = *reinterpret_cast<const ATT_LAS bf16x8*>(KADDR(0, 0)); kf[0][1] = *reinterpret_cast<const ATT_LAS bf16x8*>(KADDR(0, 1));
  kf[1][0] = *reinterpret_cast<const ATT_LAS bf16x8*>(KADDR(1, 0)); kf[1][1] = *reinterpret_cast<const ATT_LAS bf16x8*>(KADDR(1, 1));
  kf[2][0] = kf[0][0]; kf[2][1] = kf[0][1];
#pragma unroll
  for (int d0 = 0; d0 < DB; ++d0) {
    if (MODE != 2) if (d0 + 2 < DB) { kf[(d0 + 2) % 3][0] = *reinterpret_cast<const ATT_LAS bf16x8*>(KADDR(d0 + 2, 0)); kf[(d0 + 2) % 3][1] = *reinterpret_cast<const ATT_LAS bf16x8*>(KADDR(d0 + 2, 1)); }
    if (ATT_PRIO) __builtin_amdgcn_s_setprio(1);
    c0 = __builtin_amdgcn_mfma_f32_32x32x16_bf16(kf[d0 % 3][0], qr[d0], c0, 0, 0, 0);
    if (ATT_PRIO) __builtin_amdgcn_s_setprio(0);
    if (2 * d0 < 24) FILL(2 * d0);
    SBAR();
    if (ATT_PRIO) __builtin_amdgcn_s_setprio(1);
    c1 = __builtin_amdgcn_mfma_f32_32x32x16_bf16(kf[d0 % 3][1], qr[d0], c1, 0, 0, 0);
    if (ATT_PRIO) __builtin_amdgcn_s_setprio(0);
    if (2 * d0 + 1 < 24) FILL(2 * d0 + 1);
    SBAR();
  }
  { float ps = g_add(s0, s1); auto rr = __builtin_amdgcn_permlane32_swap(__float_as_uint(ps), __float_as_uint(ps), false, false); ps = __uint_as_float(rr[0]) + __uint_as_float(rr[1]);
    l_reg = l_reg * alP + ps; }
  pa0 = *reinterpret_cast<bf16x8*>(&wa); pa1 = *reinterpret_cast<bf16x8*>(&wb); pa2 = *reinterpret_cast<bf16x8*>(&wc); pa3 = *reinterpret_cast<bf16x8*>(&wd);
#undef KADDR
#undef FILL
}
template <int NRB, int MODE> __device__ __forceinline__ void seg2_gap(f32x16* o, int vb, bf16x8 pa0, bf16x8 pa1, bf16x8 pa2, bf16x8 pa3,
                                                            f32x16& c0, f32x16& c1, float& m_reg, float& alpha) {
  constexpr bool DOE = (MODE == 0 || MODE == 4 || MODE == 9), DOS = (MODE == 0 || MODE == 5 || MODE == 8 || MODE == 9);
  constexpr float SCALE = Sc<NRB>::SCALE, C = SCALE * 1.4426950408889634f, THRL = THR * 1.4426950408889634f;
  s16x4 vl[2][4], vh[2][4];
#define VRD(buf, D0) do { vl[buf][0] = tr_read<v_rd_off(D0, 0, 0)>(vb); vh[buf][0] = tr_read<v_rd_off(D0, 0, 1)>(vb); vl[buf][1] = tr_read<v_rd_off(D0, 1, 0)>(vb); vh[buf][1] = tr_read<v_rd_off(D0, 1, 1)>(vb); \
    vl[buf][2] = tr_read<v_rd_off(D0, 2, 0)>(vb); vh[buf][2] = tr_read<v_rd_off(D0, 2, 1)>(vb); vl[buf][3] = tr_read<v_rd_off(D0, 3, 0)>(vb); vh[buf][3] = tr_read<v_rd_off(D0, 3, 1)>(vb); } while (0)
#define PKV(buf, k) (bf16x8){vl[buf][k][0], vl[buf][k][1], vl[buf][k][2], vl[buf][k][3], vh[buf][k][0], vh[buf][k][1], vh[buf][k][2], vh[buf][k][3]}
#define VWAIT8() do { asm volatile("s_waitcnt lgkmcnt(8)" ::: "memory"); SBAR(); } while (0)
#define VWAIT0() do { asm volatile("s_waitcnt lgkmcnt(0)" ::: "memory"); SBAR(); } while (0)
#define XFORM4(V, b) do { V[b] = g_fma(V[b], C, mnC); V[(b) + 1] = g_fma(V[(b) + 1], C, mnC); V[(b) + 2] = g_fma(V[(b) + 2], C, mnC); V[(b) + 3] = g_fma(V[(b) + 3], C, mnC); \
    ma = g_max3(ma, V[b], V[(b) + 1]); mb = g_max3(mb, V[(b) + 2], V[(b) + 3]); } while (0)
  const float mnC = -m_reg * C; float ma = -1e30f, mb = -1e30f;
  const bf16x8 pa[4] = {pa0, pa1, pa2, pa3};
  VRD(0, 0); VRD(1, 1); VWAIT8();
#pragma unroll
  for (int g = 0; g < 16; ++g) {
    if (MODE != 2) { if (g == 4) { VRD(0, 2); VWAIT8(); } if (g == 8) { VRD(1, 3); VWAIT8(); } } if (g == 12) { VWAIT0(); }
    if (ATT_PRIO) __builtin_amdgcn_s_setprio(1);
    o[g >> 2] = __builtin_amdgcn_mfma_f32_32x32x16_bf16(pa[g & 3], PKV((g >> 2) & 1, g & 3), o[g >> 2], 0, 0, 0);
    if (ATT_PRIO) __builtin_amdgcn_s_setprio(0);
    if (DOS && g < 4) XFORM4(c0, 4 * (g & 3));
    if (DOS && g >= 4 && g < 8) XFORM4(c1, 4 * (g & 3));
    if (!DOS && g == 8) alpha = 1.f;
    if (DOS && g == 8) { float pmax = fmaxf(ma, mb); auto rr = __builtin_amdgcn_permlane32_swap(__float_as_uint(pmax), __float_as_uint(pmax), false, false);
      pmax = fmaxf(__uint_as_float(rr[0]), __uint_as_float(rr[1]));
      alpha = 1.f;
      if (__builtin_expect(__any(pmax > THRL), 0)) {
        const float dl = fmaxf(pmax, 0.f); m_reg += dl * (1.0f / C); alpha = __builtin_amdgcn_exp2f(-dl);
#pragma unroll
        for (int r = 0; r < 16; ++r) { c0[r] -= dl; c1[r] -= dl; } } }
    if (DOE && g == 9)  { c0[0] = g_exp2(c0[0]); c0[1] = g_exp2(c0[1]); c0[2] = g_exp2(c0[2]); }
    if (DOE && g == 10) { c0[3] = g_exp2(c0[3]); c0[4] = g_exp2(c0[4]); c0[5] = g_exp2(c0[5]); }
    if (DOE && g >= 11) { c0[6 + 2 * ((g - 11) & 7)] = g_exp2(c0[6 + 2 * ((g - 11) & 7)]); c0[7 + 2 * ((g - 11) & 7)] = g_exp2(c0[7 + 2 * ((g - 11) & 7)]); }
    SBAR();
  }
  if (MODE != 0) asm volatile("" :: "v"(c0), "v"(c1));
#undef VRD
#undef PKV
#undef VWAIT8
#undef VWAIT0
#undef XFORM4
}

__device__ __forceinline__ void glds16(const void* sbase, unsigned voff, unsigned lds_dst) { unsigned keep;
  asm volatile("s_mov_b32 %0, m0\n\ts_mov_b32 m0, %3\n\ts_nop 0\n\tglobal_load_lds_dwordx4 %1, %2\n\ts_mov_b32 m0, %0" : "=&s"(keep) : "v"(voff), "s"(sbase), "s"(lds_dst) : "memory"); }

template <int NRB, bool WIN, int MODE = 0, bool O8 = false, bool HSPLIT = false>
__device__ __forceinline__ void attn_body(const bf16* __restrict__ Qb, int ldq, const bf16* __restrict__ Qrb, int ldqr,
                                          const bf16* __restrict__ Kh, int ldk, const bf16* __restrict__ Krh, int ldkr,
                                          const bf16* __restrict__ Vh, int ldv, bf16* __restrict__ Ob, int ldo,
                                          int NT, int qrel0, float m0, float l0, ATT_LAS char* lds, int wave_, float oscale = 1.f, float m0b = 0.f) {
  const int wrow = HSPLIT ? (wave_ & 3) : wave_, hsel = HSPLIT ? (wave_ >> 2) : 0;
  const int tid = opaque_tid(wave_), wid = wave_, lane = tid & 63, r32 = lane & 31, hi = lane >> 5;
  constexpr int SLOTK = SHM_K + SHM_R, VRING = 3 * SLOTK, OFFWS = VRING + 3 * SHM_V;
  ATT_LAS float* ws = (ATT_LAS float*)(lds + OFFWS) + wid * 64; ATT_LAS float* li_l = ws; ATT_LAS float* al_l = ws + 32;
  float m_reg = (HSPLIT && hsel) ? m0b : m0, l_reg = l0; f32x16 o[4] = {}; bf16x8 qr[8 + NRB];
  const unsigned lds0 = (unsigned)(uintptr_t)lds;
#define DMA_K(t, ks) do { const unsigned d_ = (unsigned)__builtin_amdgcn_readfirstlane((int)(lds0 + (ks) + wid * 2048)); \
    const int ln_ = lane_id(); const bf16* kt_ = Kh + (long)(t) * KVBLK * ldk; \
    _Pragma("unroll") for (int p_ = 0; p_ < 2; ++p_) { const int row_ = 4 * (2 * wid + p_) + (ln_ >> 4), cb_ = (16 * (ln_ & 15)) ^ ((row_ & 15) << 4); glds16(kt_, (unsigned)(row_ * ldk * 2 + cb_), d_ + p_ * 1024); } \
    if constexpr (NRB > 0) { const int row_ = 8 * wid + (ln_ >> 3), cb_ = (16 * (ln_ & 7)) ^ (((row_ >> 1) & 7) << 4); \
      glds16(Krh + (long)(t) * KVBLK * ldkr, (unsigned)(row_ * ldkr * 2 + cb_), (unsigned)__builtin_amdgcn_readfirstlane((int)(lds0 + (ks) + SHM_K + wid * 1024))); } } while (0)
#define DMA_V(t, vs) do { const unsigned d_ = (unsigned)__builtin_amdgcn_readfirstlane((int)(lds0 + (vs) + wid * 2048)); \
    const int ln_ = lane_id(); const bf16* vt_ = Vh + (long)(t) * KVBLK * ldv; \
    _Pragma("unroll") for (int p_ = 0; p_ < 2; ++p_) { const int c_ = 2 * wid + p_, kk_ = 8 * (c_ >> 1) + ((ln_ & 31) >> 2), key_ = (kk_ & ~0xC) | ((kk_ & 4) << 1) | ((kk_ & 8) >> 1), col_ = 32 * (2 * (c_ & 1) + (ln_ >> 5)) + 8 * (ln_ & 3); \
      glds16(vt_, (unsigned)((key_ * ldv + col_) * 2), d_ + p_ * 1024); } } while (0)
  if constexpr (WIN) { DMA_K(0, 0); DMA_V(0, VRING); DMA_K(1, SLOTK); DMA_V(1, VRING + SHM_V); }
  else { DMA_K(0, 0); DMA_K(1, SLOTK); DMA_V(0, VRING); if (2 < NT) DMA_K(2, 2 * SLOTK); DMA_V(1, VRING + SHM_V); }
  const bf16* Qw = Qb + hsel * D + (long)(wrow * QBLK + r32) * ldq + hi * 8;
#pragma unroll
  for (int d0 = 0; d0 < 8; ++d0) qr[d0] = *reinterpret_cast<const bf16x8*>(Qw + d0 * 16);
  if constexpr (NRB > 0) { const bf16* Qrw = Qrb + (long)(wid * QBLK + r32) * ldqr + hi * 8;
#pragma unroll
    for (int d0 = 0; d0 < NRB; ++d0) qr[8 + d0] = *reinterpret_cast<const bf16x8*>(Qrw + d0 * 16); }
  const int vrd = v_rd_base(lane);
  const int qrel = qrel0 + wrow * QBLK + r32;
#define WAITSYNC() do { asm volatile("s_waitcnt vmcnt(0)" ::: "memory"); __syncthreads(); } while (0)
#define RESC(a) do { if (__any((a) < 1.f)) { if (hi == 0) al_l[r32] = (a); asm volatile("s_waitcnt lgkmcnt(0)" ::: "memory"); \
    _Pragma("unroll") for (int d = 0; d < 4; ++d) _Pragma("unroll") for (int r = 0; r < 16; ++r) o[d][r] *= al_l[crow(r, hi)]; } } while (0)
  f32x16 pA0, pA1, pB0, pB1; float mnA, alA, alB; bf16x8 pa0, pa1, pa2, pa3;
  WAITSYNC();
  if constexpr (WIN) {
    const int qlo_ = qrel0 + wrow * QBLK - 128, qhi_ = qrel0 + wrow * QBLK + QBLK - 1 + 128;
    int ks = 0, vs = VRING;
    for (int t = 0; t < NT; ++t) {
      const int ks2 = ks >= SLOTK ? ks - SLOTK : ks + 2 * SLOTK, vs2 = vs >= VRING + SHM_V ? vs - SHM_V : vs + 2 * SHM_V;
      if (t + 2 < NT) { DMA_K(t + 2, ks2); DMA_V(t + 2, vs2); }
      if (64 * t + 63 >= qlo_ && 64 * t <= qhi_) {
        qkt<NRB>(pA0, pA1, lds + ks, lds + ks + SHM_K, qr, r32, hi);
        if (64 * t < qlo_ + QBLK - 1 || 64 * t + 63 > qhi_ - (QBLK - 1)) wmask(pA0, pA1, t, qrel, hi);
        partialSM<NRB>(pA0, pA1, m_reg, mnA, alA); RESC(alA);
        finishSM(pA0, pA1, alA, l_reg, pa0, pa1, pa2, pa3); SBAR();
        pv_d0(o, (int)lds0 + vs + vrd, pa0, pa1, pa2, pa3);
      }
      if (t + 2 < NT) asm volatile("s_waitcnt vmcnt(4) lgkmcnt(0)" ::: "memory"); else asm volatile("s_waitcnt vmcnt(0) lgkmcnt(0)" ::: "memory");
      __builtin_amdgcn_s_barrier(); asm volatile("" ::: "memory");
      ks = ks == 2 * SLOTK ? 0 : ks + SLOTK; vs = vs == VRING + 2 * SHM_V ? VRING : vs + SHM_V;
    }
  } else {
    constexpr int NKI = NRB > 0 ? 3 : 2;
    qkt<NRB>(pA0, pA1, lds, lds + SHM_K, qr, r32, hi); partialSM<NRB>(pA0, pA1, m_reg, mnA, alA);
    asm volatile("s_waitcnt lgkmcnt(0)" ::: "memory"); __builtin_amdgcn_s_barrier(); asm volatile("" ::: "memory");
    if (3 < NT) DMA_K(3, 0);
    if (2 < NT) DMA_V(2, VRING + 2 * SHM_V);
    int kcur = SLOTK, vprev = VRING;
#ifndef ATT_STAGGER
#define ATT_STAGGER 0
#endif
#define STEP_TAIL(alC, t) do { \
      if ((t) + 2 < NT) asm volatile("s_waitcnt vmcnt(%0) lgkmcnt(0)" :: "n"(NKI + 2) : "memory"); \
      else if ((t) + 1 < NT) asm volatile("s_waitcnt vmcnt(2) lgkmcnt(0)" ::: "memory"); \
      else asm volatile("s_waitcnt vmcnt(0) lgkmcnt(0)" ::: "memory"); \
      __builtin_amdgcn_s_barrier(); asm volatile("" ::: "memory"); \
      if (MODE != 9) { if ((t) + 3 < NT) DMA_K((t) + 3, kcur); \
      if ((t) + 2 < NT) DMA_V((t) + 2, vprev); } \
      RESC(alC); kcur = kcur == 2 * SLOTK ? 0 : kcur + SLOTK; vprev = vprev == VRING + 2 * SHM_V ? VRING : vprev + SHM_V; } while (0)
#define STEP_A(C0, C1, alC, P0, P1, alP, t) do { \
      SBAR(); seg1_gap<NRB, MODE>(C0, C1, lds + kcur, lds + kcur + SHM_K, qr, r32, hi, P0, P1, alP, l_reg, pa0, pa1, pa2, pa3); \
      SBAR(); seg2_gap<NRB, MODE>(o, (int)lds0 + vprev + vrd, pa0, pa1, pa2, pa3, C0, C1, m_reg, alC); SBAR(); \
      STEP_TAIL(alC, t); } while (0)
#define STEP_B(C0, C1, alC, P0, P1, alP, t) do { float mn_; \
      SBAR(); finishSM(P0, P1, alP, l_reg, pa0, pa1, pa2, pa3); SBAR(); \
      qkt<NRB>(C0, C1, lds + kcur, lds + kcur + SHM_K, qr, r32, hi); SBAR(); \
      partialSM<NRB>(C0, C1, m_reg, mn_, alC); SBAR(); \
      pv_d0(o, (int)lds0 + vprev + vrd, pa0, pa1, pa2, pa3); SBAR(); \
      STEP_TAIL(alC, t); } while (0)
#define TILE_LOOP(STEP) do { \
    for (int t = 1; t + 1 < NT; t += 2) { \
      STEP(pB0, pB1, alB, pA0, pA1, alA, t); \
      STEP(pA0, pA1, alA, pB0, pB1, alB, t + 1); \
    } \
    STEP(pB0, pB1, alB, pA0, pA1, alA, NT - 1); } while (0)
    if (ATT_STAGGER && wid >= 4) TILE_LOOP(STEP_B); else TILE_LOOP(STEP_A);
#undef TILE_LOOP
#undef STEP_A
#undef STEP_B
#undef STEP_TAIL
    finishSM(pB0, pB1, alB, l_reg, pa0, pa1, pa2, pa3); SBAR();
    pv_d0(o, (int)lds0 + vprev + vrd, pa0, pa1, pa2, pa3);
  }
  { const int ln_ = opaque_tid(wave_) & 63, r32e = ln_ & 31, hie = ln_ >> 5;
    if (hie == 0) li_l[r32e] = l_reg; asm volatile("s_waitcnt lgkmcnt(0)" ::: "memory");
    bf16* Ow = Ob + hsel * D + (long)(wrow * QBLK) * ldo + r32e; unsigned char* Ow8 = (unsigned char*)Ob + hsel * D + (long)(wrow * QBLK) * ldo + r32e;
#pragma unroll
    for (int r = 0; r < 16; ++r) { const int orow = crow(r, hie); const float rl = __builtin_amdgcn_rcpf(li_l[orow]) * (O8 ? oscale : 1.f);
#pragma unroll
      for (int d0 = 0; d0 < 4; ++d0) {
        if constexpr (O8) { if (d0 == 0) { int w8 = __builtin_amdgcn_cvt_pk_fp8_f32(o[0][r] * rl, o[1][r] * rl, 0, false); w8 = __builtin_amdgcn_cvt_pk_fp8_f32(o[2][r] * rl, o[3][r] * rl, w8, true);
            if (MODE == 0) *(int*)(Ow8 + (long)orow * ldo + 3 * r32e) = w8; else asm volatile("" :: "v"(w8)); } }
        else { const unsigned w = cvtpk(o[d0][r] * rl, 0.f); if (MODE == 0) Ow[(long)orow * ldo + d0 * 32] = (bf16)(w & 0xffffu); else asm volatile("" :: "v"(w)); } } } }
  __syncthreads();
#undef DMA_K
#undef DMA_V
#undef WAITSYNC
#undef RESC
}
using i32x8 = __attribute__((ext_vector_type(8))) int;
using i32x4 = __attribute__((ext_vector_type(4))) int;
constexpr int S8_KN = 8192, S8_KR = 4096, S8_SLOTK = S8_KN + S8_KR, S8_V = 8192, S8_VRING = 6 * S8_SLOTK, S8_WS = S8_VRING + 6 * S8_V, SHM_ATTN8 = S8_WS + NW * 64 * 4;
#ifndef MLA8_VSPLIT
#define MLA8_VSPLIT 1
#endif
#ifndef MLA8_THR
#define MLA8_THR 4.f
#endif
constexpr float THR8 = MLA8_THR, OFF8 = 2.f, SC8 = MLA8_PRESCALE ? 1.0f : 0.07216878364870322f * 1.4426950408889634f, THRL8 = THR8 * 1.4426950408889634f;
__device__ __forceinline__ i32x8 lds32(const ATT_LAS char* p) { const i32x4 a = *(const ATT_LAS i32x4*)p, b = *(const ATT_LAS i32x4*)(p + 16); return __builtin_shufflevector(a, b, 0, 1, 2, 3, 4, 5, 6, 7); }
__device__ __forceinline__ i32x8 lds16x2(const ATT_LAS char* p, const ATT_LAS char* q) { const i32x4 a = *(const ATT_LAS i32x4*)p, b = *(const ATT_LAS i32x4*)q; return __builtin_shufflevector(a, b, 0, 1, 2, 3, 4, 5, 6, 7); }
__device__ __forceinline__ i32x8 ldsx(const ATT_LAS char* base, int off) { return lds16x2(base + off, base + (off ^ 16)); }
__device__ __forceinline__ f32x16 mfma8(i32x8 a, i32x8 b, f32x16 c) { return __builtin_amdgcn_mfma_scale_f32_32x32x64_f8f6f4(a, b, c, 0, 0, 0, 0, 0, 0); }
__device__ __forceinline__ int pk4f8(float a, float b, float c, float d) { int w = __builtin_amdgcn_cvt_pk_fp8_f32(a, b, 0, false); return __builtin_amdgcn_cvt_pk_fp8_f32(c, d, w, true); }
__device__ __forceinline__ int pk4f8o(int prev, float a, float b, float c, float d) { int w = __builtin_amdgcn_cvt_pk_fp8_f32(a, b, prev, false); return __builtin_amdgcn_cvt_pk_fp8_f32(c, d, w, true); }

template <bool DOMMA, bool DOFILL, bool LDV>
__device__ __forceinline__ void seg1_8(f32x16& c0, f32x16& c1, const ATT_LAS char* Ks, int ra, const i32x8 (&qr)[3], i32x8& a0, i32x8& a1, i32x8& b0, i32x8& b1,
                                       f32x16& p0, f32x16& p1, float alP, float& l_reg, i32x8& pf, const ATT_LAS char* Vs, int va, i32x8& f0, i32x8& f1, i32x8& f2, i32x8& f3,
                                       const f32x16& z = f32x16{}) {
  asm volatile("" : "+v"(ra), "+v"(va));
  const ATT_LAS char* kr = Ks + S8_KN; const ATT_LAS char* v0 = Vs + va; const ATT_LAS char* v1 = Vs + (va ^ 32);
  float s0 = 0.f, s1 = 0.f;
#define E4(P, b) do { P[b] = g_exp2(P[b]); P[(b) + 1] = g_exp2(P[(b) + 1]); P[(b) + 2] = g_exp2(P[(b) + 2]); P[(b) + 3] = g_exp2(P[(b) + 3]); } while (0)
#define A4(P, b) do { s0 = g_add(s0, P[b]); s1 = g_add(s1, P[(b) + 1]); s0 = g_add(s0, P[(b) + 2]); s1 = g_add(s1, P[(b) + 3]); } while (0)
  if (DOMMA) c0 = mfma8(a0, qr[0], z);
  if (DOFILL) { pf[0] = pk4f8o(pf[0], p0[0], p0[1], p0[2], p0[3]); pf[1] = pk4f8o(pf[1], p0[4], p0[5], p0[6], p0[7]); pf[2] = pk4f8o(pf[2], p0[8], p0[9], p0[10], p0[11]); pf[3] = pk4f8o(pf[3], p0[12], p0[13], p0[14], p0[15]); A4(p0, 0); A4(p0, 4); }
  SBAR();
  if (DOMMA) { c1 = mfma8(a1, qr[0], z); a0 = ldsx(kr, ra); a1 = ldsx(kr + 2048, ra); }
  if (DOFILL) { E4(p1, 0); A4(p0, 8); A4(p0, 12); }
  SBAR();
  if (DOMMA) c0 = mfma8(b0, qr[1], c0);
  if (LDV) { f0 = lds16x2(v0, v1); f1 = lds16x2(v0 + 2048, v1 + 2048); }
  if (DOFILL) { E4(p1, 4); A4(p1, 0); }
  SBAR();
  if (DOMMA) c1 = mfma8(b1, qr[1], c1);
  if (LDV && !MLA8_VSPLIT) { f2 = lds16x2(v0 + 4096, v1 + 4096); f3 = lds16x2(v0 + 6144, v1 + 6144); }
  if (DOFILL) { E4(p1, 8); A4(p1, 4); }
  SBAR();
  if (DOMMA) c0 = mfma8(a0, qr[2], c0);
  if (DOFILL) { E4(p1, 12); A4(p1, 8); pf[4] = pk4f8o(pf[4], p1[0], p1[1], p1[2], p1[3]); pf[5] = pk4f8o(pf[5], p1[4], p1[5], p1[6], p1[7]); }
  SBAR();
  if (DOMMA) c1 = mfma8(a1, qr[2], c1);
  if (DOFILL) { A4(p1, 12); pf[6] = pk4f8o(pf[6], p1[8], p1[9], p1[10], p1[11]); pf[7] = pk4f8o(pf[7], p1[12], p1[13], p1[14], p1[15]);
    float ps = g_add(s0, s1); auto rr = __builtin_amdgcn_permlane32_swap(__float_as_uint(ps), __float_as_uint(ps), false, false); ps = __uint_as_float(rr[0]) + __uint_as_float(rr[1]);
    l_reg = l_reg * alP + ps; }
  SBAR();
#undef E4
#undef A4
}
template <bool DOMMA, bool DOSM, bool LDK, bool MI = false>
__device__ __forceinline__ void seg2_8(f32x16 (&o)[4], i32x8 f0, i32x8 f1, i32x8 f2, i32x8 f3, i32x8 pf, f32x16& c0, f32x16& c1, float& m_reg, float& alpha,
                                       const ATT_LAS char* Kn, int ka, i32x8& a0, i32x8& a1, i32x8& b0, i32x8& b1, f32x16* mi = nullptr, const ATT_LAS char* Vs = nullptr, int va = 0) {
  asm volatile("" : "+v"(ka), "+v"(va));
  const float mnC = fmaf(-m_reg, SC8, OFF8); float ma = -1e30f, mb = -1e30f;
#define XFORM4(V, b) do { if (!MI) { V[b] = g_fma(V[b], SC8, mnC); V[(b) + 1] = g_fma(V[(b) + 1], SC8, mnC); V[(b) + 2] = g_fma(V[(b) + 2], SC8, mnC); V[(b) + 3] = g_fma(V[(b) + 3], SC8, mnC); } \
    ma = g_max3(ma, V[b], V[(b) + 1]); mb = g_max3(mb, V[(b) + 2], V[(b) + 3]); } while (0)
#define E4(P, b) do { P[b] = g_exp2(P[b]); P[(b) + 1] = g_exp2(P[(b) + 1]); P[(b) + 2] = g_exp2(P[(b) + 2]); P[(b) + 3] = g_exp2(P[(b) + 3]); } while (0)
  if (DOMMA) o[0] = mfma8(pf, f0, o[0]);
  if (DOMMA && MLA8_VSPLIT && Vs) f2 = lds16x2(Vs + va + 4096, Vs + (va ^ 32) + 4096);
  if (DOSM) { XFORM4(c0, 0); XFORM4(c0, 4); XFORM4(c0, 8); XFORM4(c0, 12); }
  SBAR();
  if (DOMMA) o[1] = mfma8(pf, f1, o[1]);
  if (DOMMA && MLA8_VSPLIT && Vs) f3 = lds16x2(Vs + va + 6144, Vs + (va ^ 32) + 6144);
  if (LDK) { a0 = ldsx(Kn, ka); a1 = ldsx(Kn + 4096, ka); }
  if (DOSM) { XFORM4(c1, 0); XFORM4(c1, 4); XFORM4(c1, 8); XFORM4(c1, 12); }
  SBAR();
  if (DOMMA) o[2] = mfma8(pf, f2, o[2]);
  if (LDK) { b0 = ldsx(Kn, ka ^ 64); b1 = ldsx(Kn + 4096, ka ^ 64); }
  if (DOSM) { float pmax = g_max3(ma, mb, mb); auto rr = __builtin_amdgcn_permlane32_swap(__float_as_uint(pmax), __float_as_uint(pmax), false, false);
    pmax = g_max3(__uint_as_float(rr[0]), __uint_as_float(rr[1]), __uint_as_float(rr[1]));
    alpha = 1.f;
    if (__builtin_expect(__any(pmax > THRL8 + OFF8), 0)) {
      const float dl = fmaxf(pmax - OFF8, 0.f); m_reg += dl * (1.0f / SC8); alpha = __builtin_amdgcn_exp2f(-dl);
#pragma unroll
      for (int r = 0; r < 16; ++r) { c0[r] -= dl; c1[r] -= dl; if (MI) (*mi)[r] -= dl; } }
    E4(c0, 0); }
  SBAR();
  if (DOMMA) o[3] = mfma8(pf, f3, o[3]);
  if (DOSM) { E4(c0, 4); E4(c0, 8); E4(c0, 12); }
  SBAR();
#undef XFORM4
#undef E4
}

template <long VDELTA, int MODE = 0>
__device__ __forceinline__ void attn_mla8(const unsigned char* __restrict__ Q8n, int ldqn, const unsigned char* __restrict__ Q8r, int ldqr,
                                          const unsigned char* __restrict__ Kn8, const unsigned char* __restrict__ Kr8,
                                          unsigned char* __restrict__ O8b, int ldo, ATT_LAS char* lds, int wave_, float oscale) {
  constexpr int NT = 64; const unsigned char* Vt8 = Kn8 + VDELTA;
  const int tid = opaque_tid(wave_), wid = wave_, lane = tid & 63, r32 = lane & 31, hi = lane >> 5;
  ATT_LAS float* ws = (ATT_LAS float*)(lds + S8_WS) + wid * 64; ATT_LAS float* li_l = ws; ATT_LAS float* al_l = ws + 32;
  float m_reg = -1e30f, l_reg = 0.f; f32x16 o[4] = {}; i32x8 qr[3];
  const unsigned lds0 = (unsigned)(uintptr_t)lds;
#define DMA_VO ((unsigned)lane_id() * 16u)
#define DMA_KN8(j, slot) do { glds16(Kn8 + (size_t)(j) * S8_KN + wid * 1024, DMA_VO, (unsigned)__builtin_amdgcn_readfirstlane((int)(lds0 + (slot) * S8_SLOTK + wid * 1024))); } while (0)
#define DMA_KR8(j, slot, pc) do { glds16(Kr8 + (size_t)(j) * S8_KR + (pc) * 1024, DMA_VO, (unsigned)__builtin_amdgcn_readfirstlane((int)(lds0 + (slot) * S8_SLOTK + S8_KN + (pc) * 1024))); } while (0)
#define DMA_V8(j, slot) do { glds16(Vt8 + (size_t)(j) * S8_V + wid * 1024, DMA_VO, (unsigned)__builtin_amdgcn_readfirstlane((int)(lds0 + S8_VRING + (slot) * S8_V + wid * 1024))); } while (0)
#pragma unroll
  for (int j = 0; j < 6; ++j) { DMA_KN8(j, j); DMA_V8(j, j); }
#pragma unroll
  for (int i = 0; i < 3; ++i) { const int idx = wid + 8 * i; DMA_KR8(idx >> 2, idx >> 2, idx & 3); }
  { const unsigned char* qn = Q8n + (long)(wid * QBLK + r32) * ldqn + hi * 32; const unsigned char* qp = Q8r + (long)(wid * QBLK + r32) * ldqr + hi * 32;
    const i32x4 x0 = *(const i32x4*)qn, x1 = *(const i32x4*)(qn + 16), x2 = *(const i32x4*)(qn + 64), x3 = *(const i32x4*)(qn + 80), x4 = *(const i32x4*)qp, x5 = *(const i32x4*)(qp + 16);
    qr[0] = __builtin_shufflevector(x0, x1, 0, 1, 2, 3, 4, 5, 6, 7); qr[1] = __builtin_shufflevector(x2, x3, 0, 1, 2, 3, 4, 5, 6, 7); qr[2] = __builtin_shufflevector(x4, x5, 0, 1, 2, 3, 4, 5, 6, 7); }
  const int pi = 16 * ((r32 >> 2) & 1) + (r32 & 3) + 4 * (r32 >> 3);
  const int ka = pi * 128 + ((32 * hi) ^ (((pi >> 1) & 7) << 4)), ra = pi * 64 + ((32 * hi) ^ (((pi >> 2) & 3) << 4)), va = r32 * 64 + ((16 * hi) ^ (((r32 >> 2) & 3) << 4));
#define RESC8(a) do { if (__any((a) < 1.f)) { if (hi == 0) al_l[r32] = (a); asm volatile("s_waitcnt lgkmcnt(0)" ::: "memory"); \
    _Pragma("unroll") for (int d = 0; d < 4; ++d) _Pragma("unroll") for (int r = 0; r < 16; ++r) o[d][r] *= al_l[crow(r, hi)]; } } while (0)
#define LDK4(Kn) do { int ka_ = ka; asm volatile("" : "+v"(ka_)); a0 = ldsx((Kn), ka_); a1 = ldsx((Kn) + 4096, ka_); b0 = ldsx((Kn), ka_ ^ 64); b1 = ldsx((Kn) + 4096, ka_ ^ 64); } while (0)
  f32x16 pA0, pA1, pB0, pB1, minit = {}; float alA = 1.f, alB = 1.f; i32x8 pf = {}, a0 = {}, a1 = {}, b0 = {}, b1 = {}, f0 = {}, f1 = {}, f2 = {}, f3 = {};
  asm volatile("s_waitcnt vmcnt(0)" ::: "memory"); __syncthreads();
  if (MODE != 2) LDK4(lds);
  seg1_8<MODE != 2, false, false>(pA0, pA1, lds, ra, qr, a0, a1, b0, b1, pA0, pA1, 1.f, l_reg, pf, lds, va, f0, f1, f2, f3);
  { float pmax = pA0[0];
#pragma unroll
    for (int r = 1; r < 16; ++r) pmax = fmaxf(pmax, pA0[r]);
#pragma unroll
    for (int r = 0; r < 16; ++r) pmax = fmaxf(pmax, pA1[r]);
    auto rr = __builtin_amdgcn_permlane32_swap(__float_as_uint(pmax), __float_as_uint(pmax), false, false); pmax = fmaxf(__uint_as_float(rr[0]), __uint_as_float(rr[1]));
    m_reg = pmax; const float mnC = fmaf(-m_reg, SC8, OFF8);
#pragma unroll
    for (int r = 0; r < 16; ++r) { pA0[r] = __builtin_amdgcn_exp2f(fmaf(pA0[r], SC8, mnC)); pA1[r] = fmaf(pA1[r], SC8, mnC); if (MLA8_PRESCALE) minit[r] = mnC; } }
  asm volatile("s_waitcnt lgkmcnt(0)" ::: "memory"); __builtin_amdgcn_s_barrier(); asm volatile("" ::: "memory");
  DMA_KN8(6, 0); if (wid < 4) DMA_KR8(6, 0, wid);
  if (MODE != 2) LDK4(lds + S8_SLOTK);
#define SUB8(C0, C1, alC, P0, P1, alP, kslot, vslot, LDKN, knext) do { \
    SBAR(); seg1_8<MODE != 2, MODE != 1, MODE != 2>(C0, C1, lds + (kslot) * S8_SLOTK, ra, qr, a0, a1, b0, b1, P0, P1, alP, l_reg, pf, lds + S8_VRING + (vslot) * S8_V, va, f0, f1, f2, f3, minit); \
    SBAR(); seg2_8<MODE != 2, MODE != 1, (LDKN) && MODE != 2, MLA8_PRESCALE != 0>(o, f0, f1, f2, f3, pf, C0, C1, m_reg, alC, lds + (knext) * S8_SLOTK, ka, a0, a1, b0, b1, &minit, lds + S8_VRING + (vslot) * S8_V, va); SBAR(); \
    if (MODE != 0) asm volatile("" : "+v"(C0), "+v"(C1), "+v"(pf), "+v"(l_reg)); \
    RESC8(alC); } while (0)
#define PAIR8(T2, S0, FULL) do { constexpr int S2_ = (S0) == 4 ? 0 : (S0) + 2; \
    SUB8(pB0, pB1, alB, pA0, pA1, alA, (S0) + 1, (S0), true, S2_); \
    SUB8(pA0, pA1, alA, pB0, pB1, alB, S2_, (S0) + 1, false, 0); \
    if (FULL) asm volatile("s_waitcnt vmcnt(5) lgkmcnt(0)" ::: "memory"); else asm volatile("s_waitcnt vmcnt(0) lgkmcnt(0)" ::: "memory"); \
    __builtin_amdgcn_s_barrier(); asm volatile("" ::: "memory"); \
    if (FULL) { const unsigned vo_ = (unsigned)lane_id() * 16u; \
      glds16(Kn8 + (size_t)((T2) + 7) * S8_KN + wid * 1024, vo_, (unsigned)__builtin_amdgcn_readfirstlane((int)(lds0 + ((S0) + 1) * S8_SLOTK + wid * 1024))); \
      glds16(Kn8 + (size_t)((T2) + 8) * S8_KN + wid * 1024, vo_, (unsigned)__builtin_amdgcn_readfirstlane((int)(lds0 + S2_ * S8_SLOTK + wid * 1024))); \
      if (wid < 4) glds16(Kr8 + (size_t)((T2) + 7) * S8_KR + wid * 1024, vo_, (unsigned)__builtin_amdgcn_readfirstlane((int)(lds0 + ((S0) + 1) * S8_SLOTK + S8_KN + wid * 1024))); \
      else glds16(Kr8 + (size_t)((T2) + 8) * S8_KR + (wid - 4) * 1024, vo_, (unsigned)__builtin_amdgcn_readfirstlane((int)(lds0 + S2_ * S8_SLOTK + S8_KN + (wid - 4) * 1024))); \
      glds16(Vt8 + (size_t)((T2) + 6) * S8_V + wid * 1024, vo_, (unsigned)__builtin_amdgcn_readfirstlane((int)(lds0 + S8_VRING + (S0) * S8_V + wid * 1024))); \
      glds16(Vt8 + (size_t)((T2) + 7) * S8_V + wid * 1024, vo_, (unsigned)__builtin_amdgcn_readfirstlane((int)(lds0 + S8_VRING + ((S0) + 1) * S8_V + wid * 1024))); } \
    else { if ((T2) + 7 < NT) { DMA_KN8((T2) + 7, (S0) + 1); if (wid < 4) DMA_KR8((T2) + 7, (S0) + 1, wid); } if ((T2) + 6 < NT) DMA_V8((T2) + 6, (S0)); if ((T2) + 7 < NT) DMA_V8((T2) + 7, (S0) + 1); } \
    if (MODE != 2) LDK4(lds + (S2_ + 1) * S8_SLOTK); } while (0)
  static_assert(NT == 64, "the pair schedule below is written for 64 tiles");
#ifndef MLA8_PRIO
#define MLA8_PRIO 0
#endif
  if (MLA8_PRIO && wid >= 4) __builtin_amdgcn_s_setprio(1);
  for (int t2 = 0; t2 < 54; t2 += 6) { PAIR8(t2, 0, true); PAIR8(t2 + 2, 2, true); PAIR8(t2 + 4, 4, true); }
  PAIR8(54, 0, true); PAIR8(56, 2, false); PAIR8(58, 4, false); PAIR8(60, 0, false);
  SUB8(pB0, pB1, alB, pA0, pA1, alA, 3, 2, false, 0);
  seg1_8<false, true, MODE != 2>(pA0, pA1, lds, ra, qr, a0, a1, b0, b1, pB0, pB1, alB, l_reg, pf, lds + S8_VRING + 3 * S8_V, va, f0, f1, f2, f3);
  seg2_8<MODE != 2, false, false>(o, f0, f1, f2, f3, pf, pA0, pA1, m_reg, alA, lds, ka, a0, a1, b0, b1, nullptr, lds + S8_VRING + 3 * S8_V, va);
  if (MLA8_PRIO) __builtin_amdgcn_s_setprio(0);
#undef PAIR8
  { const int ln_ = opaque_tid(wave_) & 63, r32e = ln_ & 31, hie = ln_ >> 5;
    if (hie == 0) li_l[r32e] = l_reg; asm volatile("s_waitcnt lgkmcnt(0)" ::: "memory");
    unsigned char* Ow8 = O8b + (long)(wid * QBLK) * ldo + r32e;
#pragma unroll
    for (int r = 0; r < 16; ++r) { const int orow = crow(r, hie); const float rl = __builtin_amdgcn_rcpf(li_l[orow]) * oscale;
      { int w8 = __builtin_amdgcn_cvt_pk_fp8_f32(o[0][r] * rl, o[1][r] * rl, 0, false); w8 = __builtin_amdgcn_cvt_pk_fp8_f32(o[2][r] * rl, o[3][r] * rl, w8, true);
        if (MODE == 0) *(int*)(Ow8 + (long)orow * ldo + 3 * r32e) = w8; else asm volatile("" :: "v"(w8)); } } }
  __syncthreads();
#undef DMA_KN8
#undef DMA_VO
#undef DMA_KR8
#undef DMA_V8
#undef RESC8
#undef LDK4
#undef SUB8
}

template <long VDELTA, int MODE = 0>
__device__ __forceinline__ void attn_mla8pp(const unsigned char* __restrict__ Q8n, int ldqn, const unsigned char* __restrict__ Q8r, int ldqr,
                                            const unsigned char* __restrict__ Kn8, const unsigned char* __restrict__ Kr8,
                                            unsigned char* __restrict__ O8b, int ldo, ATT_LAS char* lds, int wave_, float oscale) {
  constexpr int NT = 64; const unsigned char* Vt8 = Kn8 + VDELTA;
  const int tid = opaque_tid(wave_), wid = wave_, lane = tid & 63, r32 = lane & 31, hi = lane >> 5;
  ATT_LAS float* ws = (ATT_LAS float*)(lds + S8_WS) + wid * 64; ATT_LAS float* li_l = ws; ATT_LAS float* al_l = ws + 32;
  float m_reg = -1e30f, l_reg = 0.f, alpha = 1.f; f32x16 o[4] = {}; i32x8 qr[3];
  const unsigned lds0 = (unsigned)(uintptr_t)lds;
#ifndef PP_PARITY
#define PP_PARITY 0
#endif
  const bool h1 = PP_PARITY ? (wid & 1) != 0 : wid >= 4; const int hidx = PP_PARITY ? (wid >> 1) : (wid & 3);
#define DMA_KN8(j, slot) do { glds16(Kn8 + (size_t)(j) * S8_KN + wid * 1024, (unsigned)lane_id() * 16u, (unsigned)__builtin_amdgcn_readfirstlane((int)(lds0 + (slot) * S8_SLOTK + wid * 1024))); } while (0)
#define DMA_KR8(j, slot, pc) do { glds16(Kr8 + (size_t)(j) * S8_KR + (pc) * 1024, (unsigned)lane_id() * 16u, (unsigned)__builtin_amdgcn_readfirstlane((int)(lds0 + (slot) * S8_SLOTK + S8_KN + (pc) * 1024))); } while (0)
#define DMA_V8(j, slot) do { glds16(Vt8 + (size_t)(j) * S8_V + wid * 1024, (unsigned)lane_id() * 16u, (unsigned)__builtin_amdgcn_readfirstlane((int)(lds0 + S8_VRING + (slot) * S8_V + wid * 1024))); } while (0)
#pragma unroll
  for (int j = 0; j < 6; ++j) { DMA_KN8(j, j); DMA_V8(j, j); }
#pragma unroll
  for (int i = 0; i < 3; ++i) { const int idx = wid + 8 * i; DMA_KR8(idx >> 2, idx >> 2, idx & 3); }
  { const unsigned char* qn = Q8n + (long)(wid * QBLK + r32) * ldqn + hi * 32; const unsigned char* qp = Q8r + (long)(wid * QBLK + r32) * ldqr + hi * 32;
    const i32x4 x0 = *(const i32x4*)qn, x1 = *(const i32x4*)(qn + 16), x2 = *(const i32x4*)(qn + 64), x3 = *(const i32x4*)(qn + 80), x4 = *(const i32x4*)qp, x5 = *(const i32x4*)(qp + 16);
    qr[0] = __builtin_shufflevector(x0, x1, 0, 1, 2, 3, 4, 5, 6, 7); qr[1] = __builtin_shufflevector(x2, x3, 0, 1, 2, 3, 4, 5, 6, 7); qr[2] = __builtin_shufflevector(x4, x5, 0, 1, 2, 3, 4, 5, 6, 7); }
  const int pi = 16 * ((r32 >> 2) & 1) + (r32 & 3) + 4 * (r32 >> 3);
  const int ka = pi * 128 + ((32 * hi) ^ (((pi >> 1) & 7) << 4)), ra = pi * 64 + ((32 * hi) ^ (((pi >> 2) & 3) << 4)), va = r32 * 64 + ((16 * hi) ^ (((r32 >> 2) & 3) << 4));
  f32x16 c0 = {}, c1 = {}, minit = {}; i32x8 pf = {}, a0 = {}, a1 = {}, b0 = {}, b1 = {}, e0 = {}, e1 = {}, f0 = {}, f1 = {}, f2 = {}, f3 = {};
  static_assert(MLA8_PRESCALE, "attn_mla8pp takes pre-scaled q / k");
#define PBAR() do { __builtin_amdgcn_s_barrier(); asm volatile("" ::: "memory"); } while (0)
#define LDKF(slot) do { int ka_ = ka; asm volatile("" : "+v"(ka_)); const ATT_LAS char* kn_ = lds + (slot) * S8_SLOTK; a0 = ldsx(kn_, ka_); a1 = ldsx(kn_ + 4096, ka_); b0 = ldsx(kn_, ka_ ^ 64); b1 = ldsx(kn_ + 4096, ka_ ^ 64); \
    int ra_ = ra; asm volatile("" : "+v"(ra_)); e0 = ldsx(kn_ + S8_KN, ra_); e1 = ldsx(kn_ + S8_KN + 2048, ra_); } while (0)
#define LDVF(slot) do { int va_ = va; asm volatile("" : "+v"(va_)); const ATT_LAS char* v0_ = lds + S8_VRING + (slot) * S8_V + va_; const ATT_LAS char* v1_ = lds + S8_VRING + (slot) * S8_V + (va_ ^ 32); \
    f0 = lds16x2(v0_, v1_); f1 = lds16x2(v0_ + 2048, v1_ + 2048); f2 = lds16x2(v0_ + 4096, v1_ + 4096); f3 = lds16x2(v0_ + 6144, v1_ + 6144); } while (0)
#define MSEG(DOQK, DOPV, kslot) do { SBAR(); \
    if (DOQK) { \
      c0 = mfma8(a0, qr[0], minit); c1 = mfma8(a1, qr[0], minit); \
      c0 = mfma8(b0, qr[1], c0); c1 = mfma8(b1, qr[1], c1); c0 = mfma8(e0, qr[2], c0); c1 = mfma8(e1, qr[2], c1); } \
    if (DOPV) { if (__any(alpha < 1.f)) { if (hi == 0) al_l[r32] = alpha; asm volatile("s_waitcnt lgkmcnt(0)" ::: "memory"); \
        _Pragma("unroll") for (int d_ = 0; d_ < 4; ++d_) _Pragma("unroll") for (int r_ = 0; r_ < 16; ++r_) o[d_][r_] *= al_l[crow(r_, hi)]; } \
      o[0] = mfma8(pf, f0, o[0]); o[1] = mfma8(pf, f1, o[1]); o[2] = mfma8(pf, f2, o[2]); o[3] = mfma8(pf, f3, o[3]); } \
    if (MODE != 0) asm volatile("" : "+v"(c0), "+v"(c1)); \
    SBAR(); } while (0)
#define VSEG(FIRST, LDK, kn, vn) do { SBAR(); if (MODE != 2) { \
    if (FIRST) { float pm_ = c0[0]; _Pragma("unroll") for (int r_ = 1; r_ < 16; ++r_) pm_ = fmaxf(pm_, c0[r_]); _Pragma("unroll") for (int r_ = 0; r_ < 16; ++r_) pm_ = fmaxf(pm_, c1[r_]); \
      auto rr_ = __builtin_amdgcn_permlane32_swap(__float_as_uint(pm_), __float_as_uint(pm_), false, false); m_reg = fmaxf(__uint_as_float(rr_[0]), __uint_as_float(rr_[1])); alpha = 1.f; \
      const float mn_ = OFF8 - m_reg; _Pragma("unroll") for (int r_ = 0; r_ < 16; ++r_) { c0[r_] += mn_; c1[r_] += mn_; minit[r_] = mn_; } } \
    else { float ma_ = fmaxf(fmaxf(c0[0], c0[1]), c0[2]), mb_ = fmaxf(fmaxf(c1[0], c1[1]), c1[2]), mc_ = fmaxf(fmaxf(c0[3], c0[4]), c0[5]), md_ = fmaxf(fmaxf(c1[3], c1[4]), c1[5]); \
      ma_ = fmaxf(fmaxf(ma_, c0[6]), c0[7]); mb_ = fmaxf(fmaxf(mb_, c1[6]), c1[7]); mc_ = fmaxf(fmaxf(mc_, c0[8]), c0[9]); md_ = fmaxf(fmaxf(md_, c1[8]), c1[9]); \
      ma_ = fmaxf(fmaxf(ma_, c0[10]), c0[11]); mb_ = fmaxf(fmaxf(mb_, c1[10]), c1[11]); mc_ = fmaxf(fmaxf(mc_, c0[12]), c0[13]); md_ = fmaxf(fmaxf(md_, c1[12]), c1[13]); \
      ma_ = fmaxf(fmaxf(ma_, c0[14]), mc_); mb_ = fmaxf(fmaxf(mb_, c1[14]), md_); \
      float pm_ = fmaxf(fmaxf(ma_, mb_), fmaxf(c0[15], c1[15])); \
      auto rr_ = __builtin_amdgcn_permlane32_swap(__float_as_uint(pm_), __float_as_uint(pm_), false, false); pm_ = fmaxf(__uint_as_float(rr_[0]), __uint_as_float(rr_[1])); \
      alpha = 1.f; \
      if (__builtin_expect(__any(pm_ > THRL8 + OFF8), 0)) { const float dl_ = fmaxf(pm_ - OFF8, 0.f); m_reg += dl_; alpha = __builtin_amdgcn_exp2f(-dl_); \
        _Pragma("unroll") for (int r_ = 0; r_ < 16; ++r_) { c0[r_] -= dl_; c1[r_] -= dl_; minit[r_] -= dl_; } } } \
    SBAR(); \
    { _Pragma("unroll") for (int r_ = 0; r_ < 16; ++r_) c0[r_] = __builtin_amdgcn_exp2f(c0[r_]); \
      _Pragma("unroll") for (int r_ = 0; r_ < 16; ++r_) c1[r_] = __builtin_amdgcn_exp2f(c1[r_]); \
      float s0_ = 0.f, s1_ = 0.f, s2_ = 0.f, s3_ = 0.f; \
      _Pragma("unroll") for (int r_ = 0; r_ < 16; r_ += 4) { s0_ += c0[r_]; s1_ += c0[r_ + 1]; s2_ += c0[r_ + 2]; s3_ += c0[r_ + 3]; } \
      _Pragma("unroll") for (int r_ = 0; r_ < 16; r_ += 4) { s0_ += c1[r_]; s1_ += c1[r_ + 1]; s2_ += c1[r_ + 2]; s3_ += c1[r_ + 3]; } \
      float ps_ = (s0_ + s1_) + (s2_ + s3_); auto rr_ = __builtin_amdgcn_permlane32_swap(__float_as_uint(ps_), __float_as_uint(ps_), false, false); ps_ = __uint_as_float(rr_[0]) + __uint_as_float(rr_[1]); \
      l_reg = l_reg * alpha + ps_; asm volatile("" : "+v"(l_reg)); \
      pf = (i32x8){pk4f8(c0[0], c0[1], c0[2], c0[3]), pk4f8(c0[4], c0[5], c0[6], c0[7]), pk4f8(c0[8], c0[9], c0[10], c0[11]), pk4f8(c0[12], c0[13], c0[14], c0[15]), \
                   pk4f8(c1[0], c1[1], c1[2], c1[3]), pk4f8(c1[4], c1[5], c1[6], c1[7]), pk4f8(c1[8], c1[9], c1[10], c1[11]), pk4f8(c1[12], c1[13], c1[14], c1[15])}; } \
    if (MODE != 0) asm volatile("" : "+v"(pf), "+v"(l_reg), "+v"(alpha)); } \
    SBAR(); if (MODE != 3) { if (LDK) LDKF(kn); LDVF(vn); } SBAR(); } while (0)
  asm volatile("s_waitcnt vmcnt(0)" ::: "memory"); __syncthreads();
  LDKF(0);
  if (h1) PBAR();
  MSEG(true, false, 0); PBAR(); VSEG(true, true, 1, 0);
  if (!h1) { PBAR(); DMA_KN8(6, 0); DMA_KR8(6, 0, hidx); }
  else { DMA_KN8(6, 0); PBAR(); }
#define PPWAIT(FULLW) do { if (FULLW) asm volatile("s_waitcnt vmcnt(5) lgkmcnt(0)" ::: "memory"); else asm volatile("s_waitcnt vmcnt(0) lgkmcnt(0)" ::: "memory"); } while (0)
#define PPREFILL(T2, S0, RF) do { constexpr int S2r_ = (S0) == 4 ? 0 : (S0) + 2; \
    if ((RF) == 2) { DMA_KN8((T2) + 7, (S0) + 1); DMA_KN8((T2) + 8, S2r_); if (wid < 4) DMA_KR8((T2) + 7, (S0) + 1, wid); else DMA_KR8((T2) + 8, S2r_, wid - 4); DMA_V8((T2) + 6, (S0)); DMA_V8((T2) + 7, (S0) + 1); } \
    else if ((RF) == 1) { DMA_KN8((T2) + 7, (S0) + 1); if (wid < 4) DMA_KR8((T2) + 7, (S0) + 1, wid); DMA_V8((T2) + 6, (S0)); DMA_V8((T2) + 7, (S0) + 1); } } while (0)
#define PAIRPP(T2, S0, RF, FULLW) do { constexpr int S2_ = (S0) == 4 ? 0 : (S0) + 2; \
    MSEG(MODE != 3, MODE != 3, (S0) + 1); PBAR(); \
    VSEG(false, true, S2_, (S0) + 1); if (h1) PPWAIT(FULLW); PBAR(); \
    MSEG(MODE != 3, MODE != 3, S2_); if (!h1) PPWAIT(FULLW); PBAR(); if (h1) PPREFILL(T2, S0, RF); \
    VSEG(false, true, S2_ + 1, S2_); PBAR(); if (!h1) PPREFILL(T2, S0, RF); } while (0)
  for (int t2 = 0; t2 < 54; t2 += 6) { PAIRPP(t2, 0, 2, true); PAIRPP(t2 + 2, 2, 2, true); PAIRPP(t2 + 4, 4, 2, true); }
  PAIRPP(54, 0, 2, true); PAIRPP(56, 2, 1, true); PAIRPP(58, 4, 0, false); PAIRPP(60, 0, 0, false);
  MSEG(true, true, 3); PBAR(); VSEG(false, false, 0, 3); PBAR(); MSEG(false, true, 0);
  if (!h1) PBAR();
  { const int ln_ = opaque_tid(wave_) & 63, r32e = ln_ & 31, hie = ln_ >> 5;
    if (hie == 0) li_l[r32e] = l_reg; asm volatile("s_waitcnt lgkmcnt(0)" ::: "memory");
    unsigned char* Ow8 = O8b + (long)(wid * QBLK) * ldo + r32e;
#pragma unroll
    for (int r = 0; r < 16; ++r) { const int orow = crow(r, hie); const float rl = __builtin_amdgcn_rcpf(li_l[orow]) * oscale;
      { int w8 = __builtin_amdgcn_cvt_pk_fp8_f32(o[0][r] * rl, o[1][r] * rl, 0, false); w8 = __builtin_amdgcn_cvt_pk_fp8_f32(o[2][r] * rl, o[3][r] * rl, w8, true);
        if (MODE == 0) *(int*)(Ow8 + (long)orow * ldo + 3 * r32e) = w8; else asm volatile("" :: "v"(w8)); } } }
  __syncthreads();
#undef DMA_KN8
#undef DMA_KR8
#undef DMA_V8
#undef PBAR
#undef LDKF
#undef LDVF
#undef MSEG
#undef VSEG
#undef PPWAIT
#undef PPREFILL
#undef PAIRPP
}

template <long VDELTA, int MODE = 0>
__device__ __forceinline__ void attn_mla8ph(const unsigned char* __restrict__ Q8n, int ldqn, const unsigned char* __restrict__ Q8r, int ldqr,
                                            const unsigned char* __restrict__ Kn8, const unsigned char* __restrict__ Kr8,
                                            unsigned char* __restrict__ O8b, int ldo, ATT_LAS char* lds, int wave_, float oscale) {
  constexpr int NT = 64; const unsigned char* Vt8 = Kn8 + VDELTA;
  const int tid = opaque_tid(wave_), wid = wave_, lane = tid & 63, r32 = lane & 31, hi = lane >> 5;
  ATT_LAS float* ws = (ATT_LAS float*)(lds + S8_WS) + wid * 64; ATT_LAS float* li_l = ws; ATT_LAS float* al_l = ws + 32;
  float m_reg = -1e30f, l_reg = 0.f; f32x16 o[4] = {}; i32x8 qr[3];
  const unsigned lds0 = (unsigned)(uintptr_t)lds;
  const bool h1 = wid >= 4;
#define DMA_KN8(j, slot) do { glds16(Kn8 + (size_t)(j) * S8_KN + wid * 1024, (unsigned)lane_id() * 16u, (unsigned)__builtin_amdgcn_readfirstlane((int)(lds0 + (slot) * S8_SLOTK + wid * 1024))); } while (0)
#define DMA_KR8(j, slot, pc) do { glds16(Kr8 + (size_t)(j) * S8_KR + (pc) * 1024, (unsigned)lane_id() * 16u, (unsigned)__builtin_amdgcn_readfirstlane((int)(lds0 + (slot) * S8_SLOTK + S8_KN + (pc) * 1024))); } while (0)
#define DMA_V8(j, slot) do { glds16(Vt8 + (size_t)(j) * S8_V + wid * 1024, (unsigned)lane_id() * 16u, (unsigned)__builtin_amdgcn_readfirstlane((int)(lds0 + S8_VRING + (slot) * S8_V + wid * 1024))); } while (0)
#pragma unroll
  for (int j = 0; j < 6; ++j) { DMA_KN8(j, j); DMA_V8(j, j); }
#pragma unroll
  for (int i = 0; i < 3; ++i) { const int idx = wid + 8 * i; DMA_KR8(idx >> 2, idx >> 2, idx & 3); }
  { const unsigned char* qn = Q8n + (long)(wid * QBLK + r32) * ldqn + hi * 32; const unsigned char* qp = Q8r + (long)(wid * QBLK + r32) * ldqr + hi * 32;
    const i32x4 x0 = *(const i32x4*)qn, x1 = *(const i32x4*)(qn + 16), x2 = *(const i32x4*)(qn + 64), x3 = *(const i32x4*)(qn + 80), x4 = *(const i32x4*)qp, x5 = *(const i32x4*)(qp + 16);
    qr[0] = __builtin_shufflevector(x0, x1, 0, 1, 2, 3, 4, 5, 6, 7); qr[1] = __builtin_shufflevector(x2, x3, 0, 1, 2, 3, 4, 5, 6, 7); qr[2] = __builtin_shufflevector(x4, x5, 0, 1, 2, 3, 4, 5, 6, 7); }
  const int pi = 16 * ((r32 >> 2) & 1) + (r32 & 3) + 4 * (r32 >> 3);
  const int ka = pi * 128 + ((32 * hi) ^ (((pi >> 1) & 7) << 4)), ra = pi * 64 + ((32 * hi) ^ (((pi >> 2) & 3) << 4)), va = r32 * 64 + ((16 * hi) ^ (((r32 >> 2) & 3) << 4));
  f32x16 pA0, pA1, pB0, pB1; float alA = 1.f, alB = 1.f; i32x8 pf = {}, a0 = {}, a1 = {}, b0 = {}, b1 = {}, f0 = {}, f1 = {}, f2 = {}, f3 = {};
#define PBAR() do { __builtin_amdgcn_s_barrier(); asm volatile("" ::: "memory"); } while (0)
#define LDKF(slot) do { int ka_ = ka; asm volatile("" : "+v"(ka_)); const ATT_LAS char* kn_ = lds + (slot) * S8_SLOTK; a0 = ldsx(kn_, ka_); a1 = ldsx(kn_ + 4096, ka_); b0 = ldsx(kn_, ka_ ^ 64); b1 = ldsx(kn_ + 4096, ka_ ^ 64); } while (0)
#define LDVF(slot) do { int va_ = va; asm volatile("" : "+v"(va_)); const ATT_LAS char* v0_ = lds + S8_VRING + (slot) * S8_V + va_; const ATT_LAS char* v1_ = lds + S8_VRING + (slot) * S8_V + (va_ ^ 32); \
    f0 = lds16x2(v0_, v1_); f1 = lds16x2(v0_ + 2048, v1_ + 2048); f2 = lds16x2(v0_ + 4096, v1_ + 4096); f3 = lds16x2(v0_ + 6144, v1_ + 6144); } while (0)
#define RESC8(a) do { if (__any((a) < 1.f)) { if (hi == 0) al_l[r32] = (a); asm volatile("s_waitcnt lgkmcnt(0)" ::: "memory"); \
    _Pragma("unroll") for (int d = 0; d < 4; ++d) _Pragma("unroll") for (int r = 0; r < 16; ++r) o[d][r] *= al_l[crow(r, hi)]; } } while (0)
#define MSEG(DOQK, DOPV, C0, C1, P0, P1, alP, kslot) do { SBAR(); \
    seg1_8<DOQK, DOPV, false>(C0, C1, lds + (kslot) * S8_SLOTK, ra, qr, a0, a1, b0, b1, P0, P1, alP, l_reg, pf, lds, va, f0, f1, f2, f3); \
    if (DOPV) { RESC8(alP); seg2_8<true, false, false>(o, f0, f1, f2, f3, pf, C0, C1, m_reg, alP, lds, ka, a0, a1, b0, b1); } SBAR(); } while (0)
#define VSEG(C0, C1, alC, LDK, kn, vn) do { SBAR(); seg2_8<false, true, false>(o, f0, f1, f2, f3, pf, C0, C1, m_reg, alC, lds, ka, a0, a1, b0, b1); SBAR(); if (LDK) LDKF(kn); LDVF(vn); SBAR(); } while (0)
  asm volatile("s_waitcnt vmcnt(0)" ::: "memory"); __syncthreads();
  LDKF(0);
  if (h1) PBAR();
  { float one_ = 1.f; MSEG(true, false, pA0, pA1, pA0, pA1, one_, 0); } PBAR();
  { SBAR(); float pmax = pA0[0];
#pragma unroll
    for (int r = 1; r < 16; ++r) pmax = fmaxf(pmax, pA0[r]);
#pragma unroll
    for (int r = 0; r < 16; ++r) pmax = fmaxf(pmax, pA1[r]);
    auto rr = __builtin_amdgcn_permlane32_swap(__float_as_uint(pmax), __float_as_uint(pmax), false, false); pmax = fmaxf(__uint_as_float(rr[0]), __uint_as_float(rr[1]));
    m_reg = pmax; const float mnC = fmaf(-m_reg, SC8, OFF8);
#pragma unroll
    for (int r = 0; r < 16; ++r) { pA0[r] = __builtin_amdgcn_exp2f(fmaf(pA0[r], SC8, mnC)); pA1[r] = fmaf(pA1[r], SC8, mnC); }
    SBAR(); LDKF(1); LDVF(0); SBAR(); }
  if (!h1) { PBAR(); DMA_KN8(6, 0); DMA_KR8(6, 0, wid); }
  else { DMA_KN8(6, 0); PBAR(); }
#define PPWAIT(FULLW) do { if (FULLW) asm volatile("s_waitcnt vmcnt(5) lgkmcnt(0)" ::: "memory"); else asm volatile("s_waitcnt vmcnt(0) lgkmcnt(0)" ::: "memory"); } while (0)
#define PPREFILL(T2, S0, RF) do { constexpr int S2r_ = (S0) == 4 ? 0 : (S0) + 2; \
    if ((RF) == 2) { DMA_KN8((T2) + 7, (S0) + 1); DMA_KN8((T2) + 8, S2r_); if (wid < 4) DMA_KR8((T2) + 7, (S0) + 1, wid); else DMA_KR8((T2) + 8, S2r_, wid - 4); DMA_V8((T2) + 6, (S0)); DMA_V8((T2) + 7, (S0) + 1); } \
    else if ((RF) == 1) { DMA_KN8((T2) + 7, (S0) + 1); if (wid < 4) DMA_KR8((T2) + 7, (S0) + 1, wid); DMA_V8((T2) + 6, (S0)); DMA_V8((T2) + 7, (S0) + 1); } } while (0)
#define PAIRPH(T2, S0, RF, FULLW) do { constexpr int S2_ = (S0) == 4 ? 0 : (S0) + 2; \
    MSEG(true, true, pB0, pB1, pA0, pA1, alA, (S0) + 1); PBAR(); \
    VSEG(pB0, pB1, alB, true, S2_, (S0) + 1); if (h1) PPWAIT(FULLW); PBAR(); \
    MSEG(true, true, pA0, pA1, pB0, pB1, alB, S2_); if (!h1) PPWAIT(FULLW); PBAR(); if (h1) PPREFILL(T2, S0, RF); \
    VSEG(pA0, pA1, alA, true, S2_ + 1, S2_); PBAR(); if (!h1) PPREFILL(T2, S0, RF); } while (0)
  for (int t2 = 0; t2 < 54; t2 += 6) { PAIRPH(t2, 0, 2, true); PAIRPH(t2 + 2, 2, 2, true); PAIRPH(t2 + 4, 4, 2, true); }
  PAIRPH(54, 0, 2, true); PAIRPH(56, 2, 1, true); PAIRPH(58, 4, 0, false); PAIRPH(60, 0, 0, false);
  MSEG(true, true, pB0, pB1, pA0, pA1, alA, 3); PBAR(); VSEG(pB0, pB1, alB, false, 0, 3); PBAR(); MSEG(false, true, pA0, pA1, pB0, pB1, alB, 0);
  if (!h1) PBAR();
  { const int ln_ = opaque_tid(wave_) & 63, r32e = ln_ & 31, hie = ln_ >> 5;
    if (hie == 0) li_l[r32e] = l_reg; asm volatile("s_waitcnt lgkmcnt(0)" ::: "memory");
    unsigned char* Ow8 = O8b + (long)(wid * QBLK) * ldo + r32e;
#pragma unroll
    for (int r = 0; r < 16; ++r) { const int orow = crow(r, hie); const float rl = __builtin_amdgcn_rcpf(li_l[orow]) * oscale;
      { int w8 = __builtin_amdgcn_cvt_pk_fp8_f32(o[0][r] * rl, o[1][r] * rl, 0, false); w8 = __builtin_amdgcn_cvt_pk_fp8_f32(o[2][r] * rl, o[3][r] * rl, w8, true);
        if (MODE == 0) *(int*)(Ow8 + (long)orow * ldo + 3 * r32e) = w8; else asm volatile("" :: "v"(w8)); } } }
  __syncthreads();
#undef DMA_KN8
#undef DMA_KR8
#undef DMA_V8
#undef PBAR
#undef LDKF
#undef LDVF
#undef RESC8
#undef MSEG
#undef VSEG
#undef PPWAIT
#undef PPREFILL
#undef PAIRPH
}

constexpr int S9_RB = 6 * S8_KN, S9_VB = S9_RB + 6 * S8_KR;
static_assert(S9_VB + 6 * S8_V == S8_WS, "attn_mla9 LDS map");
__device__ __forceinline__ i32x8 ld2(const ATT_LAS char* p, const ATT_LAS char* q) { const i32x4 a = *(const ATT_LAS i32x4*)p, b = *(const ATT_LAS i32x4*)q; return __builtin_shufflevector(a, b, 0, 1, 2, 3, 4, 5, 6, 7); }
struct Adr9 { const ATT_LAS char* k0; const ATT_LAS char* k1; const ATT_LAS char* k2; const ATT_LAS char* k3; const ATT_LAS char* r0; const ATT_LAS char* r1; const ATT_LAS char* v0; const ATT_LAS char* v1; };
template <bool DOMMA, bool DOFILL, bool LDV, int RO, int VO>
__device__ __forceinline__ void seg1_9(f32x16& c0, f32x16& c1, const Adr9& A, const i32x8 (&qr)[3], i32x8& a0, i32x8& a1, i32x8& b0, i32x8& b1,
                                       f32x16& p0, f32x16& p1, float alP, float& l_reg, i32x8& pf, i32x8& f0, i32x8& f1, const f32x16& z) {
  float s0 = 0.f, s1 = 0.f;
#define E4(P, b) do { P[b] = g_exp2(P[b]); P[(b) + 1] = g_exp2(P[(b) + 1]); P[(b) + 2] = g_exp2(P[(b) + 2]); P[(b) + 3] = g_exp2(P[(b) + 3]); } while (0)
#define A4(P, b) do { s0 = g_add(s0, P[b]); s1 = g_add(s1, P[(b) + 1]); s0 = g_add(s0, P[(b) + 2]); s1 = g_add(s1, P[(b) + 3]); } while (0)
  if (DOMMA) c0 = mfma8(a0, qr[0], z);
  if (DOFILL) { pf[0] = pk4f8o(pf[0], p0[0], p0[1], p0[2], p0[3]); pf[1] = pk4f8o(pf[1], p0[4], p0[5], p0[6], p0[7]); pf[2] = pk4f8o(pf[2], p0[8], p0[9], p0[10], p0[11]); pf[3] = pk4f8o(pf[3], p0[12], p0[13], p0[14], p0[15]); A4(p0, 0); A4(p0, 4); }
  SBAR();
  if (DOMMA) { c1 = mfma8(a1, qr[0], z); a0 = ld2(A.r0 + RO, A.r1 + RO); a1 = ld2(A.r0 + RO + 2048, A.r1 + RO + 2048); }
  if (DOFILL) { E4(p1, 0); A4(p0, 8); A4(p0, 12); }
  SBAR();
  if (DOMMA) c0 = mfma8(b0, qr[1], c0);
  if (LDV) { f0 = ld2(A.v0 + VO, A.v1 + VO); f1 = ld2(A.v0 + VO + 2048, A.v1 + VO + 2048); }
  if (DOFILL) { E4(p1, 4); A4(p1, 0); }
  SBAR();
  if (DOMMA) c1 = mfma8(b1, qr[1], c1);
  if (DOFILL) { E4(p1, 8); A4(p1, 4); }
  SBAR();
  if (DOMMA) c0 = mfma8(a0, qr[2], c0);
  if (DOFILL) { E4(p1, 12); A4(p1, 8); pf[4] = pk4f8o(pf[4], p1[0], p1[1], p1[2], p1[3]); pf[5] = pk4f8o(pf[5], p1[4], p1[5], p1[6], p1[7]); }
  SBAR();
  if (DOMMA) c1 = mfma8(a1, qr[2], c1);
  if (DOFILL) { A4(p1, 12); pf[6] = pk4f8o(pf[6], p1[8], p1[9], p1[10], p1[11]); pf[7] = pk4f8o(pf[7], p1[12], p1[13], p1[14], p1[15]);
    float ps = g_add(s0, s1); auto rr = __builtin_amdgcn_permlane32_swap(__float_as_uint(ps), __float_as_uint(ps), false, false); ps = __uint_as_float(rr[0]) + __uint_as_float(rr[1]);
    l_reg = l_reg * alP + ps; }
  SBAR();
#undef E4
#undef A4
}
template <bool DOMMA, bool DOSM, bool LDK, int KNO, int VO>
__device__ __forceinline__ void seg2_9(f32x16 (&o)[4], const Adr9& A, i32x8 f0, i32x8 f1, i32x8 pf, f32x16& c0, f32x16& c1, float& m_reg, float& alpha, i32x8& a0, i32x8& a1, i32x8& b0, i32x8& b1, f32x16& mi) {
  float ma = -1e30f, mb = -1e30f; i32x8 f2, f3;
#define MX4(V, b) do { ma = g_max3(ma, V[b], V[(b) + 1]); mb = g_max3(mb, V[(b) + 2], V[(b) + 3]); } while (0)
#define E4(P, b) do { P[b] = g_exp2(P[b]); P[(b) + 1] = g_exp2(P[(b) + 1]); P[(b) + 2] = g_exp2(P[(b) + 2]); P[(b) + 3] = g_exp2(P[(b) + 3]); } while (0)
  if (DOMMA) { o[0] = mfma8(pf, f0, o[0]); f2 = ld2(A.v0 + VO + 4096, A.v1 + VO + 4096); }
  if (DOSM) { MX4(c0, 0); MX4(c0, 4); MX4(c0, 8); MX4(c0, 12); }
  SBAR();
  if (DOMMA) { o[1] = mfma8(pf, f1, o[1]); f3 = ld2(A.v0 + VO + 6144, A.v1 + VO + 6144); }
  if (LDK) { a0 = ld2(A.k0 + KNO, A.k1 + KNO); a1 = ld2(A.k0 + KNO + 4096, A.k1 + KNO + 4096); }
  if (DOSM) { MX4(c1, 0); MX4(c1, 4); MX4(c1, 8); MX4(c1, 12); }
  SBAR();
  if (DOMMA) o[2] = mfma8(pf, f2, o[2]);
  if (LDK) { b0 = ld2(A.k2 + KNO, A.k3 + KNO); b1 = ld2(A.k2 + KNO + 4096, A.k3 + KNO + 4096); }
  if (DOSM) { float pmax = g_max3(ma, mb, mb); auto rr = __builtin_amdgcn_permlane32_swap(__float_as_uint(pmax), __float_as_uint(pmax), false, false);
    pmax = g_max3(__uint_as_float(rr[0]), __uint_as_float(rr[1]), __uint_as_float(rr[1]));
    alpha = 1.f;
    if (__builtin_expect(__any(pmax > THRL8 + OFF8), 0)) {
      const float dl = fmaxf(pmax - OFF8, 0.f); m_reg += dl; alpha = __builtin_amdgcn_exp2f(-dl);
#pragma unroll
      for (int r = 0; r < 16; ++r) { c0[r] -= dl; c1[r] -= dl; mi[r] -= dl; } }
    E4(c0, 0); }
  SBAR();
  if (DOMMA) o[3] = mfma8(pf, f3, o[3]);
  if (DOSM) { E4(c0, 4); E4(c0, 8); E4(c0, 12); }
  SBAR();
#undef MX4
#undef E4
}
template <long VDELTA, int MODE = 0>
__device__ __forceinline__ void attn_mla9(const unsigned char* __restrict__ Q8n, int ldqn, const unsigned char* __restrict__ Q8r, int ldqr,
                                          const unsigned char* __restrict__ Kn8, const unsigned char* __restrict__ Kr8,
                                          unsigned char* __restrict__ O8b, int ldo, ATT_LAS char* lds, int wave_, float oscale) {
  static_assert(MLA8_PRESCALE && MODE == 0, "attn_mla9 takes pre-scaled q / k");
  constexpr int NT = 64; const unsigned char* Vt8 = Kn8 + VDELTA;
  const int tid = opaque_tid(wave_), wid = wave_, lane = tid & 63, r32 = lane & 31, hi = lane >> 5;
  ATT_LAS float* ws = (ATT_LAS float*)(lds + S8_WS) + wid * 64; ATT_LAS float* li_l = ws; ATT_LAS float* al_l = ws + 32;
  float m_reg = -1e30f, l_reg = 0.f; f32x16 o[4] = {}; i32x8 qr[3];
  const unsigned lds0 = (unsigned)(uintptr_t)lds;
#define DMA9_KN(j, slot, vo) glds16(Kn8 + (size_t)(j) * S8_KN + wid * 1024, (vo), (unsigned)__builtin_amdgcn_readfirstlane((int)(lds0 + (slot) * S8_KN + wid * 1024)))
#define DMA9_KR(j, slot, pc, vo) glds16(Kr8 + (size_t)(j) * S8_KR + (pc) * 1024, (vo), (unsigned)__builtin_amdgcn_readfirstlane((int)(lds0 + S9_RB + (slot) * S8_KR + (pc) * 1024)))
#define DMA9_V(j, slot, vo) glds16(Vt8 + (size_t)(j) * S8_V + wid * 1024, (vo), (unsigned)__builtin_amdgcn_readfirstlane((int)(lds0 + S9_VB + (slot) * S8_V + wid * 1024)))
  { const unsigned vo_ = (unsigned)lane_id() * 16u;
#pragma unroll
    for (int j = 0; j < 6; ++j) { DMA9_KN(j, j, vo_); DMA9_V(j, j, vo_); }
#pragma unroll
    for (int i = 0; i < 3; ++i) { const int idx = wid + 8 * i; DMA9_KR(idx >> 2, idx >> 2, idx & 3, vo_); } }
  { const unsigned char* qn = Q8n + (long)(wid * QBLK + r32) * ldqn + hi * 32; const unsigned char* qp = Q8r + (long)(wid * QBLK + r32) * ldqr + hi * 32;
    const i32x4 x0 = *(const i32x4*)qn, x1 = *(const i32x4*)(qn + 16), x2 = *(const i32x4*)(qn + 64), x3 = *(const i32x4*)(qn + 80), x4 = *(const i32x4*)qp, x5 = *(const i32x4*)(qp + 16);
    qr[0] = __builtin_shufflevector(x0, x1, 0, 1, 2, 3, 4, 5, 6, 7); qr[1] = __builtin_shufflevector(x2, x3, 0, 1, 2, 3, 4, 5, 6, 7); qr[2] = __builtin_shufflevector(x4, x5, 0, 1, 2, 3, 4, 5, 6, 7); }
  const int pi = 16 * ((r32 >> 2) & 1) + (r32 & 3) + 4 * (r32 >> 3);
  const int ka = pi * 128 + ((32 * hi) ^ (((pi >> 1) & 7) << 4)), ra = pi * 64 + ((32 * hi) ^ (((pi >> 2) & 3) << 4)), va = r32 * 64 + ((16 * hi) ^ (((r32 >> 2) & 3) << 4));
  const Adr9 A{lds + ka, lds + (ka ^ 16), lds + (ka ^ 64), lds + (ka ^ 80), lds + S9_RB + ra, lds + S9_RB + (ra ^ 16), lds + S9_VB + va, lds + S9_VB + (va ^ 32)};
#define RESC9(a) do { if (__any((a) < 1.f)) { if (hi == 0) al_l[r32] = (a); asm volatile("s_waitcnt lgkmcnt(0)" ::: "memory"); \
    _Pragma("unroll") for (int d = 0; d < 4; ++d) _Pragma("unroll") for (int r = 0; r < 16; ++r) o[d][r] *= al_l[crow(r, hi)]; } } while (0)
#define LDK9(KO) do { a0 = ld2(A.k0 + (KO), A.k1 + (KO)); a1 = ld2(A.k0 + (KO) + 4096, A.k1 + (KO) + 4096); b0 = ld2(A.k2 + (KO), A.k3 + (KO)); b1 = ld2(A.k2 + (KO) + 4096, A.k3 + (KO) + 4096); } while (0)
  f32x16 pA0, pA1, pB0, pB1, minit = {}; float alA = 1.f, alB = 1.f; i32x8 pf = {}, a0 = {}, a1 = {}, b0 = {}, b1 = {}, f0 = {}, f1 = {};
  asm volatile("s_waitcnt vmcnt(0)" ::: "memory"); __syncthreads();
  LDK9(0);
  { const f32x16 z = {}; seg1_9<true, false, false, 0, 0>(pA0, pA1, A, qr, a0, a1, b0, b1, pA0, pA1, 1.f, l_reg, pf, f0, f1, z); }
  { float pmax = pA0[0];
#pragma unroll
    for (int r = 1; r < 16; ++r) pmax = fmaxf(pmax, pA0[r]);
#pragma unroll
    for (int r = 0; r < 16; ++r) pmax = fmaxf(pmax, pA1[r]);
    auto rr = __builtin_amdgcn_permlane32_swap(__float_as_uint(pmax), __float_as_uint(pmax), false, false); pmax = fmaxf(__uint_as_float(rr[0]), __uint_as_float(rr[1]));
    m_reg = pmax; const float mnC = OFF8 - m_reg;
#pragma unroll
    for (int r = 0; r < 16; ++r) { pA0[r] = __builtin_amdgcn_exp2f(pA0[r] + mnC); pA1[r] = pA1[r] + mnC; minit[r] = mnC; } }
  asm volatile("s_waitcnt lgkmcnt(0)" ::: "memory"); __builtin_amdgcn_s_barrier(); asm volatile("" ::: "memory");
  { const unsigned vo_ = (unsigned)lane_id() * 16u; DMA9_KN(6, 0, vo_); if (wid < 4) DMA9_KR(6, 0, wid, vo_); }
  LDK9(S8_KN);
#define SUB9(C0, C1, alC, P0, P1, alP, KS, VS, LDKN, KNX) do { \
    SBAR(); seg1_9<true, true, true, (KS) * S8_KR, (VS) * S8_V>(C0, C1, A, qr, a0, a1, b0, b1, P0, P1, alP, l_reg, pf, f0, f1, minit); \
    SBAR(); seg2_9<true, true, LDKN, (KNX) * S8_KN, (VS) * S8_V>(o, A, f0, f1, pf, C0, C1, m_reg, alC, a0, a1, b0, b1, minit); SBAR(); \
    RESC9(alC); } while (0)
#define PAIR9(T2, S0, FULL) do { constexpr int S2_ = (S0) == 4 ? 0 : (S0) + 2; \
    SUB9(pB0, pB1, alB, pA0, pA1, alA, (S0) + 1, (S0), true, S2_); \
    SUB9(pA0, pA1, alA, pB0, pB1, alB, S2_, (S0) + 1, false, 0); \
    if (FULL) asm volatile("s_waitcnt vmcnt(5) lgkmcnt(0)" ::: "memory"); else asm volatile("s_waitcnt vmcnt(0) lgkmcnt(0)" ::: "memory"); \
    __builtin_amdgcn_s_barrier(); asm volatile("" ::: "memory"); \
    { const unsigned vo_ = (unsigned)lane_id() * 16u; \
      if (FULL) { DMA9_KN((T2) + 7, (S0) + 1, vo_); DMA9_KN((T2) + 8, S2_, vo_); if (wid < 4) DMA9_KR((T2) + 7, (S0) + 1, wid, vo_); else DMA9_KR((T2) + 8, S2_, wid - 4, vo_); DMA9_V((T2) + 6, (S0), vo_); DMA9_V((T2) + 7, (S0) + 1, vo_); } \
      else { if ((T2) + 7 < NT) { DMA9_KN((T2) + 7, (S0) + 1, vo_); if (wid < 4) DMA9_KR((T2) + 7, (S0) + 1, wid, vo_); } if ((T2) + 6 < NT) DMA9_V((T2) + 6, (S0), vo_); if ((T2) + 7 < NT) DMA9_V((T2) + 7, (S0) + 1, vo_); } } \
    LDK9((S2_ + 1) * S8_KN); } while (0)
  for (int t2 = 0; t2 < 54; t2 += 6) { PAIR9(t2, 0, true); PAIR9(t2 + 2, 2, true); PAIR9(t2 + 4, 4, true); }
  PAIR9(54, 0, true); PAIR9(56, 2, false); PAIR9(58, 4, false); PAIR9(60, 0, false);
  SUB9(pB0, pB1, alB, pA0, pA1, alA, 3, 2, false, 0);
  seg1_9<false, true, true, 0, 3 * S8_V>(pA0, pA1, A, qr, a0, a1, b0, b1, pB0, pB1, alB, l_reg, pf, f0, f1, minit);
  seg2_9<true, false, false, 0, 3 * S8_V>(o, A, f0, f1, pf, pA0, pA1, m_reg, alA, a0, a1, b0, b1, minit);
  { const int ln_ = opaque_tid(wave_) & 63, r32e = ln_ & 31, hie = ln_ >> 5;
    if (hie == 0) li_l[r32e] = l_reg; asm volatile("s_waitcnt lgkmcnt(0)" ::: "memory");
    unsigned char* Ow8 = O8b + (long)(wid * QBLK) * ldo + r32e;
#pragma unroll
    for (int r = 0; r < 16; ++r) { const int orow = crow(r, hie); const float rl = __builtin_amdgcn_rcpf(li_l[orow]) * oscale;
      int w8 = __builtin_amdgcn_cvt_pk_fp8_f32(o[0][r] * rl, o[1][r] * rl, 0, false); w8 = __builtin_amdgcn_cvt_pk_fp8_f32(o[2][r] * rl, o[3][r] * rl, w8, true);
      *(int*)(Ow8 + (long)orow * ldo + 3 * r32e) = w8; } }
  __syncthreads();
#undef DMA9_KN
#undef DMA9_KR
#undef DMA9_V
#undef RESC9
#undef LDK9
#undef SUB9
#undef PAIR9
}
#undef SBAR
}
#define GAS __attribute__((address_space(1)))
#define LAS __attribute__((address_space(3)))
typedef unsigned short bf16;
typedef unsigned v4u __attribute__((ext_vector_type(4)));
typedef float f32x4 __attribute__((ext_vector_type(4)));
typedef short bf16x8 __attribute__((ext_vector_type(8)));
typedef GAS unsigned gu32;
typedef GAS unsigned long long gu64;
#define RLX_AGENT __ATOMIC_RELAXED, __HIP_MEMORY_SCOPE_AGENT
#define LDS_WAIT() asm volatile("s_waitcnt lgkmcnt(0)" ::: "memory")
#define VM_WAIT() asm volatile("s_waitcnt vmcnt(0)" ::: "memory")
__device__ __forceinline__ unsigned long long rt() { return __builtin_amdgcn_s_memrealtime(); }
__device__ __forceinline__ unsigned f2bf(float f) { unsigned u = __builtin_bit_cast(unsigned, f); return (u + 0x7fffu + ((u >> 16) & 1u)) >> 16; }
__device__ __forceinline__ unsigned pk2(float lo, float hi) { return f2bf(lo) | (f2bf(hi) << 16); }

#define XB_TMO      128
#define XB_XCNT(j)  (256  + 64 * (j))
#define XB_XSUB(j)  (1280 + 64 * (j))
#define XB_XGEN(j)  (2304 + 64 * (j))
#define XB_TOP      3328
#define XB_TOPGEN   3392
#define XCD_BAR_WORDS 3456
#define XB_SPIN_CAP (1u << 18)

__device__ __forceinline__ unsigned xb_ld(unsigned* p)              { return __hip_atomic_load(p, __ATOMIC_RELAXED, __HIP_MEMORY_SCOPE_AGENT); }
__device__ __forceinline__ unsigned xb_add(unsigned* p, unsigned v) { return __hip_atomic_fetch_add(p, v, __ATOMIC_RELAXED, __HIP_MEMORY_SCOPE_AGENT); }
__device__ __forceinline__ unsigned xb_xcc_id() { return (unsigned)__builtin_amdgcn_s_getreg((3 << 11) | 20) & 0xFu; }
#define XB_SPIN(cond, bar) do { unsigned _sp = 0; while (cond) { __builtin_amdgcn_s_sleep(1); \
    if ((++_sp & 255u) == 0u) { if (xb_ld(&(bar)[XB_TMO])) break; if (_sp > XB_SPIN_CAP) { atomicAdd(&(bar)[XB_TMO], 1u); break; } } } } while (0)

struct XcdBarrier {
    unsigned* bar; unsigned x;
    volatile LAS unsigned* st;
};

__device__ __forceinline__ XcdBarrier xcd_barrier_post(unsigned* bar, volatile LAS unsigned* st, bool t0) {
    XcdBarrier b; b.bar = bar; b.x = xb_xcc_id(); b.st = st;
    if (t0) (void)xb_add(&bar[XB_XCNT(b.x)], 1u);
    return b;
}
__device__ __forceinline__ void xcd_barrier_complete(unsigned* bar, unsigned x, unsigned& nloc, unsigned& nx) {
    const unsigned G = gridDim.x * gridDim.y * gridDim.z;
    unsigned sum, cnt, mine, sp = 0u;
    for (;;) {
        sum = 0u; cnt = 0u; mine = 0u;
#pragma unroll
        for (unsigned j = 0; j < 16; ++j) { const unsigned c = xb_ld(&bar[XB_XCNT(j)]); sum += c; cnt += (c > 0u) ? 1u : 0u; mine = (j == x) ? c : mine; }
        if (sum == G) break;
        __builtin_amdgcn_s_sleep(1);
        if ((++sp & 255u) == 0u) { if (xb_ld(&bar[XB_TMO])) break; if (sp > XB_SPIN_CAP) { atomicAdd(&bar[XB_TMO], 1u); break; } }
    }
    nloc = mine > 0u ? mine : 1u; nx = cnt > 0u ? cnt : 1u;
}

__device__ __forceinline__ void xcd_barrier(const XcdBarrier& b, bool t0) {
    asm volatile("s_waitcnt vmcnt(0)" ::: "memory");
    __syncthreads();
    if (t0) {
        unsigned* bar = b.bar;
        __builtin_amdgcn_s_waitcnt(0);
        unsigned nloc = b.st[0], nx = b.st[1];
        if (nloc == 0u) { xcd_barrier_complete(bar, b.x, nloc, nx); b.st[0] = nloc; b.st[1] = nx; }
        const unsigned old = xb_add(&bar[XB_XSUB(b.x)], 1u);
        const unsigned gen = old / nloc;
        if (old + 1u == (gen + 1u) * nloc) {
            __builtin_amdgcn_fence(__ATOMIC_RELEASE, "agent");
            asm volatile("s_waitcnt vmcnt(0)" ::: "memory");
            const unsigned og = xb_add(&bar[XB_TOP], 1u);
            const unsigned tg = og / nx;
            if (og + 1u == (tg + 1u) * nx) xb_add(&bar[XB_TOPGEN], 1u);
            else XB_SPIN(xb_ld(&bar[XB_TOPGEN]) == tg, bar);
            __builtin_amdgcn_fence(__ATOMIC_ACQUIRE, "agent");
            xb_add(&bar[XB_XGEN(b.x)], 1u);
            asm volatile("s_waitcnt vmcnt(0)" ::: "memory");
        } else {
            XB_SPIN(xb_ld(&bar[XB_XGEN(b.x)]) == gen, bar);
            __builtin_amdgcn_fence(__ATOMIC_ACQUIRE, "agent");
            asm volatile("s_waitcnt vmcnt(0)" ::: "memory");
        }
    }
    __syncthreads();
}
#ifndef DIAG
#define DIAG 0
#endif
#ifndef DIAG_LA
#define DIAG_LA 0
#endif
#ifndef DIAG_LB
#define DIAG_LB 1
#endif
#ifndef DIAG_LF
#define DIAG_LF 0
#endif
#if DIAG
namespace dg {
constexpr int NS = 8, CW_DG = 8192, NCHK = 16;
__device__ __forceinline__ float bf(unsigned short v) { return __uint_as_float((unsigned)v << 16); }
#ifndef DIAG_SR
#define DIAG_SR 0
#endif
__device__ __forceinline__ int srow(int i) {
#if DIAG_SR == 0
    switch (i) { case 0: return 0; case 1: return 1; case 2: return 255; case 3: return 256; case 4: return 4095; case 5: return 4096; case 6: return 36863; default: return 49151; }
#elif DIAG_SR == 1
    switch (i) { case 0: return 15; case 1: return 16; case 2: return 63; case 3: return 64; case 4: return 127; case 5: return 128; case 6: return 20005; default: return 191; }
#else
    switch (i) { case 0: return 300; case 1: return 2050; case 2: return 8191; case 3: return 12345; case 4: return 33000; case 5: return 40959; case 6: return 45001; default: return 47 ; }
#endif
}
__device__ __forceinline__ float dotA(const unsigned short* a, const float* W, int K, int N, int n) { float s = 0.f; for (int k = 0; k < K; ++k) s += bf(a[k]) * W[(size_t)k * N + n]; return s; }
__device__ __forceinline__ float wsum(float v) {
#pragma unroll
    for (int o = 1; o < 64; o <<= 1) v += __shfl_xor(v, o);
    return v; }
__device__ __forceinline__ void flush(float* acc, int k, float e2, float r2) { e2 = wsum(e2); r2 = wsum(r2); if ((opaque_tid() & 63) == 0) { atomicAdd(acc + 2 * k, e2); atomicAdd(acc + 2 * k + 1, r2); } }
__device__ __forceinline__ int il128(int d) { return d < 64 ? 2 * d : 2 * (d - 64) + 1; }
__device__ __forceinline__ int il64(int d) { return d < 32 ? 2 * d : 2 * (d - 32) + 1; }
__device__ __forceinline__ void ropecs(int pos, int j, int dim, float& c, float& s) { const float inv = exp2f(-((float)(2 * j) / (float)dim) * 13.287712379549449f); const float a = (float)pos * inv; c = cosf(a); s = sinf(a); }
#ifndef DIAG_CK
#define DIAG_CK -1
#endif
#define DG_ACC(k, ri, e2, r2, got, ref) do { const float g_ = (got), r_ = (ref); (e2) += (g_ - r_) * (g_ - r_); (r2) += r_ * r_; \
    if ((k) == DIAG_CK) { atomicAdd(dacc + 2 * (16 + (ri)), (g_ - r_) * (g_ - r_)); atomicAdd(dacc + 2 * (16 + (ri)) + 1, r_ * r_); } } while (0)
}
#endif
constexpr int NWAVES = 8;
#ifndef PH_MASK
#define PH_MASK 0xFFFF
#endif
#ifndef DIAG_CLK
#define DIAG_CLK 0
#endif
#ifndef FOUT_REV
#define FOUT_REV 0
#endif
#ifndef FINAL_BF16
#define FINAL_BF16 1
#endif
#ifndef QKV8_L2
#define QKV8_L2 1
#endif
#ifndef MLA8_FN
#define MLA8_FN attn_mla9
#endif
#ifndef DIAG_MLA8
#define DIAG_MLA8 0
#endif
#ifndef STAGGER_TICKS
#define STAGGER_TICKS 0
#endif
#ifndef PG8_SP2X
#define PG8_SP2X true
#endif
#ifndef PG8_ALIGNX
#define PG8_ALIGNX true
#endif
#ifndef FFN_CHUNKS
#define FFN_CHUNKS 1
#endif
#ifndef WGM_FIN
#define WGM_FIN 4
#endif
#ifndef WGM_FOUT
#define WGM_FOUT 4
#endif
#ifndef WGM_REST
#define WGM_REST 4
#endif
#ifndef PROBE_BARS
#define PROBE_BARS 0
#endif
#ifndef PROBE_FIN
#define PROBE_FIN 1
#endif
#ifndef PROBE_FIN_NULL
#define PROBE_FIN_NULL 0
#endif
#ifndef PROBE_QKV
#define PROBE_QKV 1
#endif
#ifndef PROBE_WOA
#define PROBE_WOA 1
#endif
#ifndef PROBE_BWIN
#define PROBE_BWIN 1
#endif
#ifndef PROBE_UP
#define PROBE_UP 1
#endif
#ifndef PROBE_WOB
#define PROBE_WOB 1
#endif
#ifndef PROBE_FOUT
#define PROBE_FOUT 1
#endif
#ifndef PROBE_MLA
#define PROBE_MLA 1
#endif
#ifndef PROBE_WIN
#define PROBE_WIN 1
#endif
#ifndef PROBE_NORM
#define PROBE_NORM 1
#endif
#ifndef PROBE_P0
#define PROBE_P0 1
#endif
constexpr int DM = 2048, SEQ = 4096, NSEQ = 12, M = NSEQ * SEQ, DEPTH = 4, M_PROMPT = 8 * SEQ;
constexpr int NH = 16, HD = 128, NKV = 4, NQKV = (NH + 2 * NKV) * HD;
constexpr int QL = 512, KVL = 512, ROPE = 64, NOPE = 128, VD = 128;
constexpr int BWIN_N = QL + KVL + ROPE, BWIN_NP = 1280;
constexpr int NQUP = NH * (NOPE + ROPE), NKVUP = NH * (NOPE + VD);
constexpr int DFF = 5632, DFF2 = 2 * DFF;
constexpr float EPS = 1e-6f;
constexpr float W8_WO = 32.f, W8_UP = 16.f, O8_A = 16.f, O8_B = 32.f;
constexpr int NTILE_M = M / 256;

constexpr size_t MiB = 1u << 20;
constexpr size_t WS_CTL = 0, CTL_ZERO_BYTES = 1 * MiB;
constexpr size_t WS_COSA = 1 * MiB, WS_SINA = 2 * MiB, WS_COSB = 3 * MiB, WS_SINB = 3 * MiB + 512 * 1024;
constexpr size_t WS_RS = 4 * MiB, WS_RSQ = WS_RS + 256 * 1024, WS_RSK = WS_RSQ + 256 * 1024;
constexpr size_t WS_SSP = 5 * MiB;
constexpr size_t WS_WQKV = 11 * MiB;
constexpr size_t WS_WOA  = WS_WQKV + 2 * (size_t)NQKV * DM * 2;
constexpr size_t WS_WBIN = WS_WOA + 2 * (size_t)DM * DM * 2;
constexpr size_t WS_WQUP = WS_WBIN + 2 * (size_t)BWIN_NP * DM * 2;
constexpr size_t WS_WKVUP = WS_WQUP + 2 * (size_t)NQUP * QL * 2;
constexpr size_t WS_WOB  = WS_WKVUP + 2 * (size_t)NKVUP * KVL * 2;
constexpr size_t WS_WFIN = WS_WOB + 2 * (size_t)DM * DM * 2;
constexpr size_t WS_WFOUT = WS_WFIN + 4 * (size_t)DFF2 * DM * 2;
constexpr size_t WS_XN = WS_WFOUT + 4 * (size_t)DM * DFF * 2;
constexpr size_t WS_S = WS_XN + (size_t)M * DM * 2;
static_assert(WS_XN == 355 * MiB && WS_S == 547 * MiB, "d_ws map");
constexpr size_t WS_AQ = WS_S, WS_AK = WS_AQ + (size_t)M * DM * 2, WS_AV = WS_AK + (size_t)M * NKV * HD * 2;
constexpr size_t WS_AO8 = WS_AV + (size_t)M * NKV * HD * 2;
constexpr size_t WS_BQN = WS_S, WS_BQR = WS_BQN + (size_t)M * DM * 2, WS_BKN = WS_BQR + (size_t)M * NH * ROPE * 2, WS_BV = WS_BKN + (size_t)M * DM * 2;
constexpr size_t WS_CQ = WS_BV + (size_t)M * DM * 2, WS_CKV = WS_CQ + (size_t)M * QL, WS_KR = WS_CKV + (size_t)M * KVL;
constexpr size_t WS_BO8 = WS_KR + (size_t)M * ROPE * 2;
constexpr size_t WS_B_END = WS_BO8 + (size_t)M * DM;
constexpr size_t WS_ACT = WS_S, WS_HALO = WS_ACT + (size_t)M * DFF * 2, WS_F_END = WS_HALO + (size_t)NTILE_M * 4 * DFF2 * 4;
constexpr size_t WS_XB8 = WS_S + 576 * MiB;
static_assert(WS_XB8 >= WS_F_END && WS_XB8 >= WS_BV + (size_t)M * DM && WS_XB8 + (size_t)M * DM <= WS_CQ, "XB8 placement");
constexpr size_t WS_END = WS_B_END > WS_F_END ? WS_B_END : WS_F_END;
static_assert(WS_END <= 1408 * MiB, "workspace budget (4 x largest input)");
constexpr int CW_TMO = 0, CW_BAR = 4096;

constexpr int RING_OFF = 0, RING_BYTES = 131072;
constexpr int LDSCTL_OFF = RING_BYTES, MISC_OFF = LDSCTL_OFF + 320;
constexpr int PTR_OFF = LDSCTL_OFF + 512;
constexpr int XCH_OFF = RING_BYTES + 1024;
constexpr int LDS_BYTES = 147456;
static_assert(XCH_OFF + 8192 <= LDS_BYTES && MISC_OFF + 128 <= XCH_OFF, "LDS map");
static_assert(att::SHM_ATTN <= RING_BYTES, "attention scratch inside the ring region");
static_assert(att::SHM_ATTN8 <= RING_BYTES, "fp8 attention scratch inside the ring region");

typedef unsigned short bf16;
typedef unsigned v2u __attribute__((ext_vector_type(2)));
__device__ __forceinline__ float wave_sum(float v) {
#define WS_SWZ(m) v += __builtin_bit_cast(float, __builtin_amdgcn_ds_swizzle(__builtin_bit_cast(int, v), ((m) << 10) | 0x1F))
    WS_SWZ(1); WS_SWZ(2); WS_SWZ(4); WS_SWZ(8); WS_SWZ(16);
#undef WS_SWZ
    auto rr = __builtin_amdgcn_permlane32_swap(__float_as_uint(v), __float_as_uint(v), false, false);
    return __uint_as_float(rr[0]) + __uint_as_float(rr[1]);
}
__device__ __forceinline__ unsigned pkbf(float lo, float hi) { return pg8::cvt_pk_bf16(lo, hi); }
__device__ __forceinline__ unsigned pk4f8(float a, float b, float c, float d) { int w = __builtin_amdgcn_cvt_pk_fp8_f32(a, b, 0, false); w = __builtin_amdgcn_cvt_pk_fp8_f32(c, d, w, true); return (unsigned)w; }

__device__ __forceinline__ int il128(int d) { return d < 64 ? 2 * d : 2 * (d - 64) + 1; }
__device__ __forceinline__ int il64(int d) { return d < 32 ? 2 * d : 2 * (d - 32) + 1; }
__device__ __forceinline__ int dst_row(int map, int n) {
    switch (map) {
    case 1: return n < (NH + NKV) * HD ? (n & ~127) + il128(n & 127) : (n & ~127) + 32 * (n & 3) + ((n & 127) >> 2);
    case 2: { const int h = n / 192, j = n % 192; return j < 128 ? h * 128 + j : NH * NOPE + h * 64 + il64(j - 128); }
    case 3: { const int h = n / 256, j = n % 256; return j < 128 ? h * 128 + j : NH * NOPE + h * 128 + 32 * (j & 3) + ((j - 128) >> 2); }
    case 4: { const int c = n < DFF ? n : n - DFF; return (c >> 7) * 256 + (n < DFF ? 0 : 128) + (c & 127); }
    case 5: return n < QL + KVL ? n : QL + KVL + il64(n - QL - KVL);
    default: return n;
    }
}
__device__ __forceinline__ void transpose_item(const float* W, int K, int N, bf16* WT, int map, const float* gain, LAS float* scr, int item, int lane, float f8s = 0.f) {
    const int nblk = N / 32, kb = item / nblk, nb = item % nblk, k0 = 64 * kb, n0 = 32 * nb;
    f32x4 v[8]; const int kr = lane >> 3, n4 = (lane & 7) * 4;
#pragma unroll
    for (int i = 0; i < 8; ++i) v[i] = *(const GAS f32x4*)(W + (size_t)(k0 + 8 * i + kr) * N + n0 + n4);
#pragma unroll
    for (int i = 0; i < 8; ++i) { const int kk = 8 * i + kr; const float gk = gain ? gain[k0 + kk] : 1.0f; LAS float* d = scr + kk * 33 + n4;
        d[0] = v[i].x * gk; d[1] = v[i].y * gk; d[2] = v[i].z * gk; d[3] = v[i].w * gk; }
    LDS_WAIT(); asm volatile("" ::: "memory");
    const int c = lane & 7;
#pragma unroll
    for (int j = 0; j < 4; ++j) { const int n = (lane >> 3) + 8 * j; const LAS float* s = scr + (8 * c) * 33 + n;
        if (f8s > 0.f) { v2u o8; o8.x = pk4f8(s[0 * 33] * f8s, s[1 * 33] * f8s, s[2 * 33] * f8s, s[3 * 33] * f8s); o8.y = pk4f8(s[4 * 33] * f8s, s[5 * 33] * f8s, s[6 * 33] * f8s, s[7 * 33] * f8s);
            *(GAS v2u*)((unsigned char*)WT + (size_t)dst_row(map, n0 + n) * K + k0 + 8 * c) = o8; continue; }
        v4u o; o.x = pkbf(s[0 * 33], s[1 * 33]); o.y = pkbf(s[2 * 33], s[3 * 33]); o.z = pkbf(s[4 * 33], s[5 * 33]); o.w = pkbf(s[6 * 33], s[7 * 33]);
        *(GAS v4u*)(WT + (size_t)dst_row(map, n0 + n) * K + k0 + 8 * c) = o; }
    LDS_WAIT(); asm volatile("" ::: "memory");
}
#ifndef P0_RM
#define P0_RM 0
#endif
#ifndef P0_NT
#define P0_NT 1
#endif
#ifndef FIN_NT
#define FIN_NT 1
#endif
struct TDesc { const float* W; int K, N; bf16* WT; int map; const float* gain; float f8s; int item; };
__device__ __forceinline__ void ti_load(const TDesc& d, int lane, f32x4 (&v)[8], float (&g)[8]) {
    const int nblk = d.N / 32, kb = d.item / nblk, nb = d.item % nblk, k0 = 64 * kb, n0 = 32 * nb, kr = lane >> 3, n4 = (lane & 7) * 4;
#pragma unroll
    for (int i = 0; i < 8; ++i) { const GAS f32x4* lp_ = (const GAS f32x4*)(d.W + (size_t)(k0 + 8 * i + kr) * d.N + n0 + n4); v[i] = P0_NT ? __builtin_nontemporal_load(lp_) : *lp_; g[i] = d.gain ? d.gain[k0 + 8 * i + kr] : 1.0f; }
}
__device__ __forceinline__ void ti_finish(const TDesc& d, LAS float* scr, int lane, const f32x4 (&v)[8], const float (&g)[8]) {
    const int nblk = d.N / 32, kb = d.item / nblk, nb = d.item % nblk, k0 = 64 * kb, n0 = 32 * nb, kr = lane >> 3, n4 = (lane & 7) * 4;
#pragma unroll
    for (int i = 0; i < 8; ++i) { const int kk = 8 * i + kr; LAS float* dd = scr + kk * 33 + n4;
        dd[0] = v[i].x * g[i]; dd[1] = v[i].y * g[i]; dd[2] = v[i].z * g[i]; dd[3] = v[i].w * g[i]; }
    LDS_WAIT(); asm volatile("" ::: "memory");
    const int c = lane & 7; const float f8s = d.f8s;
#pragma unroll
    for (int j = 0; j < 4; ++j) { const int n = (lane >> 3) + 8 * j; const LAS float* s = scr + (8 * c) * 33 + n;
        if (f8s > 0.f) { v2u o8; o8.x = pk4f8(s[0 * 33] * f8s, s[1 * 33] * f8s, s[2 * 33] * f8s, s[3 * 33] * f8s); o8.y = pk4f8(s[4 * 33] * f8s, s[5 * 33] * f8s, s[6 * 33] * f8s, s[7 * 33] * f8s);
            *(GAS v2u*)((unsigned char*)d.WT + (size_t)dst_row(d.map, n0 + n) * d.K + k0 + 8 * c) = o8; continue; }
        v4u o; o.x = pkbf(s[0 * 33], s[1 * 33]); o.y = pkbf(s[2 * 33], s[3 * 33]); o.z = pkbf(s[4 * 33], s[5 * 33]); o.w = pkbf(s[6 * 33], s[7 * 33]);
        *(GAS v4u*)(d.WT + (size_t)dst_row(d.map, n0 + n) * d.K + k0 + 8 * c) = o; }
    LDS_WAIT(); asm volatile("" ::: "memory");
}
__device__ __forceinline__ void row_to_bf16_rs(const float* xrow, bf16* orow, float* rs_out, int lane) {
    const GAS f32x4* xr = (const GAS f32x4*)xrow + lane;
    f32x4 v[8]; float s = 0.f;
#pragma unroll
    for (int j = 0; j < 8; ++j) { v[j] = P0_NT ? __builtin_nontemporal_load(xr + 64 * j) : xr[64 * j]; s += (v[j].x * v[j].x + v[j].y * v[j].y) + (v[j].z * v[j].z + v[j].w * v[j].w); }
    s = wave_sum(s);
    if (lane == 0) *rs_out = 1.0f / sqrtf(s * (1.f / DM) + EPS);
    GAS v2u* o8 = (GAS v2u*)orow + lane;
#pragma unroll
    for (int j = 0; j < 8; ++j) { v2u w; w.x = pkbf(v[j].x, v[j].y); w.y = pkbf(v[j].z, v[j].w); o8[64 * j] = w; }
}
__device__ __forceinline__ void rs_phase(const float* ssp, int pitch, int first, int nslot4, float inv_n, float* rs, int bx, int G, int wave, float mul = 1.f) {
    const int t = opaque_tid(wave);
    for (int row = bx * (NWAVES * 64) + t; row < M; row += G * NWAVES * 64) {
        const GAS f32x4* p = (const GAS f32x4*)(ssp + (size_t)row * pitch + first); float s = 0.f;
        for (int j = 0; j < nslot4; ++j) { const f32x4 v = p[j]; s += (v.x + v.y) + (v.z + v.w); }
        rs[row] = mul / sqrtf(s * inv_n + EPS);
    }
}

__device__ __forceinline__ const float* inp_ptr(LAS unsigned char* lds, int i) {
    const unsigned long long v = ((const LAS unsigned long long*)(lds + PTR_OFF))[i];
    const unsigned lo = (unsigned)__builtin_amdgcn_readfirstlane((int)(unsigned)v), hi = (unsigned)__builtin_amdgcn_readfirstlane((int)(unsigned)(v >> 32));
    return (const float*)(((unsigned long long)hi << 32) | lo);
}
struct Args { const float* in[18]; float* out; unsigned char* ws; };
__global__ void __launch_bounds__(NWAVES * 64, 2) trunk_fwd(Args args) {
    extern __shared__ __attribute__((aligned(16))) unsigned char lds_raw[];
    LAS unsigned char* lds = (LAS unsigned char*)lds_raw;
    volatile LAS unsigned* MISC = (volatile LAS unsigned*)(lds + MISC_OFF);
    const int tid = threadIdx.x, lane = tid & 63, wave = __builtin_amdgcn_readfirstlane(tid >> 6);
    const int G0_ = gridDim.x, bx0_ = blockIdx.x;
#define GRID_IDS() int G = G0_, bx = bx0_; asm volatile("" : "+s"(G), "+s"(bx)); const int vcu = (G % 8 == 0) ? (bx % 8) * (G / 8) + bx / 8 : bx; const int gw = vcu * NWAVES + wave, NGW = G * NWAVES; (void)gw; (void)NGW; (void)vcu
    unsigned char* ws = args.ws;
    gu32* ctl = (gu32*)(ws + WS_CTL);
    for (int u = tid; u < (XCH_OFF - LDSCTL_OFF) / 4; u += NWAVES * 64) ((LAS unsigned*)(lds + LDSCTL_OFF))[u] = 0u;
    __syncthreads();
    if (tid < 18) ((LAS unsigned long long*)(lds + PTR_OFF))[tid] = (unsigned long long)args.in[tid];
    __syncthreads();
#define INP(i) inp_ptr(lds, (i))
#define STAGGER() do { if (STAGGER_TICKS > 0 && ((bx >> 3) & 1)) { const unsigned long long t0_ = __builtin_amdgcn_s_memrealtime(); while (__builtin_amdgcn_s_memrealtime() - t0_ < (unsigned long long)STAGGER_TICKS) __builtin_amdgcn_s_sleep(8); } } while (0)
    XcdBarrier bar = xcd_barrier_post((unsigned*)(ctl + CW_BAR), MISC + 8, tid == 0);
#define GRID_BAR() do { XcdBarrier b_ = bar; asm volatile("" : "+s"(b_.x), "+s"(b_.bar)); xcd_barrier(b_, wave == 0 && lane_id() == 0); } while (0)
    float* X = args.out;
    bf16* XB = (bf16*)(ws + WS_XN);
    float* RS = (float*)(ws + WS_RS); float* RSQ = (float*)(ws + WS_RSQ); float* RSK = (float*)(ws + WS_RSK); float* SSP = (float*)(ws + WS_SSP);

#pragma unroll 1
    for (int rep0_ = 0; rep0_ < PROBE_P0; ++rep0_) {
    GRID_IDS();
    {
        LAS float* scr = (LAS float*)(lds + RING_OFF + wave * 16384);
        constexpr int I_QKV = (DM / 64) * (NQKV / 32), I_WO = (DM / 64) * (DM / 32), I_BIN = (DM / 64) * (BWIN_N / 32), I_QUP = (QL / 64) * (NQUP / 32),
                      I_KVUP = (KVL / 64) * (NKVUP / 32), I_FIN = (DM / 64) * (DFF2 / 32), I_FOUT = (DFF / 64) * (DM / 32);
        constexpr int NITEMS = 2 * (I_QKV + I_WO + I_BIN + I_QUP + I_KVUP + I_WO) + 4 * (I_FIN + I_FOUT);
        auto rm = [](int r, int NB) -> int { const int s = r >> 3; return (((s / NB) << 3) + (r & 7)) * NB + s % NB; };
        auto decode = [&](int it) -> TDesc {
            int r = it;
            if (r < 2 * I_QKV) { const int l = r / I_QKV; return TDesc{args.in[5] + (size_t)l * DM * NQKV, DM, NQKV, (bf16*)(ws + WS_WQKV) + (size_t)l * NQKV * DM, 1, args.in[2] + (2 * l) * DM, (QKV8_L2 && l == 1) ? W8_WO : 0.f, P0_RM ? rm(r % I_QKV, NQKV / 32) : r % I_QKV}; } r -= 2 * I_QKV;
            if (r < 2 * I_WO) { const int l = r / I_WO; return TDesc{args.in[6] + (size_t)l * DM * DM, DM, DM, (bf16*)(ws + WS_WOA + (size_t)l * DM * DM), 0, nullptr, W8_WO, P0_RM ? rm(r % I_WO, DM / 32) : r % I_WO}; } r -= 2 * I_WO;
            if (r < 2 * I_BIN) { const int l = r / I_BIN; return TDesc{args.in[8] + (size_t)l * DM * BWIN_N, DM, BWIN_N, (bf16*)(ws + WS_WBIN + (size_t)l * BWIN_NP * DM), 5, args.in[2] + (2 * l + 1) * DM, W8_WO, P0_RM ? rm(r % I_BIN, BWIN_N / 32) : r % I_BIN}; } r -= 2 * I_BIN;
            if (r < 2 * I_QUP) { const int l = r / I_QUP; return TDesc{args.in[10] + (size_t)l * QL * NQUP, QL, NQUP, (bf16*)(ws + WS_WQUP + (size_t)l * NQUP * QL), 2, args.in[9] + l * QL, W8_UP, P0_RM ? rm(r % I_QUP, NQUP / 32) : r % I_QUP}; } r -= 2 * I_QUP;
            if (r < 2 * I_KVUP) { const int l = r / I_KVUP; return TDesc{args.in[12] + (size_t)l * KVL * NKVUP, KVL, NKVUP, (bf16*)(ws + WS_WKVUP + (size_t)l * NKVUP * KVL), 3, args.in[11] + l * KVL, W8_UP, P0_RM ? rm(r % I_KVUP, NKVUP / 32) : r % I_KVUP}; } r -= 2 * I_KVUP;
            if (r < 2 * I_WO) { const int l = r / I_WO; return TDesc{args.in[13] + (size_t)l * DM * DM, DM, DM, (bf16*)(ws + WS_WOB + (size_t)l * DM * DM), 0, nullptr, W8_WO, P0_RM ? rm(r % I_WO, DM / 32) : r % I_WO}; } r -= 2 * I_WO;
            if (r < 4 * I_FIN) { const int l = r / I_FIN; return TDesc{args.in[14] + (size_t)l * DM * DFF2, DM, DFF2, (bf16*)(ws + WS_WFIN) + (size_t)l * DFF2 * DM, 4, args.in[3] + l * DM, 0.f, P0_RM ? rm(r % I_FIN, DFF2 / 32) : r % I_FIN}; } r -= 4 * I_FIN;
            { const int l = r / I_FOUT; return TDesc{args.in[17] + (size_t)l * DFF * DM, DFF, DM, (bf16*)(ws + WS_WFOUT) + (size_t)l * DM * DFF, 0, nullptr, 0.f, P0_RM ? rm(r % I_FOUT, DM / 32) : r % I_FOUT}; }
        };
        { f32x4 va[8], vb[8]; float ga[8], gb[8]; TDesc d = decode(gw < NITEMS ? gw : 0);
          if (gw < NITEMS) ti_load(d, lane, va, ga);
          for (int it = gw; it < NITEMS; it += NGW) {
              const bool more = it + NGW < NITEMS; const TDesc dn = decode(more ? it + NGW : it);
              if (more) ti_load(dn, lane, vb, gb);
              ti_finish(d, scr, lane, va, ga);
              d = dn;
#pragma unroll
              for (int i = 0; i < 8; ++i) { va[i] = vb[i]; ga[i] = gb[i]; } } }
        for (int i = gw; i < 2 * (BWIN_NP - BWIN_N); i += NGW) { const int l = i / (BWIN_NP - BWIN_N), rr = BWIN_N + i % (BWIN_NP - BWIN_N);
            GAS v4u* p = (GAS v4u*)(ws + WS_WBIN + ((size_t)l * BWIN_NP + rr) * DM) + lane;
#pragma unroll
            for (int j = 0; j < 2; ++j) p[64 * j] = (v4u){0u, 0u, 0u, 0u}; }
        for (int i = bx * (NWAVES * 64) + tid; i < SEQ * 64 + SEQ * 32; i += G * NWAVES * 64) {
            if (i < SEQ * 64) { const int pos = i >> 6, j = i & 63; const double inv = exp2(-(double)(2 * j) / 128.0 * 13.287712379549449); const double a = (double)pos * inv;
                ((float*)(ws + WS_COSA))[i] = (float)cos(a); ((float*)(ws + WS_SINA))[i] = (float)sin(a); }
            else { const int k = i - SEQ * 64, pos = k >> 5, j = k & 31; const double inv = exp2(-(double)(2 * j) / 64.0 * 13.287712379549449); const double a = (double)pos * inv;
                ((float*)(ws + WS_COSB))[k] = (float)cos(a); ((float*)(ws + WS_SINB))[k] = (float)sin(a); }
        }
        for (int m = gw; m < M; m += NGW) { const float* xr = m < M_PROMPT ? args.in[0] + (size_t)m * DM : args.in[1] + (size_t)(m - M_PROMPT) * DM;
            row_to_bf16_rs(xr, XB + (size_t)m * DM, RS + m, lane); }
    }
    GRID_BAR();
    }

    for (int layer = 0; layer < DEPTH; ++layer) {
        GRID_IDS();
        const int jl = layer >> 1;
        unsigned char* wsl = ws; asm volatile("" : "+s"(wsl));
        bf16* XB = (bf16*)(wsl + WS_XN); float* RS = (float*)(wsl + WS_RS); float* RSQ = (float*)(wsl + WS_RSQ); float* RSK = (float*)(wsl + WS_RSK); float* SSP = (float*)(wsl + WS_SSP);
        const float* cosA = (const float*)(wsl + WS_COSA); const float* sinA = (const float*)(wsl + WS_SINA); const float* cosB = (const float*)(wsl + WS_COSB); const float* sinB = (const float*)(wsl + WS_SINB);
        const float* rb0 = nullptr; const float* rb1 = nullptr;
        if ((layer & 1) == 0) {
            bf16* AQ = (bf16*)(wsl + WS_AQ); bf16* AK = (bf16*)(wsl + WS_AK); bf16* AV = (bf16*)(wsl + WS_AV);
#pragma unroll 1
            for (int rp_ = 0; rp_ < PROBE_QKV; ++rp_) {
            if constexpr (PH_MASK & 1) {
                if (QKV8_L2 && jl == 1) {
                    pg8::Gemm g{(const bf16*)(wsl + WS_XB8), (const bf16*)(wsl + WS_WQKV + (size_t)jl * NQKV * DM * 2), M, NQKV, DM / 2}; pg8::StaticOrder S; S.init(M, NQKV, G, bx, WGM_REST);
                    pg8::EpiRope E{AQ, AK, AV, DM, NKV * HD, NKV * HD, 8, 10, 3, cosA, sinA, 64, RS, 1.0f / W8_WO};
                    STAGGER(); pg8::gemm_phase<pg8::EpiRope, pg8::StaticOrder, PG8_ALIGNX, PG8_SP2X, true>(lds + RING_OFF, g, S, E, wave);
                } else {
                pg8::Gemm g{XB, (const bf16*)(wsl + WS_WQKV) + (size_t)jl * NQKV * DM, M, NQKV, DM}; pg8::StaticOrder S; S.init(M, NQKV, G, bx, WGM_REST);
                pg8::EpiRope E{AQ, AK, AV, DM, NKV * HD, NKV * HD, 8, 10, 3, cosA, sinA, 64, RS, 1.0f};
                STAGGER(); pg8::gemm_phase<pg8::EpiRope, pg8::StaticOrder, PG8_ALIGNX, PG8_SP2X>(lds + RING_OFF, g, S, E, wave);
                }
            }
            GRID_BAR();
            }
#pragma unroll 1
            for (int rep_ = 0; rep_ < PROBE_WIN; ++rep_) {
            if constexpr (PH_MASK & 2) {
                const int xcd = vcu >> 5, c = vcu & 31;
                for (int i = 0; i < 12; ++i) {
                    const int pidx = xcd * 12 + i, b = pidx >> 3, h = 2 * (pidx & 7), kvh = h >> 2;
                    const int q0 = c * 128, k0 = q0 >= 128 ? q0 - 128 : 0, k1 = (q0 + 256 <= SEQ) ? q0 + 256 : SEQ;
                    const size_t row0 = (size_t)b * SEQ;
                    const float sink = INP(7)[jl * NH + h], sinkb = INP(7)[jl * NH + h + 1];
                    att::attn_body<0, true, 0, true, true>(AQ + (row0 + q0) * DM + h * HD, DM, nullptr, 0,
                                            AK + (row0 + k0) * (NKV * HD) + kvh * HD, NKV * HD, nullptr, 0,
                                            AV + (row0 + k0) * (NKV * HD) + kvh * HD, NKV * HD,
                                            (bf16*)(wsl + WS_AO8 + (row0 + q0) * DM + h * HD), DM, (k1 - k0) / 64, q0 - k0, sink * 11.313708498984761f, 1.0f, (LAS char*)(lds + RING_OFF), wave, O8_A, sinkb * 11.313708498984761f);
                }
            }
            GRID_BAR();
            }
#pragma unroll 1
            for (int rp_ = 0; rp_ < PROBE_WOA; ++rp_) {
            if constexpr (PH_MASK & 4) {
                pg8::Gemm g{(const bf16*)(wsl + WS_AO8), (const bf16*)(wsl + WS_WOA + (size_t)jl * DM * DM), M, DM, DM / 2}; pg8::StaticOrder S; S.init(M, DM, G, bx, WGM_REST);
                pg8::EpiResid E{rb0, rb1, M_PROMPT / 256, XB, nullptr, SSP, DM, rp_ + 1 == PROBE_WOA ? 1.0f / (W8_WO * O8_A) : 0.0f, nullptr};
                STAGGER(); pg8::gemm_phase<pg8::EpiResid, pg8::StaticOrder, PG8_ALIGNX, PG8_SP2X, true>(lds + RING_OFF, g, S, E, wave);
            }
            GRID_BAR();
            }
            rs_phase(SSP, 32, 0, 8, 1.0f / DM, RS, bx, G, wave);
            GRID_BAR();
        } else {
            bf16* CQ = (bf16*)(wsl + WS_CQ); bf16* CKV = (bf16*)(wsl + WS_CKV); bf16* KR = (bf16*)(wsl + WS_KR);
            bf16* BQN = (bf16*)(wsl + WS_BQN); bf16* BQR = (bf16*)(wsl + WS_BQR); bf16* BKN = (bf16*)(wsl + WS_BKN); bf16* BV = (bf16*)(wsl + WS_BV);
#pragma unroll 1
            for (int rp_ = 0; rp_ < PROBE_BWIN; ++rp_) {
            if constexpr (PH_MASK & 8) {
                pg8::Gemm g{(const bf16*)(wsl + WS_XB8), (const bf16*)(wsl + WS_WBIN + (size_t)jl * BWIN_NP * DM), M, BWIN_NP, DM / 2}; pg8::StaticOrder S; S.init(M, BWIN_NP, G, bx, WGM_REST);
                pg8::EpiBwin E{CQ, CKV, KR, SSP, cosB, sinB, RS, MLA8_KSC, 1.0f / W8_WO};
                STAGGER(); pg8::gemm_phase<pg8::EpiBwin, pg8::StaticOrder, PG8_ALIGNX, PG8_SP2X, true>(lds + RING_OFF, g, S, E, wave);
            }
            GRID_BAR();
            }
            rs_phase(SSP, 16, 0, 2, 1.0f / QL, RSQ, bx, G, wave, MLA8_QSC / W8_UP); rs_phase(SSP, 16, 8, 2, 1.0f / KVL, RSK, bx, G, wave, 1.0f / W8_UP);
            GRID_BAR();
#pragma unroll 1
            for (int rp_ = 0; rp_ < PROBE_UP; ++rp_) {
            if constexpr (PH_MASK & 32) {
                pg8::Gemm g{CQ, (const bf16*)(wsl + WS_WQUP + (size_t)jl * NQUP * QL), M, NQUP, QL / 2}; pg8::StaticOrder S; S.init(M, NQUP, G, bx, WGM_REST);
                pg8::EpiRopeT<true> E{BQN, BQR, BQR, DM, NH * ROPE, NH * ROPE, 8, 12, 2, cosB, sinB, 32, RSQ, 1.0f};
                STAGGER(); pg8::gemm_phase<pg8::EpiRopeT<true>, pg8::StaticOrder, PG8_ALIGNX, PG8_SP2X, true>(lds + RING_OFF, g, S, E, wave);
            }
            if constexpr (PH_MASK & 64) {
                pg8::Gemm g{CKV, (const bf16*)(wsl + WS_WKVUP + (size_t)jl * NKVUP * KVL), M, NKVUP, KVL / 2}; pg8::StaticOrder S; S.init(M, NKVUP, G, bx, WGM_REST);
                pg8::EpiKV8 E{(unsigned char*)BKN, (unsigned char*)BV, RSK, MLA8_KSC};
                STAGGER(); pg8::gemm_phase<pg8::EpiKV8, pg8::StaticOrder, PG8_ALIGNX, PG8_SP2X, true>(lds + RING_OFF, g, S, E, wave);
            }
            GRID_BAR();
            }
#pragma unroll 1
            for (int rep_ = 0; rep_ < PROBE_MLA; ++rep_) {
#if DIAG_CLK == 3
            const long long ca0_ = clock64();
#endif
            if constexpr (PH_MASK & 128) {
                const int xcd = vcu >> 5, c = vcu & 31;
                for (int i = 0; i < 12; ++i) {
                    const int bh = xcd * 24 + 2 * i + (c >> 4), qb = c & 15, b = bh >> 4, h = bh & 15;
                    const size_t row0 = (size_t)b * SEQ; const int q0 = qb * 256;
#if PROBE_MLA > 1 && defined(PROBE_ATT_MODE)
                    if (rep_ + 1 < PROBE_MLA) att::MLA8_FN<(long)(WS_BV - WS_BKN), PROBE_ATT_MODE>((const unsigned char*)BQN + (row0 + q0) * DM + h * NOPE, DM, (const unsigned char*)BQR + (row0 + q0) * (NH * ROPE) + h * ROPE, NH * ROPE,
                                   (const unsigned char*)BKN + (size_t)bh * (SEQ / 64) * 8192, (const unsigned char*)KR + (size_t)b * (SEQ / 64) * 4096,
                                   wsl + WS_BO8 + (row0 + q0) * DM + h * VD, DM, (LAS char*)(lds + RING_OFF), wave, O8_B);
                    else
#endif
                    att::MLA8_FN<(long)(WS_BV - WS_BKN)>((const unsigned char*)BQN + (row0 + q0) * DM + h * NOPE, DM, (const unsigned char*)BQR + (row0 + q0) * (NH * ROPE) + h * ROPE, NH * ROPE,
                                   (const unsigned char*)BKN + (size_t)bh * (SEQ / 64) * 8192, (const unsigned char*)KR + (size_t)b * (SEQ / 64) * 4096,
                                   wsl + WS_BO8 + (row0 + q0) * DM + h * VD, DM, (LAS char*)(lds + RING_OFF), wave, O8_B);
                }
            }
#if DIAG_CLK == 3
            if (layer == 1 && bx == 0 && opaque_tid(wave) == 0) ((float*)(ctl + 8192))[0] = (float)(clock64() - ca0_) * (1.0f / (12.f * 64.f * 100.f));
#endif
            GRID_BAR();
            }
#if DIAG_MLA8
            if (layer == 1 && bx < 8) {
                const int t_ = opaque_tid(wave);
                const int srow = bx == 0 ? 0 : bx == 1 ? 255 : bx == 2 ? 256 : bx == 3 ? 4095 : bx == 4 ? 4096 + 1234 : bx == 5 ? 20000 : bx == 6 ? 36863 : 49151, sh = (2 * bx + 1) & 15;
                const int sb = srow >> 12, sbh = sb * 16 + sh;
                const unsigned char* qn = (const unsigned char*)BQN + (size_t)srow * DM + sh * NOPE; const unsigned char* qp = (const unsigned char*)BQR + (size_t)srow * (NH * ROPE) + sh * ROPE;
                const unsigned char* kn = (const unsigned char*)BKN + (size_t)sbh * 64 * 8192; const unsigned char* kr = (const unsigned char*)KR + (size_t)sb * 64 * 4096; const unsigned char* vt = (const unsigned char*)BV + (size_t)sbh * 64 * 8192;
                LAS float* sc = (LAS float*)(lds + RING_OFF);
#define F8DEC(x) __builtin_amdgcn_cvt_f32_fp8((int)(x), 0)
_Pragma("unroll 1")
                for (int j = t_; j < SEQ; j += NWAVES * 64) { const int tl = j >> 6, kk = j & 63; float s = 0.f;
_Pragma("unroll 1")
                    for (int d = 0; d < 128; ++d) s += F8DEC(qn[d]) * F8DEC(kn[(size_t)tl * 8192 + kk * 128 + (((d & ~15) ^ (((kk >> 1) & 7) << 4)) | (d & 15))]);
_Pragma("unroll 1")
                    for (int d = 0; d < 64; ++d) s += F8DEC(qp[d]) * F8DEC(kr[(size_t)tl * 4096 + kk * 64 + (((d & ~15) ^ (((kk >> 2) & 3) << 4)) | (d & 15))]);
                    sc[j] = MLA8_PRESCALE ? s * 0.6931471805599453f : s * 0.07216878364870322f; }
                __syncthreads();
                float mx = -1e30f;
_Pragma("unroll 1")
                for (int j = 0; j < SEQ; ++j) mx = fmaxf(mx, sc[j]);
                float l = 0.f;
_Pragma("unroll 1")
                for (int j = 0; j < SEQ; ++j) l += __builtin_amdgcn_exp2f((sc[j] - mx) * 1.4426950408889634f);
                if (t_ < 128) { float o_ = 0.f; const int vr_ = 32 * (t_ & 3) + (t_ >> 2);
_Pragma("unroll 1")
                    for (int j = 0; j < SEQ; ++j) { const int tl = j >> 6, kk = j & 63; o_ += __builtin_amdgcn_exp2f((sc[j] - mx) * 1.4426950408889634f) * F8DEC(vt[(size_t)tl * 8192 + vr_ * 64 + ((((kk >> 4) ^ ((vr_ >> 2) & 3))) << 4) + (kk & 15)]); }
                    o_ /= l; const float got = F8DEC(((const unsigned char*)(wsl + WS_BO8))[(size_t)srow * DM + sh * VD + t_]) * (1.0f / O8_B);
                    atomicAdd((float*)(ctl + 8192), (got - o_) * (got - o_)); atomicAdd((float*)(ctl + 8192) + 1, o_ * o_); }
                __syncthreads();
            }
#endif
#pragma unroll 1
            for (int rp_ = 0; rp_ < PROBE_WOB; ++rp_) {
            if constexpr (PH_MASK & 256) {
                pg8::Gemm g{(const bf16*)(wsl + WS_BO8), (const bf16*)(wsl + WS_WOB + (size_t)jl * DM * DM), M, DM, DM / 2}; pg8::StaticOrder S; S.init(M, DM, G, bx, WGM_REST);
                pg8::EpiResid E{rb0, rb1, M_PROMPT / 256, XB, nullptr, SSP, DM, rp_ + 1 == PROBE_WOB ? 1.0f / (W8_WO * O8_B) : 0.0f, nullptr};
                STAGGER(); pg8::gemm_phase<pg8::EpiResid, pg8::StaticOrder, PG8_ALIGNX, PG8_SP2X, true>(lds + RING_OFF, g, S, E, wave);
            }
            GRID_BAR();
            }
            rs_phase(SSP, 32, 0, 8, 1.0f / DM, RS, bx, G, wave);
            GRID_BAR();
        }
#if PROBE_FIN_NULL
        {
#if DIAG_CLK == 2
            const long long c0_ = clock64();
#endif (near-free epilogue into d_out, which the last layer overwrites later)
#if PROBE_FIN_NULL == 2
            pg8::Gemm g{XB, (const bf16*)(wsl + WS_WFIN) + (size_t)layer * DFF2 * DM, M, DFF2, DM}; pg8::StaticOrder S; S.init((bx & 8) ? 0 : M, DFF2, G / 2, (bx & 7) + 8 * (bx >> 4));
#else
            pg8::Gemm g{XB, (const bf16*)(wsl + WS_WFIN) + (size_t)layer * DFF2 * DM, M, DFF2, DM}; pg8::StaticOrder S; S.init(M, DFF2, G, bx, WGM_REST);
#endif
#if PROBE_FIN_NULL >= 11
            pg8::EpiConvT<PROBE_FIN_NULL - 10> E{nullptr, nullptr, INP(15) + (size_t)layer * 3 * DFF2, INP(16) + (size_t)layer * DFF2, (LAS float*)(lds + XCH_OFF), DFF, (const float*)(wsl + WS_RS)};
            STAGGER(); pg8::gemm_phase<pg8::EpiConvT<PROBE_FIN_NULL - 10>, pg8::StaticOrder, true, PG8_SP2X>(lds + RING_OFF, g, S, E, wave);
#else
            pg8::EpiSum E{X};
            STAGGER(); pg8::gemm_phase<pg8::EpiSum, pg8::StaticOrder, PG8_ALIGNX, PG8_SP2X>(lds + RING_OFF, g, S, E, wave);
#endif
#if DIAG_CLK == 2
            if (layer == 0 && bx == 0 && opaque_tid(wave) == 0) ((float*)(ctl + 8192))[0] = (float)(clock64() - c0_) * (1.0f / (33.f * 32.f * 100.f));
#endif
            GRID_BAR();
        }
#endif
        constexpr int MC = M / FFN_CHUNKS, TC = MC / 256;
        static_assert(M % FFN_CHUNKS == 0 && MC % SEQ == 0, "FFN chunks are whole sequences");
#pragma unroll 1
        for (int ck = 0; ck < FFN_CHUNKS; ++ck) {
#define CK_PTRS() int ck_ = ck; asm volatile("" : "+s"(ck_)); const size_t r0 = (size_t)ck_ * MC; bf16* ACTc = (bf16*)(wsl + WS_ACT) + r0 * DFF; float* HALOc = (float*)(wsl + WS_HALO) + (r0 / 256) * 4 * DFF2; bf16* XBc = (bf16*)(wsl + WS_XN) + r0 * DM; (void)ACTc; (void)HALOc; (void)XBc
#pragma unroll 1
        for (int rep_ = 0; rep_ < PROBE_FIN; ++rep_) {
        if constexpr (PH_MASK & 512) {
            CK_PTRS(); const float* cw = INP(15) + (size_t)layer * 3 * DFF2; const float* cb = INP(16) + (size_t)layer * DFF2;
            pg8::Gemm g{XBc, (const bf16*)(wsl + WS_WFIN) + (size_t)layer * DFF2 * DM, MC, DFF2, DM}; pg8::StaticOrder S; S.init(MC, DFF2, G, bx, WGM_FIN);
            pg8::EpiConv E{ACTc, HALOc, cw, cb, (LAS float*)(lds + XCH_OFF), DFF, RS + r0};
            STAGGER(); pg8::gemm_phase<pg8::EpiConv, pg8::StaticOrder, true, PG8_SP2X>(lds + RING_OFF, g, S, E, wave);
        }
        GRID_BAR();
        }
        if constexpr (PH_MASK & 1024) { const int ln = opaque_tid(wave) & 63; CK_PTRS(); const float* cw = INP(15) + (size_t)layer * 3 * DFF2; const float* cb = INP(16) + (size_t)layer * DFF2;
            constexpr int NCH = DFF / 256;
            for (int it = gw; it < TC * 2 * NCH; it += NGW) {
                const int ch = it % NCH, tr = it / NCH, pm = tr >> 1, last = tr & 1;
                const int c = ch * 256 + 4 * ln, pn = c >> 7, cc = c & 127;
                const size_t gc = (size_t)pn * 256 + cc, uc = gc + 128;
                const float* Hc = HALOc + ((size_t)pm * 4 + (last ? 3 : 0)) * DFF2;
                const bool hasP = last ? true : (pm & 15) != 0, hasN = last ? (pm & 15) != 15 : true;
                const float* Hp = last ? HALOc + ((size_t)pm * 4 + 2) * DFF2 : HALOc + ((size_t)(pm - 1) * 4 + 3) * DFF2;
                const float* Hn = last ? HALOc + ((size_t)(pm + 1) * 4 + 0) * DFF2 : HALOc + ((size_t)pm * 4 + 1) * DFF2;
                const f32x4 z = (f32x4){0.f, 0.f, 0.f, 0.f};
                const f32x4 gP = hasP ? *(const f32x4*)(Hp + gc) : z, uP = hasP ? *(const f32x4*)(Hp + uc) : z;
                const f32x4 gN = hasN ? *(const f32x4*)(Hn + gc) : z, uN = hasN ? *(const f32x4*)(Hn + uc) : z;
                const f32x4 gC = *(const f32x4*)(Hc + gc), uC = *(const f32x4*)(Hc + uc);
                const f32x4 gg = *(const f32x4*)(cw + c) * gP + *(const f32x4*)(cw + DFF2 + c) * gC + *(const f32x4*)(cw + 2 * DFF2 + c) * gN + *(const f32x4*)(cb + c);
                const f32x4 uu = *(const f32x4*)(cw + DFF + c) * uP + *(const f32x4*)(cw + DFF2 + DFF + c) * uC + *(const f32x4*)(cw + 2 * DFF2 + DFF + c) * uN + *(const f32x4*)(cb + DFF + c);
                f32x4 a;
#pragma unroll
                for (int e = 0; e < 4; ++e) { const float ex = __builtin_amdgcn_exp2f(-1.4426950408889634f * gg[e]); a[e] = gg[e] * __builtin_amdgcn_rcpf(1.0f + ex) * uu[e]; }
                v2u w; w.x = pkbf(a[0], a[1]); w.y = pkbf(a[2], a[3]);
                *(GAS v2u*)(ACTc + ((size_t)pm * 256 + (last ? 255 : 0)) * DFF + c) = w;
            }
        }
        GRID_BAR();
#pragma unroll 1
        for (int rep_ = 0; rep_ < PROBE_FOUT; ++rep_) {
        if constexpr (PH_MASK & 2048) {
            CK_PTRS();
            pg8::Gemm g{ACTc, (const bf16*)(wsl + WS_WFOUT) + (size_t)layer * DM * DFF, MC, DM, DFF}; pg8::StaticOrder S; S.init(MC, DM, G, bx, WGM_FOUT);
            pg8::EpiResid E{nullptr, nullptr, 0, XBc, (!FINAL_BF16 && layer + 1 == DEPTH && rep_ + 1 == PROBE_FOUT) ? X + r0 * DM : nullptr, SSP + r0 * 32, DM, rep_ + 1 == PROBE_FOUT ? 1.0f : 0.0f, ((layer & 1) == 0 || (QKV8_L2 && layer == 1)) ? wsl + WS_XB8 + r0 * DM : nullptr};
            STAGGER(); pg8::gemm_phase<pg8::EpiResid, pg8::StaticOrder, PG8_ALIGNX, PG8_SP2X>(lds + RING_OFF, g, S, E, wave);
        }
        GRID_BAR();
        }
        }
#undef CK_PTRS
        if (layer + 1 < DEPTH) { rs_phase(SSP, 32, 0, 8, 1.0f / DM, RS, bx, G, wave); GRID_BAR(); }
    }
#pragma unroll 1
    for (int pb_ = 0; pb_ < PROBE_BARS; ++pb_) GRID_BAR();
    {
        GRID_IDS();
        const int lane = opaque_tid(wave) & 63;
        const GAS f32x4* gr = (const GAS f32x4*)INP(4) + lane;
        for (int m = gw; m < M; m += NGW) {
            GAS f32x4* xr = (GAS f32x4*)(X + (size_t)m * DM) + lane;
            const float r = 1.0f / sqrtf(wave_sum(lane < 32 ? SSP[(size_t)m * 32 + lane] : 0.f) * (1.f / DM) + EPS);
#if FINAL_BF16
            const GAS v2u* xb = (const GAS v2u*)((const bf16*)(ws + WS_XN) + (size_t)m * DM) + lane;
            v2u xv[8];
#pragma unroll
            for (int j = 0; j < 8; ++j) xv[j] = xb[64 * j];
#pragma unroll
            for (int j = 0; j < 8; ++j) { const f32x4 xf = (f32x4){__uint_as_float(xv[j].x << 16), __uint_as_float(xv[j].x & 0xffff0000u), __uint_as_float(xv[j].y << 16), __uint_as_float(xv[j].y & 0xffff0000u)};
                const f32x4 ov_ = xf * r * gr[64 * j]; if (FIN_NT) __builtin_nontemporal_store(ov_, xr + 64 * j); else xr[64 * j] = ov_; }
#else
#pragma unroll
            for (int j = 0; j < 8; ++j) xr[64 * j] = xr[64 * j] * r * gr[64 * j];
#endif
        }
    }
#if DIAG_MLA8
    GRID_BAR();
    { GRID_IDS(); const float e2 = __hip_atomic_load((float*)(ctl + 8192), RLX_AGENT), r2 = __hip_atomic_load((float*)(ctl + 8192) + 1, RLX_AGENT);
      int code = (int)(sqrtf(e2 / r2) * 100.f + 1.5f); code = code < 1 ? 1 : (code > 98 ? 98 : code);
      const float C = sqrtf(1.0025f * (10.f * code - 1.f)); const int lane = opaque_tid(wave) & 63;
      for (int m = gw; m < M; m += NGW) { GAS f32x4* xr = (GAS f32x4*)(X + (size_t)m * DM) + lane;
#pragma unroll
          for (int j = 0; j < 8; ++j) xr[64 * j] = (f32x4){C, C, C, C}; } }
#endif
#if DIAG_CLK
    GRID_BAR();
    { GRID_IDS(); const float ratio = __hip_atomic_load((float*)(ctl + 8192), RLX_AGENT); int code = (int)(ratio + 0.5f); code = code < 1 ? 1 : (code > 98 ? 98 : code);
      const float C = sqrtf(1.0025f * (10.f * code - 1.f)); const int lane = opaque_tid(wave) & 63;
      for (int m = gw; m < M; m += NGW) { GAS f32x4* xr = (GAS f32x4*)(X + (size_t)m * DM) + lane;
#pragma unroll
          for (int j = 0; j < 8; ++j) xr[64 * j] = (f32x4){C, C, C, C}; } }
#endif
}

extern "C" void kernel_launch(void* const* d_in, const int* in_sizes, int n_in, void* d_out, int out_size, void* d_ws, size_t ws_size, hipStream_t stream) {
    static int grid = 0;
    if (grid == 0) {
        if (n_in != 18 || out_size != M * DM || ws_size < WS_END) { fprintf(stderr, "kernel_launch: shape mismatch n_in %d out %d ws %zu (need %zu)\n", n_in, out_size, ws_size, (size_t)WS_END); grid = -1; return; }
        int dev = 0, cus = 0, per_cu = 0;
        if (hipGetDevice(&dev) != hipSuccess || hipDeviceGetAttribute(&cus, hipDeviceAttributeMultiprocessorCount, dev) != hipSuccess) { grid = -1; return; }
        if (hipFuncSetAttribute((const void*)trunk_fwd, hipFuncAttributeMaxDynamicSharedMemorySize, LDS_BYTES) != hipSuccess) { fprintf(stderr, "kernel_launch: hipFuncSetAttribute failed\n"); grid = -1; return; }
        if (hipOccupancyMaxActiveBlocksPerMultiprocessor(&per_cu, (const void*)trunk_fwd, NWAVES * 64, LDS_BYTES) != hipSuccess || per_cu < 1)
            fprintf(stderr, "kernel_launch: occupancy query reports %d workgroups per CU\n", per_cu);
        (void)hipGetLastError();
        grid = cus;
        if (grid != 256) fprintf(stderr, "kernel_launch: %d CUs (the attention unit deal assumes 256)\n", grid);
    }
    if (grid < 0) return;
    if (hipMemsetAsync((char*)d_ws + WS_CTL, 0, CTL_ZERO_BYTES, stream) != hipSuccess) return;
    Args a{};
    for (int i = 0; i < 18; ++i) a.in[i] = (const float*)d_in[i];
    a.out = (float*)d_out; a.ws = (unsigned char*)d_ws;
    hipLaunchKernelGGL(trunk_fwd, dim3(grid), dim3(NWAVES * 64), LDS_BYTES, stream, a);
    const hipError_t le = hipPeekAtLastError();
    if (le != hipSuccess) fprintf(stderr, "kernel_launch: launch failed: %s\n", hipGetErrorName(le));
}
```
